# Optimizing an MI355X kernel written in HIP

```python
import math
import jax, jax.numpy as jnp
from jax import lax
import numpy as np

D_MODEL = 1024
BATCH = 2
SEQ = 16384
DEPTH = 1

HEAD_DIM = 64
D_MIX = D_MODEL
D_MOBA = D_MIX // 2
D_RET = D_MIX - D_MOBA
N_HEADS_MOBA = D_MOBA // HEAD_DIM
N_HEADS_RET = D_RET // HEAD_DIM
N_PROJ = 3 * D_MOBA + 4 * D_RET
MOBA_BLOCK = 256
MOBA_TOPK = 3
Q_BLOCK = 128
RET_CHUNK = 256
REL_BUCKETS = 32
REL_MAX_DIST = 128
ROPE_BASE = 10000.0
D_FF = ((8 * D_MODEL // 3 + 255) // 256) * 256
CONV_WIDTH = 3
EPS = 1e-6
NEG = -1e30

kernel_name = 'hybrid_moba_retention_block'


def rmsnorm(x, g):
    xf = x.astype(jnp.float32)
    y = xf * lax.rsqrt(jnp.mean(xf * xf, axis=-1, keepdims=True) + EPS)
    return (y * g.astype(jnp.float32)).astype(x.dtype)


def t5_bucket(rel):
    n = jnp.maximum(rel, 0)
    max_exact = REL_BUCKETS // 2
    n_f = jnp.maximum(n, 1).astype(jnp.float32)
    large = max_exact + (jnp.log(n_f / max_exact) / math.log(REL_MAX_DIST / max_exact)
                         * (REL_BUCKETS - max_exact)).astype(jnp.int32)
    large = jnp.minimum(large, REL_BUCKETS - 1)
    return jnp.where(n < max_exact, n, large)


def moba_attention(q, k, v, rel_bias):
    B, H, S, D = q.shape
    nb = S // MOBA_BLOCK
    n_sel = min(MOBA_TOPK, nb)
    scale = D ** -0.5
    kb = k.reshape(B, H, nb, MOBA_BLOCK, D)
    vb = v.reshape(B, H, nb, MOBA_BLOCK, D)
    k_mean = jnp.mean(kb.astype(jnp.float32), axis=3).astype(k.dtype)
    bias_t = rel_bias.T.astype(jnp.float32)
    head_ix = jnp.arange(H)[None, :, None, None, None]
    blk_pos = jnp.arange(MOBA_BLOCK, dtype=jnp.int32)
    gather = jax.vmap(jax.vmap(lambda blocks, ix: blocks[ix]))

    def one_query_block(i):
        q0 = i * Q_BLOCK
        qi = lax.dynamic_slice_in_dim(q, q0, Q_BLOCK, axis=2)
        t = q0 + jnp.arange(Q_BLOCK, dtype=jnp.int32)
        c = q0 // MOBA_BLOCK
        gate = jnp.einsum('bhqd,bhnd->bhqn', qi, k_mean).astype(jnp.float32)
        gate = jnp.where(jnp.arange(nb) < c, gate, -jnp.inf)
        _, idx = lax.top_k(gate, n_sel)
        valid = idx < c
        k_sel = gather(kb, idx)
        v_sel = gather(vb, idx)
        s_sel = jnp.einsum('bhqd,bhqnkd->bhqnk', qi, k_sel).astype(jnp.float32) * scale
        pos_sel = idx[..., None] * MOBA_BLOCK + blk_pos
        bias_sel = bias_t[head_ix, t5_bucket(t[:, None, None] - pos_sel)]
        s_sel = jnp.where(valid[..., None], s_sel + bias_sel, NEG)
        k_own = lax.dynamic_slice_in_dim(k, c * MOBA_BLOCK, MOBA_BLOCK, axis=2)
        v_own = lax.dynamic_slice_in_dim(v, c * MOBA_BLOCK, MOBA_BLOCK, axis=2)
        rel_own = t[:, None] - (c * MOBA_BLOCK + blk_pos)[None, :]
        s_own = jnp.einsum('bhqd,bhkd->bhqk', qi, k_own).astype(jnp.float32) * scale
        bias_own = bias_t[:, t5_bucket(rel_own)]
        s_own = jnp.where(rel_own >= 0, s_own + bias_own, NEG)
        logits = jnp.concatenate(
            [s_sel.reshape(B, H, Q_BLOCK, n_sel * MOBA_BLOCK), s_own], axis=-1)
        p = jax.nn.softmax(logits, axis=-1).astype(v.dtype)
        p_sel = p[..., :n_sel * MOBA_BLOCK].reshape(B, H, Q_BLOCK, n_sel, MOBA_BLOCK)
        p_own = p[..., n_sel * MOBA_BLOCK:]
        return (jnp.einsum('bhqnk,bhqnkd->bhqd', p_sel, v_sel)
                + jnp.einsum('bhqk,bhkd->bhqd', p_own, v_own))

    outs = lax.map(one_query_block, jnp.arange(S // Q_BLOCK, dtype=jnp.int32))
    return outs.transpose(1, 2, 0, 3, 4).reshape(B, H, S, D)


def rotary(x):
    S, D = x.shape[2], x.shape[3]
    inv = ROPE_BASE ** (-jnp.arange(0, D, 2, dtype=jnp.float32) / D)
    ang = jnp.arange(S, dtype=jnp.float32)[:, None] * inv[None, :]
    cos, sin = jnp.cos(ang), jnp.sin(ang)
    x1, x2 = x[..., :D // 2], x[..., D // 2:]
    return jnp.concatenate([x1 * cos - x2 * sin, x1 * sin + x2 * cos], axis=-1)


def retention(q, k, v, g):
    B, H, S, D = q.shape
    C = RET_CHUNK
    NC = S // C
    qf = rotary(q.astype(jnp.float32))
    kf = rotary(k.astype(jnp.float32)) * (D ** -0.5)
    vf = v.astype(jnp.float32)
    log_gamma = jnp.log(1.0 - 2.0 ** (-5.0 - jnp.arange(H, dtype=jnp.float32)))
    n = jnp.arange(C, dtype=jnp.float32)
    rel = n[:, None] - n[None, :]
    decay_mask = jnp.where(rel >= 0, jnp.exp(jnp.maximum(rel, 0.0)[None] * log_gamma[:, None, None]), 0.0)
    qc = qf.reshape(B, H, NC, C, D)
    kc = kf.reshape(B, H, NC, C, D)
    vc = vf.reshape(B, H, NC, C, D)
    scores = jnp.einsum('bhcnd,bhcmd->bhcnm', qc, kc) * decay_mask[None, :, None]
    y_inner = jnp.einsum('bhcnm,bhcme->bhcne', scores, vc)
    decay_end = jnp.exp((C - 1.0 - n)[None, :] * log_gamma[:, None])
    kv = jnp.einsum('bhcmd,bhcme->bhcde', kc * decay_end[None, :, None, :, None], vc)
    chunk_decay = jnp.exp(C * log_gamma)[None, :, None, None]

    def step(state, kv_c):
        return state * chunk_decay + kv_c, state

    _, r_prev = lax.scan(step, jnp.zeros((B, H, D, D), jnp.float32), jnp.moveaxis(kv, 2, 0))
    r_prev = jnp.moveaxis(r_prev, 0, 2)
    decay_start = jnp.exp((n + 1.0)[None, :] * log_gamma[:, None])
    y_cross = jnp.einsum('bhcnd,bhcde->bhcne', qc, r_prev) * decay_start[None, :, None, :, None]
    y = (y_inner + y_cross).reshape(B, H, S, D)
    mu = jnp.mean(y, axis=-1, keepdims=True)
    var = jnp.mean(jnp.square(y - mu), axis=-1, keepdims=True)
    y = (y - mu) * lax.rsqrt(var + EPS)
    y = y.transpose(0, 2, 1, 3).reshape(B, S, H * D)
    return (jax.nn.silu(g.astype(jnp.float32)) * y).astype(q.dtype)


def setup_inputs(seed: int = 0) -> dict:
    key = jax.random.key(seed)
    ks = jax.random.split(key, 12)
    L = DEPTH

    def nrm(k, shape, scale):
        return jax.random.normal(k, shape, jnp.float32) * scale

    return {
        'x': nrm(ks[0], (BATCH, SEQ, D_MODEL), 1.0),
        'norm_mix_pre': 1.0 + nrm(ks[1], (L, D_MODEL), 0.05),
        'w_in': nrm(ks[2], (L, D_MODEL, N_PROJ), D_MODEL ** -0.5),
        'rel_bias': nrm(ks[3], (REL_BUCKETS, N_HEADS_MOBA), 0.5),
        'w_out': nrm(ks[4], (L, D_MIX, D_MODEL), D_MIX ** -0.5),
        'norm_mix_post': 1.0 + nrm(ks[5], (L, D_MODEL), 0.05),
        'norm_ffn_pre': 1.0 + nrm(ks[6], (L, D_MODEL), 0.05),
        'w_up': nrm(ks[7], (L, D_MODEL, 2 * D_FF), D_MODEL ** -0.5),
        'conv_w': nrm(ks[8], (L, CONV_WIDTH, 2 * D_FF), CONV_WIDTH ** -0.5),
        'conv_b': nrm(ks[9], (L, 2 * D_FF), 0.02),
        'w_down': nrm(ks[10], (L, D_FF, D_MODEL), D_FF ** -0.5),
        'norm_ffn_post': 1.0 + nrm(ks[11], (L, D_MODEL), 0.05),
    }


def reference(x, norm_mix_pre, w_in, rel_bias, w_out, norm_mix_post,
              norm_ffn_pre, w_up, conv_w, conv_b, w_down, norm_ffn_post):
    B, S, _ = x.shape
    S_pad = -(-S // MOBA_BLOCK) * MOBA_BLOCK

    def heads(t, n_heads):
        return t.reshape(B, S_pad, n_heads, HEAD_DIM).transpose(0, 2, 1, 3)

    for l in range(DEPTH):
        h = rmsnorm(x, norm_mix_pre[l])
        proj = jnp.einsum('bsd,dn->bsn', h, w_in[l])
        proj = jnp.pad(proj, ((0, 0), (0, S_pad - S), (0, 0)))
        qa, ka, va, qr, kr, vr, gr = jnp.split(
            proj, np.cumsum([D_MOBA, D_MOBA, D_MOBA, D_RET, D_RET, D_RET])[:].tolist(), axis=-1)
        ya = moba_attention(heads(qa, N_HEADS_MOBA), heads(ka, N_HEADS_MOBA),
                            heads(va, N_HEADS_MOBA), rel_bias)
        ya = ya.transpose(0, 2, 1, 3).reshape(B, S_pad, D_MOBA)
        yr = retention(heads(qr, N_HEADS_RET), heads(kr, N_HEADS_RET),
                       heads(vr, N_HEADS_RET), gr)
        y = jnp.concatenate([ya, yr], axis=-1)[:, :S]
        y = jnp.einsum('bsn,nd->bsd', y, w_out[l])
        x = x + rmsnorm(y, norm_mix_post[l])
        h = rmsnorm(x, norm_ffn_pre[l])
        u = jnp.einsum('bsd,df->bsf', h, w_up[l])
        up = jnp.pad(u, ((0, 0), (CONV_WIDTH - 1, 0), (0, 0)))
        u = conv_b[l] + sum(conv_w[l, j] * up[:, j:j + S] for j in range(CONV_WIDTH))
        a, b = jnp.split(u, 2, axis=-1)
        f = jax.nn.gelu(a, approximate=True) * b
        y = jnp.einsum('bsf,fd->bsd', f, w_down[l])
        x = x + rmsnorm(y, norm_ffn_post[l])
    return x
```

```cpp
#include <hip/hip_runtime.h>
#include <hip/hip_cooperative_groups.h>
#include <cstdio>
#include <cstdint>
namespace pg8 {
#define PG8_LAS __attribute__((address_space(3)))
typedef unsigned short bf16_t;
typedef short bf16x8 __attribute__((ext_vector_type(8)));
typedef float f32x4 __attribute__((ext_vector_type(4)));
typedef unsigned u32x4 __attribute__((ext_vector_type(4)));
constexpr int BM = 256, BK = 64, HALF = 128, HTB = HALF * BK * 2  , STAGE_BYTES = 8 * HTB, NXCD = 8, WGM = 8;

__host__ __device__ __forceinline__ int lds_byte(int r, int c) { const int st = (r >> 4) * 2 + (c >> 5), rr = r & 15, cc = c & 31, ob = rr * 64 + cc * 2; return st * 1024 + (ob ^ (((ob >> 9) & 1) << 5)); }
__host__ __device__ __forceinline__ void stage_rc(int b, int& R, int& C) { const int st = b / 1024, sb = b % 1024, swz = sb ^ (((sb >> 9) & 1) << 5); R = (st >> 1) * 16 + swz / 64; C = (st & 1) * 32 + (swz % 64) / 2; }
__host__ __device__ __forceinline__ int perm32(int rho) { const int n = rho >> 4, i = rho & 15; return 8 * (i >> 2) + 4 * n + (i & 3); }

struct Unit { int pm, pn; };
struct Gemm { const bf16_t* A; const bf16_t* Bt; int M, N, K; };

struct StaticOrder {
    int nM, nN, nwg, G, c;
    __host__ __device__ void init(int M, int N, int G_, int c_) { nM = M / BM; nN = N / BM; nwg = nM * nN; G = G_; c = c_; }
    __host__ __device__ bool next(int i, Unit& u) const {
        const long L = (long)i * G + c; if (L >= nwg) return false;
        int wgid = (int)L; { const int q = nwg / NXCD, r = nwg % NXCD, xcd = wgid % NXCD, off = wgid / NXCD; wgid = (xcd < r ? xcd * (q + 1) : r * (q + 1) + (xcd - r) * q) + off; }
        const int nig = WGM * nN, gid = wgid / nig, fm = gid * WGM, gsz = (nM - fm) < WGM ? (nM - fm) : WGM;
        u.pm = fm + ((wgid % nig) % gsz); u.pn = (wgid % nig) / gsz; return true;
    }
    __device__ __forceinline__ void a_ready(const Unit&) const {}
    __device__ __forceinline__ void done(const Unit&) const {}
};

__device__ __forceinline__ unsigned cvt_pk_bf16(float lo, float hi) { unsigned r; asm volatile("v_cvt_pk_bf16_f32 %0, %1, %2" : "=v"(r) : "v"(lo), "v"(hi)); return r; }
typedef float f32x2 __attribute__((ext_vector_type(2)));
__device__ __forceinline__ f32x2 gelu_pk(f32x2 v) {
    const f32x2 av = __builtin_elementwise_abs(v), d = av * 0.2316418882f + 1.0f;
    f32x2 t; t.x = __builtin_amdgcn_rcpf(d.x); t.y = __builtin_amdgcn_rcpf(d.y);
    f32x2 q = t * 0.5307027145f + (-0.7265760135f); q = q * t + 0.7107068705f; q = q * t + (-0.142248368f); q = q * t + 0.127414796f; q = q * t;
    const f32x2 s = (v * v) * (-0.72134752044f);
    f32x2 e; e.x = __builtin_amdgcn_exp2f(s.x); e.y = __builtin_amdgcn_exp2f(s.y);
    const f32x2 m = v * (q * e), r = v - m;
    f32x2 o; o.x = v.x < 0.f ? m.x : r.x; o.y = v.y < 0.f ? m.y : r.y; return o;
}

template <int ACT  > struct EpiBf16 {
    static constexpr bool PERM = true, AFTER_DRAIN = false; static_assert(ACT == 0 || ACT == 1, "EpiBf16: ACT is 0 (none) or 1 (gelu_pk)");
    bf16_t* O; int ldc; const float* bias; int split_cols; size_t split_stride; float scale0;
    __device__ __forceinline__ void operator()(const f32x4 (&acc)[2][2][4][2], const Unit& u, int wr, int wc, int fr, int fq) const {
        const int row0 = u.pm * BM + wr * 64 + fr; int colt = u.pn * BM; bf16_t* base = O;
        float sc = 1.f; if (split_cols) { const int t = colt / split_cols; base += (size_t)t * split_stride; colt -= t * split_cols; if (t == 0) sc = scale0; }
        const int col0 = colt + wc * 32 + 8 * fq, bcol0 = u.pn * BM + wc * 32 + 8 * fq;
        f32x4 bv[2][2];
#pragma unroll
        for (int bj = 0; bj < 2; ++bj)
#pragma unroll
            for (int n = 0; n < 2; ++n) bv[bj][n] = bias ? *(const f32x4*)(bias + bcol0 + bj * HALF + 4 * n) : (f32x4){0.f, 0.f, 0.f, 0.f};
#pragma unroll
        for (int ai = 0; ai < 2; ++ai)
#pragma unroll
            for (int m = 0; m < 4; ++m) { bf16_t* rowp = base + (size_t)(row0 + ai * HALF + m * 16) * ldc + col0;
#pragma unroll
                for (int bj = 0; bj < 2; ++bj) { f32x4 v0 = acc[ai][bj][m][0] + bv[bj][0], v1 = acc[ai][bj][m][1] + bv[bj][1];
                    if (ACT == 1) { f32x2 a = gelu_pk((f32x2){v0[0], v0[1]}), b = gelu_pk((f32x2){v0[2], v0[3]}), c = gelu_pk((f32x2){v1[0], v1[1]}), d = gelu_pk((f32x2){v1[2], v1[3]});
                        v0 = (f32x4){a.x, a.y, b.x, b.y}; v1 = (f32x4){c.x, c.y, d.x, d.y}; }
                    v0 = v0 * sc; v1 = v1 * sc; u32x4 w; w.x = cvt_pk_bf16(v0[0], v0[1]); w.y = cvt_pk_bf16(v0[2], v0[3]); w.z = cvt_pk_bf16(v1[0], v1[1]); w.w = cvt_pk_bf16(v1[2], v1[3]);
                    *(u32x4*)(rowp + bj * HALF) = w; } }
    }
};
template <class Epi, class Sched, bool ALIGN_EPI = false, bool SP2 = false>
__device__ __forceinline__ void gemm_phase(PG8_LAS unsigned char* lds, const Gemm g, const Sched& S, const Epi& E) {
    const int tid = threadIdx.x, wid = __builtin_amdgcn_readfirstlane(tid >> 6), lane = tid & 63, wr = wid >> 2, wc = wid & 3, fr = lane & 15, fq = lane >> 4;
    const int K = g.K, nt = K / BK;
    unsigned voffA[2], voffB[2];
#pragma unroll
    for (int i = 0; i < 2; ++i) { int R, C; stage_rc(tid * 16 + i * 8192, R, C); const int Rb = Epi::PERM ? ((R & ~31) + perm32(R & 31)) : R;
        voffA[i] = (unsigned)(R * K + C) * 2u; voffB[i] = (unsigned)(Rb * K + C) * 2u; }
    const size_t kstep = (size_t)(BK * 2);
    const size_t hstep = (size_t)HALF * K * 2;
    const size_t tstep = 2 * hstep;
    const unsigned ldsw = (unsigned)wid * 1024u;
    const int aoff = lds_byte(wr * 64 + fr, fq * 8), boff = lds_byte(wc * 32 + fr, fq * 8);
#define PG8_SA(b, h) (((b) * 2 + (h)) * HTB)
#define PG8_SB(b, h) ((4 + (b) * 2 + (h)) * HTB)
#define PG8_STAGE(bufoff, gbase, voff) do { _Pragma("unroll") for (int _i = 0; _i < 2; ++_i) \
        __builtin_amdgcn_global_load_lds((const unsigned*)((const char*)(gbase) + (voff)[_i]), (PG8_LAS unsigned*)(lds + (bufoff) + ldsw + _i * 8192), 16, 0, 0); } while (0)
#define PG8_LDA(dst, b, h) do { _Pragma("unroll") for (int m = 0; m < 4; ++m) _Pragma("unroll") for (int k = 0; k < 2; ++k) dst[m][k] = *(const PG8_LAS bf16x8*)(lds + PG8_SA(b, h) + aoff + m * 2048 + k * 1024); } while (0)
#define PG8_LDB(dst, b, h) do { _Pragma("unroll") for (int n = 0; n < 2; ++n) _Pragma("unroll") for (int k = 0; k < 2; ++k) dst[n][k] = *(const PG8_LAS bf16x8*)(lds + PG8_SB(b, h) + boff + n * 2048 + k * 1024); } while (0)
#define PG8_MMA(ai, bj, At, Bt) do { __builtin_amdgcn_s_setprio(1); _Pragma("unroll") for (int m = 0; m < 4; ++m) _Pragma("unroll") for (int n = 0; n < 2; ++n) _Pragma("unroll") for (int k = 0; k < 2; ++k) \
        acc[ai][bj][m][n] = __builtin_amdgcn_mfma_f32_16x16x32_bf16(Bt[n][k], At[m][k], acc[ai][bj][m][n], 0, 0, 0); __builtin_amdgcn_s_setprio(0); } while (0)
#define PG8_WAIT_V(n) asm volatile("s_waitcnt vmcnt(" #n ")" ::: "memory")
#define PG8_WAIT_L(n) asm volatile("s_waitcnt lgkmcnt(" #n ")" ::: "memory")
#define PG8_BAR __builtin_amdgcn_s_barrier()
#define PG8_SCHED __builtin_amdgcn_sched_barrier(0)
    Unit cur, nxt; int ui = 0;
    if (!S.next(0, cur)) return;
    f32x4 acc[2][2][4][2];
#pragma unroll
    for (int a = 0; a < 2; ++a)
#pragma unroll
        for (int b = 0; b < 2; ++b)
#pragma unroll
            for (int m = 0; m < 4; ++m)
#pragma unroll
                for (int n = 0; n < 2; ++n) acc[a][b][m][n] = (f32x4){0.f, 0.f, 0.f, 0.f};
    bf16x8 At[4][2], B0[2][2], B1[2][2];
    const char* cA = (const char*)g.A + (size_t)cur.pm * tstep; const char* cB = (const char*)g.Bt + (size_t)cur.pn * tstep;
    S.a_ready(cur);
    if constexpr (SP2) {
        PG8_STAGE(PG8_SB(0, 0), cB, voffB); PG8_STAGE(PG8_SB(0, 1), cB + hstep, voffB); PG8_STAGE(PG8_SA(0, 0), cA, voffA); PG8_STAGE(PG8_SA(0, 1), cA + hstep, voffA);
        if (wr == 1) PG8_BAR;
        PG8_WAIT_V(2); PG8_BAR;
        PG8_STAGE(PG8_SB(1, 0), cB + kstep, voffB); PG8_STAGE(PG8_SA(1, 0), cA + kstep, voffA); PG8_STAGE(PG8_SB(1, 1), cB + hstep + kstep, voffB);
        PG8_WAIT_V(6); PG8_BAR;
    } else {
        PG8_STAGE(PG8_SB(0, 0), cB, voffB); PG8_STAGE(PG8_SA(0, 0), cA, voffA); PG8_STAGE(PG8_SB(0, 1), cB + hstep, voffB); PG8_STAGE(PG8_SA(0, 1), cA + hstep, voffA);
        if (wr == 1) PG8_BAR;
        PG8_WAIT_V(4); PG8_BAR;
        PG8_STAGE(PG8_SB(1, 0), cB + kstep, voffB); PG8_STAGE(PG8_SA(1, 0), cA + kstep, voffA); PG8_STAGE(PG8_SB(1, 1), cB + hstep + kstep, voffB);
        PG8_WAIT_V(6); PG8_BAR;
    }
    for (;;) {
        const bool has_next = S.next(ui + 1, nxt);
        const char* nA = has_next ? (const char*)g.A + (size_t)nxt.pm * tstep : cA; const char* nB = has_next ? (const char*)g.Bt + (size_t)nxt.pn * tstep : cB;
        for (int t = 0; t < nt; t += 2) {
            const bool last = (t == nt - 2);
            const char* a1 = cA + (size_t)(t + 1) * kstep;
            const char* a2 = last ? nA : cA + (size_t)(t + 2) * kstep; const char* b2 = last ? nB : cB + (size_t)(t + 2) * kstep;
            const char* a3 = a2 + kstep; const char* b3 = b2 + kstep;
            if (last && has_next) S.a_ready(nxt);
            if constexpr (SP2) {
            PG8_LDB(B0, 0, 0); PG8_LDB(B1, 0, 1); PG8_SCHED; PG8_LDA(At, 0, 0); PG8_STAGE(PG8_SA(1, 1), a1 + hstep, voffA);
            PG8_WAIT_V(8); PG8_WAIT_L(0); PG8_BAR; PG8_MMA(0, 0, At, B0); PG8_MMA(0, 1, At, B1); PG8_BAR; PG8_SCHED;
            PG8_LDA(At, 0, 1); PG8_STAGE(PG8_SB(0, 0), b2, voffB); PG8_STAGE(PG8_SB(0, 1), b2 + hstep, voffB); PG8_STAGE(PG8_SA(0, 0), a2, voffA);
            PG8_WAIT_V(8); PG8_WAIT_L(0); PG8_BAR; PG8_MMA(1, 0, At, B0); PG8_MMA(1, 1, At, B1); PG8_BAR; PG8_SCHED;
            PG8_LDB(B0, 1, 0); PG8_LDB(B1, 1, 1); PG8_SCHED; PG8_LDA(At, 1, 0); PG8_STAGE(PG8_SA(0, 1), a2 + hstep, voffA);
            PG8_WAIT_V(8); PG8_WAIT_L(0); PG8_BAR; PG8_MMA(0, 0, At, B0); PG8_MMA(0, 1, At, B1); PG8_BAR; PG8_SCHED;
            PG8_LDA(At, 1, 1); PG8_STAGE(PG8_SB(1, 0), b3, voffB); PG8_STAGE(PG8_SB(1, 1), b3 + hstep, voffB); PG8_STAGE(PG8_SA(1, 0), a3, voffA);
            PG8_WAIT_V(8); PG8_WAIT_L(0); PG8_BAR; PG8_MMA(1, 0, At, B0); PG8_MMA(1, 1, At, B1); PG8_BAR; PG8_SCHED;
            } else {
            PG8_LDB(B0, 0, 0); PG8_SCHED; PG8_LDA(At, 0, 0); PG8_STAGE(PG8_SA(1, 1), a1 + hstep, voffA);
            PG8_WAIT_L(8); PG8_BAR; PG8_WAIT_L(0); PG8_MMA(0, 0, At, B0); PG8_BAR; PG8_SCHED;
            PG8_LDB(B1, 0, 1); PG8_STAGE(PG8_SB(0, 0), b2, voffB);
            PG8_BAR; PG8_WAIT_L(0); PG8_MMA(0, 1, At, B1); PG8_BAR;
            PG8_LDA(At, 0, 1); PG8_STAGE(PG8_SA(0, 0), a2, voffA);
            PG8_BAR; PG8_WAIT_L(0); PG8_MMA(1, 0, At, B0); PG8_BAR; PG8_SCHED;
            PG8_STAGE(PG8_SB(0, 1), b2 + hstep, voffB);
            PG8_WAIT_V(6); PG8_BAR; PG8_MMA(1, 1, At, B1); PG8_BAR;
            PG8_LDB(B0, 1, 0); PG8_SCHED; PG8_LDA(At, 1, 0); PG8_STAGE(PG8_SA(0, 1), a2 + hstep, voffA);
            PG8_WAIT_L(8); PG8_BAR; PG8_WAIT_L(0); PG8_MMA(0, 0, At, B0); PG8_BAR; PG8_SCHED;
            PG8_LDB(B1, 1, 1); PG8_STAGE(PG8_SB(1, 0), b3, voffB);
            PG8_BAR; PG8_WAIT_L(0); PG8_MMA(0, 1, At, B1); PG8_BAR;
            PG8_LDA(At, 1, 1); PG8_STAGE(PG8_SA(1, 0), a3, voffA);
            PG8_BAR; PG8_WAIT_L(0); PG8_MMA(1, 0, At, B0); PG8_BAR; PG8_SCHED;
            PG8_STAGE(PG8_SB(1, 1), b3 + hstep, voffB);
            PG8_WAIT_V(6); PG8_BAR; PG8_MMA(1, 1, At, B1); PG8_BAR;
            }
        }
        if constexpr (ALIGN_EPI) { if (wr == 0) PG8_BAR; }
        if constexpr (!Epi::AFTER_DRAIN) { E(acc, cur, wr, wc, fr, fq); S.done(cur); }
        if (!has_next) break;
#pragma unroll
        for (int a = 0; a < 2; ++a)
#pragma unroll
            for (int b = 0; b < 2; ++b)
#pragma unroll
                for (int m = 0; m < 4; ++m)
#pragma unroll
                    for (int n = 0; n < 2; ++n) acc[a][b][m][n] = (f32x4){0.f, 0.f, 0.f, 0.f};
        cur = nxt; cA = nA; cB = nB; ++ui;
        if constexpr (ALIGN_EPI) { if (wr == 1) PG8_BAR; }
    }
    PG8_WAIT_V(0);
    if constexpr (!ALIGN_EPI) { if (wr == 0) PG8_BAR; }
    PG8_BAR;
    if constexpr (Epi::AFTER_DRAIN) { E.fused(acc, cur, wr, wc, fr, fq, lds, wid, lane); S.done(cur); }
#undef PG8_SA
#undef PG8_SB
#undef PG8_STAGE
#undef PG8_LDA
#undef PG8_LDB
#undef PG8_MMA
#undef PG8_WAIT_V
#undef PG8_WAIT_L
#undef PG8_BAR
#undef PG8_SCHED
}
}

#ifndef PG8_SP2
#define PG8_SP2 true
#endif
#ifndef PG8_ALIGN
#define PG8_ALIGN true
#endif
#define GAS __attribute__((address_space(1)))
#define LAS __attribute__((address_space(3)))
typedef unsigned short bf16;
typedef unsigned v4u __attribute__((ext_vector_type(4)));
typedef float f32x4 __attribute__((ext_vector_type(4)));
typedef short bf16x8 __attribute__((ext_vector_type(8)));
typedef GAS unsigned gu32;
typedef GAS unsigned long long gu64;
#define RLX_AGENT __ATOMIC_RELAXED, __HIP_MEMORY_SCOPE_AGENT
#define LDS_WAIT() asm volatile("s_waitcnt lgkmcnt(0)" ::: "memory")
#define VM_WAIT() asm volatile("s_waitcnt vmcnt(0)" ::: "memory")
__device__ __forceinline__ unsigned long long rt() { return __builtin_amdgcn_s_memrealtime(); }
__device__ __forceinline__ unsigned f2bf(float f) { unsigned u = __builtin_bit_cast(unsigned, f); return (u + 0x7fffu + ((u >> 16) & 1u)) >> 16; }
__device__ __forceinline__ unsigned pk2(float lo, float hi) { return f2bf(lo) | (f2bf(hi) << 16); }

#define XB_TMO      128
#define XB_XCNT(j)  (256  + 64 * (j))
#define XB_XSUB(j)  (1280 + 64 * (j))
#define XB_XGEN(j)  (2304 + 64 * (j))
#define XB_TOP      3328
#define XB_TOPGEN   3392
#define XCD_BAR_WORDS 3456
#define XB_SPIN_CAP (1u << 18)

__device__ __forceinline__ unsigned xb_ld(unsigned* p)              { return __hip_atomic_load(p, __ATOMIC_RELAXED, __HIP_MEMORY_SCOPE_AGENT); }
__device__ __forceinline__ unsigned xb_add(unsigned* p, unsigned v) { return __hip_atomic_fetch_add(p, v, __ATOMIC_RELAXED, __HIP_MEMORY_SCOPE_AGENT); }
__device__ __forceinline__ unsigned xb_xcc_id() { return (unsigned)__builtin_amdgcn_s_getreg((3 << 11) | 20) & 0xFu; }
#define XB_SPIN(cond, bar) do { unsigned _sp = 0; while (cond) { __builtin_amdgcn_s_sleep(1); \
    if ((++_sp & 255u) == 0u) { if (xb_ld(&(bar)[XB_TMO])) break; if (_sp > XB_SPIN_CAP) { atomicAdd(&(bar)[XB_TMO], 1u); break; } } } } while (0)

struct XcdBarrier {
    unsigned* bar; unsigned x;
    volatile LAS unsigned* st;
};

__device__ __forceinline__ XcdBarrier xcd_barrier_post(unsigned* bar, volatile LAS unsigned* st) {
    XcdBarrier b; b.bar = bar; b.x = xb_xcc_id(); b.st = st;
    if (threadIdx.x == 0) (void)xb_add(&bar[XB_XCNT(b.x)], 1u);
    return b;
}
__device__ __forceinline__ void xcd_barrier_complete(unsigned* bar, unsigned x, unsigned& nloc, unsigned& nx) {
    const unsigned G = gridDim.x * gridDim.y * gridDim.z;
    unsigned sum, cnt, mine, sp = 0u;
    for (;;) {
        sum = 0u; cnt = 0u; mine = 0u;
#pragma unroll
        for (unsigned j = 0; j < 16; ++j) { const unsigned c = xb_ld(&bar[XB_XCNT(j)]); sum += c; cnt += (c > 0u) ? 1u : 0u; mine = (j == x) ? c : mine; }
        if (sum == G) break;
        __builtin_amdgcn_s_sleep(1);
        if ((++sp & 255u) == 0u) { if (xb_ld(&bar[XB_TMO])) break; if (sp > XB_SPIN_CAP) { atomicAdd(&bar[XB_TMO], 1u); break; } }
    }
    nloc = mine > 0u ? mine : 1u; nx = cnt > 0u ? cnt : 1u;
}

__device__ __forceinline__ void xcd_barrier(const XcdBarrier& b) {
    asm volatile("s_waitcnt vmcnt(0)" ::: "memory");
    __syncthreads();
    if (threadIdx.x == 0) {
        unsigned* bar = b.bar;
        __builtin_amdgcn_s_waitcnt(0);
        unsigned nloc = b.st[0], nx = b.st[1];
        if (nloc == 0u) { xcd_barrier_complete(bar, b.x, nloc, nx); b.st[0] = nloc; b.st[1] = nx; }
        const unsigned old = xb_add(&bar[XB_XSUB(b.x)], 1u);
        const unsigned gen = old / nloc;
        if (old + 1u == (gen + 1u) * nloc) {
            __builtin_amdgcn_fence(__ATOMIC_RELEASE, "agent");
            asm volatile("s_waitcnt vmcnt(0)" ::: "memory");
            const unsigned og = xb_add(&bar[XB_TOP], 1u);
            const unsigned tg = og / nx;
            if (og + 1u == (tg + 1u) * nx) xb_add(&bar[XB_TOPGEN], 1u);
            else XB_SPIN(xb_ld(&bar[XB_TOPGEN]) == tg, bar);
            __builtin_amdgcn_fence(__ATOMIC_ACQUIRE, "agent");
            xb_add(&bar[XB_XGEN(b.x)], 1u);
            asm volatile("s_waitcnt vmcnt(0)" ::: "memory");
        } else {
            XB_SPIN(xb_ld(&bar[XB_XGEN(b.x)]) == gen, bar);
            __builtin_amdgcn_fence(__ATOMIC_ACQUIRE, "agent");
            asm volatile("s_waitcnt vmcnt(0)" ::: "memory");
        }
    }
    __syncthreads();
}

constexpr int BATCH = 2, SEQ = 16384, DM = 1024, TT = BATCH * SEQ, NPROJ = 3584, DFF = 2816, NUP = 2 * DFF, NPANEL = TT / 256;
constexpr int NH = 8, HD = 64, HW = 512;
constexpr float EPS = 1e-6f;
#ifndef MK_ONE_LAUNCH
#define MK_ONE_LAUNCH 0
#endif

constexpr size_t MiB = 1u << 20;
constexpr size_t WS_CTL = 0, CTL_ZERO_BYTES = 1 * MiB;
constexpr size_t WS_WIN = 1 * MiB, WS_WOUT = 8 * MiB, WS_WUP = 10 * MiB, WS_WDN = 21 * MiB;
constexpr size_t WS_CS = 27 * MiB;
constexpr size_t WS_SMALL = 31 * MiB;
constexpr size_t SM_BIASD = 0, SM_DPOS = 8192, SM_DNEG = 16384, SM_GAM = 24576, SM_G256 = 24576 + 64;
constexpr size_t WS_KMS = 32 * MiB;
constexpr size_t WS_ROWSS = 33 * MiB;
constexpr size_t WS_SEL = 35 * MiB;
constexpr size_t WS_KV = 40 * MiB, WS_RP = 56 * MiB;
constexpr size_t WS_XN = 72 * MiB;
constexpr size_t WS_PROJ = 136 * MiB;
constexpr size_t PROJ_SEG = (size_t)TT * 512 * 2;
constexpr size_t WS_Y = 360 * MiB;
constexpr size_t WS_Y1 = 136 * MiB;
constexpr size_t WS_U = 136 * MiB;
constexpr size_t WS_F = 312 * MiB;
constexpr size_t WS_END = 496 * MiB;
constexpr int CW_BAR = 4096;

typedef unsigned u32x4v __attribute__((ext_vector_type(4)));
typedef unsigned u32x2v __attribute__((ext_vector_type(2)));

__device__ __forceinline__ float bflo(unsigned w) { return __uint_as_float(w << 16); }
__device__ __forceinline__ float bfhi(unsigned w) { return __uint_as_float(w & 0xffff0000u); }
__device__ __forceinline__ float bf1(bf16 b) { return __uint_as_float((unsigned)b << 16); }

namespace pg8 {
struct EpiProj {
    static constexpr bool PERM = true, AFTER_DRAIN = false;
    bf16_t* proj; const float* cs; const float* dpos; const float* dneg; float* kms;
    __device__ __forceinline__ void operator()(const f32x4 (&acc)[2][2][4][2], const Unit& u, int wr, int wc, int fr, int fq) const {
        const int seg = u.pn >> 1, cb = (u.pn & 1) * 256;
        bf16_t* base = proj + (size_t)seg * ((size_t)TT * 512);
        const int row0 = u.pm * BM + wr * 64 + fr, colw = cb + wc * 32 + 8 * fq;
        if (seg == 3 || seg == 4) {
            const int i0 = 16 * (wc & 1) + 4 * fq;
#pragma unroll
            for (int ai = 0; ai < 2; ++ai)
#pragma unroll
                for (int m = 0; m < 4; ++m) {
                    const int row = row0 + ai * HALF + m * 16, t = row & (SEQ - 1), tl = t & 255;
                    const f32x4 c01 = *(const f32x4*)(cs + ((size_t)t * 32 + i0) * 2), c23 = *(const f32x4*)(cs + ((size_t)t * 32 + i0) * 2 + 4);
                    bf16_t* rowp = base + (size_t)row * 512 + colw;
#pragma unroll
                    for (int bj = 0; bj < 2; ++bj) {
                        const int head = (cb >> 6) + bj * 2 + (wc >> 1);
                        const float ds = (seg == 3) ? dpos[head * 256 + tl] : 0.125f * dneg[head * 256 + tl];
                        const f32x4 v0 = acc[ai][bj][m][0], v1 = acc[ai][bj][m][1];
                        u32x4 w;
                        w.x = cvt_pk_bf16((v0[0] * c01[0] - v0[1] * c01[1]) * ds, (v0[0] * c01[1] + v0[1] * c01[0]) * ds);
                        w.y = cvt_pk_bf16((v0[2] * c01[2] - v0[3] * c01[3]) * ds, (v0[2] * c01[3] + v0[3] * c01[2]) * ds);
                        w.z = cvt_pk_bf16((v1[0] * c23[0] - v1[1] * c23[1]) * ds, (v1[0] * c23[1] + v1[1] * c23[0]) * ds);
                        w.w = cvt_pk_bf16((v1[2] * c23[2] - v1[3] * c23[3]) * ds, (v1[2] * c23[3] + v1[3] * c23[2]) * ds);
                        *(u32x4*)(rowp + bj * HALF) = w;
                    }
                }
        } else {
            const float sc = (seg == 0) ? 0.125f : 1.0f;
#pragma unroll
            for (int ai = 0; ai < 2; ++ai)
#pragma unroll
                for (int m = 0; m < 4; ++m) {
                    bf16_t* rowp = base + (size_t)(row0 + ai * HALF + m * 16) * 512 + colw;
#pragma unroll
                    for (int bj = 0; bj < 2; ++bj) {
                        const f32x4 v0 = acc[ai][bj][m][0] * sc, v1 = acc[ai][bj][m][1] * sc;
                        u32x4 w; w.x = cvt_pk_bf16(v0[0], v0[1]); w.y = cvt_pk_bf16(v0[2], v0[3]); w.z = cvt_pk_bf16(v1[0], v1[1]); w.w = cvt_pk_bf16(v1[2], v1[3]);
                        *(u32x4*)(rowp + bj * HALF) = w;
                    }
                }
            if (seg == 1) {
#pragma unroll
                for (int bj = 0; bj < 2; ++bj)
#pragma unroll
                    for (int n = 0; n < 2; ++n) {
                        f32x4 s = acc[0][bj][0][n];
#pragma unroll
                        for (int m = 1; m < 4; ++m) s += acc[0][bj][m][n];
#pragma unroll
                        for (int m = 0; m < 4; ++m) s += acc[1][bj][m][n];
#pragma unroll
                        for (int o = 1; o < 16; o <<= 1) { s[0] += __shfl_xor(s[0], o); s[1] += __shfl_xor(s[1], o); s[2] += __shfl_xor(s[2], o); s[3] += __shfl_xor(s[3], o); }
                        if (fr == 0) *(f32x4*)(kms + ((size_t)wr * NPANEL + u.pm) * 512 + colw + bj * HALF + 4 * n) = s;
                    }
            }
        }
    }
};
struct EpiY {
    static constexpr bool PERM = true, AFTER_DRAIN = false;
    bf16_t* Y; float* rowss;
    __device__ __forceinline__ void operator()(const f32x4 (&acc)[2][2][4][2], const Unit& u, int wr, int wc, int fr, int fq) const {
        const int row0 = u.pm * BM + wr * 64 + fr, colw = u.pn * BM + wc * 32 + 8 * fq;
#pragma unroll
        for (int ai = 0; ai < 2; ++ai)
#pragma unroll
            for (int m = 0; m < 4; ++m) {
                const int row = row0 + ai * HALF + m * 16;
                bf16_t* rowp = Y + (size_t)row * 1024 + colw; float ss = 0.f;
#pragma unroll
                for (int bj = 0; bj < 2; ++bj) {
                    const f32x4 v0 = acc[ai][bj][m][0], v1 = acc[ai][bj][m][1];
                    ss += (v0[0] * v0[0] + v0[1] * v0[1]) + (v0[2] * v0[2] + v0[3] * v0[3]) + (v1[0] * v1[0] + v1[1] * v1[1]) + (v1[2] * v1[2] + v1[3] * v1[3]);
                    u32x4 w; w.x = cvt_pk_bf16(v0[0], v0[1]); w.y = cvt_pk_bf16(v0[2], v0[3]); w.z = cvt_pk_bf16(v1[0], v1[1]); w.w = cvt_pk_bf16(v1[2], v1[3]);
                    *(u32x4*)(rowp + bj * HALF) = w;
                }
                ss += __shfl_xor(ss, 16); ss += __shfl_xor(ss, 32);
                if (fq == 0) rowss[(size_t)row * 16 + u.pn * 4 + wc] = ss;
            }
    }
};
}

constexpr int RING_OFF = 0, RING_BYTES = 131072;
constexpr int LDSCTL_OFF = RING_BYTES, MISC_OFF = LDSCTL_OFF + 320;
constexpr int LDS_BYTES = 147456;
constexpr int NWAVES = 8;

struct Frame {
    LAS unsigned char* lds; volatile LAS unsigned* MISC; gu32* ctl;
    int tid, lane, wave, vcu, G;
    const float *x, *g_mix_pre, *w_in, *rel_bias, *w_out, *g_mix_post, *g_ffn_pre, *w_up, *conv_w, *conv_b, *w_down, *g_ffn_post;
    float* out;
    bf16 *Win_t, *Wout_t, *Wup_t, *Wdn_t, *XN, *PROJ, *Y, *Y1, *U, *Fb;
    float *cs, *biasd, *dpos, *dneg, *gam, *g256, *kms, *rowss, *KV, *RP;
    unsigned* sel;
};

__device__ __forceinline__ float wave_sum(float v) {
#pragma unroll
    for (int o = 1; o < 64; o <<= 1) v += __shfl_xor(v, o);
    return v;
}

template <int MODE> __device__ __forceinline__ int src_col(int n) {
    if (MODE == 1) { const int seg = n >> 9; if (seg == 3 || seg == 4) { const int p = n & 63; return (n & ~63) + (p >> 1) + 32 * (p & 1); } }
    return n;
}
template <int MODE> __device__ __forceinline__ void p0_transpose_item(const float* W, const float* gain, int K, int N, bf16* WT, LAS float* scr, int item, int lane) {
    const int nblk = N / 32, kb = item / nblk, nb = item % nblk, k0 = 64 * kb, n0 = 32 * nb;
    const int sc = src_col<MODE>(n0 + (lane & 31));
#pragma unroll 8
    for (int i = 0; i < 32; ++i) { const int kk = 2 * i + (lane >> 5); const float g = gain ? gain[k0 + kk] : 1.0f; scr[kk * 33 + (lane & 31)] = W[(size_t)(k0 + kk) * N + sc] * g; }
    LDS_WAIT(); asm volatile("" ::: "memory");
    const int c = lane & 7;
#pragma unroll
    for (int j = 0; j < 4; ++j) { const int n = (lane >> 3) + 8 * j; const LAS float* s = scr + (8 * c) * 33 + n;
        v4u o; o.x = pk2(s[0 * 33], s[1 * 33]); o.y = pk2(s[2 * 33], s[3 * 33]); o.z = pk2(s[4 * 33], s[5 * 33]); o.w = pk2(s[6 * 33], s[7 * 33]);
        *(GAS v4u*)(WT + (size_t)(n0 + n) * K + k0 + 8 * c) = o; }
    LDS_WAIT(); asm volatile("" ::: "memory");
}
__device__ __forceinline__ int t5_bucket(int n) {
    if (n < 16) return n;
    int l = 16 + (int)(__logf((float)n * (1.0f / 16.0f)) / __logf(8.0f) * 16.0f);
    return l < 31 ? l : 31;
}
__device__ __forceinline__ void p0_prologue(Frame& F) {
    LAS float* scr = (LAS float*)(F.lds + RING_OFF + F.wave * 16384);
    const int gw = F.vcu * NWAVES + F.wave, NGW = F.G * NWAVES;
    constexpr int I_IN = (DM / 64) * (NPROJ / 32), I_OUT = (DM / 64) * (DM / 32), I_UP = (DM / 64) * (NUP / 32), I_DN = (DFF / 64) * (DM / 32);
    for (int it = gw; it < I_IN + I_OUT + I_UP + I_DN; it += NGW) {
        int r = it;
        if (r < I_IN) { p0_transpose_item<1>(F.w_in, F.g_mix_pre, DM, NPROJ, F.Win_t, scr, r, F.lane); continue; } r -= I_IN;
        if (r < I_OUT) { p0_transpose_item<0>(F.w_out, nullptr, DM, DM, F.Wout_t, scr, r, F.lane); continue; } r -= I_OUT;
        if (r < I_UP) { p0_transpose_item<0>(F.w_up, F.g_ffn_pre, DM, NUP, F.Wup_t, scr, r, F.lane); continue; } r -= I_UP;
        p0_transpose_item<0>(F.w_down, nullptr, DFF, DM, F.Wdn_t, scr, r, F.lane);
    }
    for (int m = gw; m < TT; m += NGW) {
        const GAS f32x4* xr = (const GAS f32x4*)(F.x + (size_t)m * DM) + F.lane;
        f32x4 v[4]; float s = 0.f;
#pragma unroll
        for (int j = 0; j < 4; ++j) { v[j] = xr[64 * j]; s += (v[j].x * v[j].x + v[j].y * v[j].y) + (v[j].z * v[j].z + v[j].w * v[j].w); }
        const float rstd = 1.0f / sqrtf(wave_sum(s) * (1.f / DM) + EPS);
        GAS unsigned long long* o8 = (GAS unsigned long long*)(F.XN + (size_t)m * DM) + F.lane;
#pragma unroll
        for (int j = 0; j < 4; ++j) o8[64 * j] = (unsigned long long)pk2(v[j].x * rstd, v[j].y * rstd) | ((unsigned long long)pk2(v[j].z * rstd, v[j].w * rstd) << 32);
    }
    const int gt = blockIdx.x * (NWAVES * 64) + F.tid, NT = F.G * NWAVES * 64;
    for (int i = gt; i < SEQ * 32; i += NT) {
        const int t = i >> 5, k = i & 31;
        double inv = 1.0; for (int q = 0; q < k; ++q) inv *= 0.74989420933245582730;
        const float ang = (float)t * (float)inv;
        const double rev = (double)ang * 0.15915494309189533577; const double fr = rev - __builtin_rint(rev);
        F.cs[2 * i] = __builtin_amdgcn_cosf((float)fr); F.cs[2 * i + 1] = __builtin_amdgcn_sinf((float)fr);
    }
    for (int i = gt; i < NH * 256; i += NT) {
        const int h = i >> 8, n = i & 255; const double g = 1.0 - 1.0 / (double)(32 << h);
        double p = 1.0; for (int q = 0; q < n; ++q) p *= g;
        F.dpos[i] = (float)p; F.dneg[i] = (float)(1.0 / p);
        if (n == 255) { F.gam[h] = (float)g; F.g256[h] = (float)(p * g); }
    }
    for (int i = gt; i < NH * 132; i += NT) { const int h = i / 132, d = i % 132; F.biasd[i] = F.rel_bias[t5_bucket(d < 128 ? d : 128) * NH + h]; }
}

__device__ __forceinline__ void p2_gate(Frame& F) {
    LAS float* km = (LAS float*)(F.lds + RING_OFF);
    const bf16* QA = F.PROJ;
    for (int it = blockIdx.x; it < 512; it += F.G) {
        const int cp = 31 - (it & 31), bh = it >> 5, b = bh >> 3, h = bh & 7, c0 = 2 * cp, nj = c0 + 1;
        __syncthreads();
        for (int i = F.tid; i < nj * 64; i += NWAVES * 64) { const int j = i >> 6, d = i & 63; const size_t o = (size_t)(b * 64 + j) * 512 + h * 64 + d;
            km[i] = (F.kms[o] + F.kms[(size_t)NPANEL * 512 + o]) * (1.0f / 256.0f); }
        __syncthreads();
        const int t = c0 * 256 + F.tid, c = t >> 8; const size_t row = (size_t)b * SEQ + t;
        float q[64];
        { const GAS u32x4v* qp = (const GAS u32x4v*)(QA + row * 512 + h * 64);
#pragma unroll
          for (int i = 0; i < 8; ++i) { const u32x4v w = qp[i]; q[8 * i] = bflo(w.x); q[8 * i + 1] = bfhi(w.x); q[8 * i + 2] = bflo(w.y); q[8 * i + 3] = bfhi(w.y); q[8 * i + 4] = bflo(w.z); q[8 * i + 5] = bfhi(w.z); q[8 * i + 6] = bflo(w.w); q[8 * i + 7] = bfhi(w.w); } }
        float v0 = -INFINITY, v1 = -INFINITY, v2 = -INFINITY; unsigned i0 = 255u, i1 = 255u, i2 = 255u;
        for (int j = 0; j < c; ++j) {
            const LAS f32x4* kp = (const LAS f32x4*)(km + j * 64); float g = 0.f;
#pragma unroll
            for (int i = 0; i < 16; ++i) { const f32x4 k4 = kp[i]; g += q[4 * i] * k4.x + q[4 * i + 1] * k4.y + q[4 * i + 2] * k4.z + q[4 * i + 3] * k4.w; }
            if (g > v0) { v2 = v1; i2 = i1; v1 = v0; i1 = i0; v0 = g; i0 = (unsigned)j; }
            else if (g > v1) { v2 = v1; i2 = i1; v1 = g; i1 = (unsigned)j; }
            else if (g > v2) { v2 = g; i2 = (unsigned)j; }
        }
        F.sel[row * 8 + h] = i0 | (i1 << 8) | (i2 << 16);
    }
}
__device__ __forceinline__ void p2_kv_simple(Frame& F) {
    const bf16* KR = F.PROJ + 4 * (size_t)TT * 512; const bf16* VR = F.PROJ + 5 * (size_t)TT * 512;
    for (int it = blockIdx.x; it < 1024; it += F.G) {
        const int b = it >> 9, h = (it >> 6) & 7, c = it & 63; const size_t row0 = (size_t)b * SEQ + c * 256;
        const int d = F.tid >> 3, e0 = (F.tid & 7) * 8; float a[8];
#pragma unroll
        for (int i = 0; i < 8; ++i) a[i] = 0.f;
        for (int m = 0; m < 256; ++m) {
            const float kk = bf1(KR[(row0 + m) * 512 + h * 64 + d]);
            const u32x4v w = *(const GAS u32x4v*)(VR + (row0 + m) * 512 + h * 64 + e0);
            a[0] += kk * bflo(w.x); a[1] += kk * bfhi(w.x); a[2] += kk * bflo(w.y); a[3] += kk * bfhi(w.y); a[4] += kk * bflo(w.z); a[5] += kk * bfhi(w.z); a[6] += kk * bflo(w.w); a[7] += kk * bfhi(w.w);
        }
        const float sc = F.dpos[h * 256 + 255];
#pragma unroll
        for (int i = 0; i < 8; ++i) F.KV[(size_t)it * 4096 + d * 64 + e0 + i] = a[i] * sc;
    }
}
__device__ __forceinline__ void p3_scan(Frame& F) {
    const int gt = blockIdx.x * (NWAVES * 64) + F.tid;
    if (gt < 16 * 4096) {
        const int bh = gt >> 12, idx = gt & 4095, h = bh & 7; const float g = F.g256[h]; float st = 0.f;
        for (int c = 0; c < 64; ++c) { const size_t o = ((size_t)(bh * 64 + c)) * 4096 + idx; F.RP[o] = st; st = st * g + F.KV[o]; }
    }
}
__device__ __forceinline__ void p3_moba_simple(Frame& F) {
    const bf16* QA = F.PROJ; const bf16* KA = F.PROJ + (size_t)TT * 512; const bf16* VA = F.PROJ + 2 * (size_t)TT * 512;
    const int gt = blockIdx.x * (NWAVES * 64) + F.tid, NT = F.G * NWAVES * 64;
    for (int idx = gt; idx < TT * NH; idx += NT) {
        const int h = idx >> 15, row = idx & (TT - 1), b = row >> 14, t = row & (SEQ - 1), c = t >> 8;
        float q[64], o[64];
        { const GAS u32x4v* qp = (const GAS u32x4v*)(QA + (size_t)row * 512 + h * 64);
#pragma unroll
          for (int i = 0; i < 8; ++i) { const u32x4v w = qp[i]; q[8 * i] = bflo(w.x); q[8 * i + 1] = bfhi(w.x); q[8 * i + 2] = bflo(w.y); q[8 * i + 3] = bfhi(w.y); q[8 * i + 4] = bflo(w.z); q[8 * i + 5] = bfhi(w.z); q[8 * i + 6] = bflo(w.w); q[8 * i + 7] = bfhi(w.w); } }
#pragma unroll
        for (int i = 0; i < 64; ++i) o[i] = 0.f;
        const unsigned sw = F.sel[(size_t)row * 8 + h]; const float* bd = F.biasd + h * 132;
        float mrun = -3.0e38f, l = 0.f;
        for (int slot = 0; slot < 4; ++slot) {
            const int j = slot < 3 ? (int)((sw >> (8 * slot)) & 255u) : c;
            if (slot < 3 && j >= c) continue;
            const size_t r0 = (size_t)b * SEQ + j * 256;
            for (int s = 0; s < 256; ++s) {
                const int pos = j * 256 + s; if (pos > t) break;
                const GAS u32x4v* kp = (const GAS u32x4v*)(KA + (r0 + s) * 512 + h * 64); float dot = 0.f;
#pragma unroll
                for (int i = 0; i < 8; ++i) { const u32x4v w = kp[i]; dot += q[8 * i] * bflo(w.x) + q[8 * i + 1] * bfhi(w.x) + q[8 * i + 2] * bflo(w.y) + q[8 * i + 3] * bfhi(w.y) + q[8 * i + 4] * bflo(w.z) + q[8 * i + 5] * bfhi(w.z) + q[8 * i + 6] * bflo(w.w) + q[8 * i + 7] * bfhi(w.w); }
                const int dist = t - pos; const float sc = dot + bd[dist < 128 ? dist : 128];
                if (sc > mrun) { const float a = __expf(mrun - sc); l *= a;
#pragma unroll
                    for (int i = 0; i < 64; ++i) o[i] *= a;
                    mrun = sc; }
                const float p = __expf(sc - mrun); l += p;
                const GAS u32x4v* vp = (const GAS u32x4v*)(VA + (r0 + s) * 512 + h * 64);
#pragma unroll
                for (int i = 0; i < 8; ++i) { const u32x4v w = vp[i]; o[8 * i] += p * bflo(w.x); o[8 * i + 1] += p * bfhi(w.x); o[8 * i + 2] += p * bflo(w.y); o[8 * i + 3] += p * bfhi(w.y); o[8 * i + 4] += p * bflo(w.z); o[8 * i + 5] += p * bfhi(w.z); o[8 * i + 6] += p * bflo(w.w); o[8 * i + 7] += p * bfhi(w.w); }
            }
        }
        const float il = 1.0f / l;
        GAS u32x4v* yp = (GAS u32x4v*)(F.Y + (size_t)row * 1024 + h * 64);
#pragma unroll
        for (int i = 0; i < 8; ++i) { u32x4v w; w.x = pk2(o[8 * i] * il, o[8 * i + 1] * il); w.y = pk2(o[8 * i + 2] * il, o[8 * i + 3] * il); w.z = pk2(o[8 * i + 4] * il, o[8 * i + 5] * il); w.w = pk2(o[8 * i + 6] * il, o[8 * i + 7] * il); yp[i] = w; }
    }
}
__device__ __forceinline__ void p4_ret_simple(Frame& F) {
    const bf16* QR = F.PROJ + 3 * (size_t)TT * 512; const bf16* KR = F.PROJ + 4 * (size_t)TT * 512; const bf16* VR = F.PROJ + 5 * (size_t)TT * 512; const bf16* GR = F.PROJ + 6 * (size_t)TT * 512;
    const int gt = blockIdx.x * (NWAVES * 64) + F.tid, NT = F.G * NWAVES * 64;
    for (int idx = gt; idx < TT * NH; idx += NT) {
        const int h = idx >> 15, row = idx & (TT - 1), b = row >> 14, t = row & (SEQ - 1), c = t >> 8, n = t & 255;
        float q[64], y[64];
        { const GAS u32x4v* qp = (const GAS u32x4v*)(QR + (size_t)row * 512 + h * 64);
#pragma unroll
          for (int i = 0; i < 8; ++i) { const u32x4v w = qp[i]; q[8 * i] = bflo(w.x); q[8 * i + 1] = bfhi(w.x); q[8 * i + 2] = bflo(w.y); q[8 * i + 3] = bfhi(w.y); q[8 * i + 4] = bflo(w.z); q[8 * i + 5] = bfhi(w.z); q[8 * i + 6] = bflo(w.w); q[8 * i + 7] = bfhi(w.w); } }
#pragma unroll
        for (int i = 0; i < 64; ++i) y[i] = 0.f;
        const size_t r0 = (size_t)row - n;
        for (int m = 0; m <= n; ++m) {
            const GAS u32x4v* kp = (const GAS u32x4v*)(KR + (r0 + m) * 512 + h * 64); float dot = 0.f;
#pragma unroll
            for (int i = 0; i < 8; ++i) { const u32x4v w = kp[i]; dot += q[8 * i] * bflo(w.x) + q[8 * i + 1] * bfhi(w.x) + q[8 * i + 2] * bflo(w.y) + q[8 * i + 3] * bfhi(w.y) + q[8 * i + 4] * bflo(w.z) + q[8 * i + 5] * bfhi(w.z) + q[8 * i + 6] * bflo(w.w) + q[8 * i + 7] * bfhi(w.w); }
            const GAS u32x4v* vp = (const GAS u32x4v*)(VR + (r0 + m) * 512 + h * 64);
#pragma unroll
            for (int i = 0; i < 8; ++i) { const u32x4v w = vp[i]; y[8 * i] += dot * bflo(w.x); y[8 * i + 1] += dot * bfhi(w.x); y[8 * i + 2] += dot * bflo(w.y); y[8 * i + 3] += dot * bfhi(w.y); y[8 * i + 4] += dot * bflo(w.z); y[8 * i + 5] += dot * bfhi(w.z); y[8 * i + 6] += dot * bflo(w.w); y[8 * i + 7] += dot * bfhi(w.w); }
        }
        const float* R = F.RP + ((size_t)((b * 8 + h) * 64 + c)) * 4096; const float gam = F.gam[h];
        const bf16* qrow = QR + (size_t)row * 512 + h * 64;
        for (int d = 0; d < 64; ++d) {
            const float qd = bf1(qrow[d]) * gam; const GAS f32x4* rp = (const GAS f32x4*)(R + d * 64);
#pragma unroll
            for (int i = 0; i < 16; ++i) { const f32x4 r4 = rp[i]; y[4 * i] += qd * r4.x; y[4 * i + 1] += qd * r4.y; y[4 * i + 2] += qd * r4.z; y[4 * i + 3] += qd * r4.w; }
        }
        float mu = 0.f;
#pragma unroll
        for (int i = 0; i < 64; ++i) mu += y[i];
        mu *= (1.f / 64.f); float var = 0.f;
#pragma unroll
        for (int i = 0; i < 64; ++i) { y[i] -= mu; var += y[i] * y[i]; }
        const float rs = 1.0f / sqrtf(var * (1.f / 64.f) + EPS);
        const GAS u32x4v* gp = (const GAS u32x4v*)(GR + (size_t)row * 512 + h * 64);
        GAS u32x4v* yp = (GAS u32x4v*)(F.Y + (size_t)row * 1024 + 512 + h * 64);
#pragma unroll
        for (int i = 0; i < 8; ++i) { const u32x4v w = gp[i]; float g[8] = {bflo(w.x), bfhi(w.x), bflo(w.y), bfhi(w.y), bflo(w.z), bfhi(w.z), bflo(w.w), bfhi(w.w)}; float r[8];
#pragma unroll
            for (int k = 0; k < 8; ++k) r[k] = g[k] / (1.0f + __expf(-g[k])) * (y[8 * i + k] * rs);
            u32x4v ow; ow.x = pk2(r[0], r[1]); ow.y = pk2(r[2], r[3]); ow.z = pk2(r[4], r[5]); ow.w = pk2(r[6], r[7]); yp[i] = ow; }
    }
}
__device__ __forceinline__ void rows_residual(Frame& F, const float* xin, const bf16* Yb, const float* gpost, float* xout, bf16* XNo) {
    const int gw = F.vcu * NWAVES + F.wave, NGW = F.G * NWAVES;
    for (int m = gw; m < TT; m += NGW) {
        float ss = 0.f;
        { const GAS f32x4* rp = (const GAS f32x4*)(F.rowss + (size_t)m * 16);
#pragma unroll
          for (int i = 0; i < 4; ++i) { const f32x4 r = rp[i]; ss += (r.x + r.y) + (r.z + r.w); } }
        const float rstd = 1.0f / sqrtf(ss * (1.f / DM) + EPS);
        const GAS f32x4* xr = (const GAS f32x4*)(xin + (size_t)m * DM) + F.lane;
        const GAS u32x2v* yr = (const GAS u32x2v*)(Yb + (size_t)m * DM) + F.lane;
        const GAS f32x4* gr = (const GAS f32x4*)gpost + F.lane;
        GAS f32x4* orow = (GAS f32x4*)(xout + (size_t)m * DM) + F.lane;
        f32x4 v[4]; float s2 = 0.f;
#pragma unroll
        for (int j = 0; j < 4; ++j) { const f32x4 xv = xr[64 * j]; const u32x2v yw = yr[64 * j]; const f32x4 g = gr[64 * j];
            v[j].x = xv.x + bflo(yw.x) * rstd * g.x; v[j].y = xv.y + bfhi(yw.x) * rstd * g.y; v[j].z = xv.z + bflo(yw.y) * rstd * g.z; v[j].w = xv.w + bfhi(yw.y) * rstd * g.w;
            orow[64 * j] = v[j]; s2 += (v[j].x * v[j].x + v[j].y * v[j].y) + (v[j].z * v[j].z + v[j].w * v[j].w); }
        if (XNo) {
            const float r2 = 1.0f / sqrtf(wave_sum(s2) * (1.f / DM) + EPS);
            GAS unsigned long long* o8 = (GAS unsigned long long*)(XNo + (size_t)m * DM) + F.lane;
#pragma unroll
            for (int j = 0; j < 4; ++j) o8[64 * j] = (unsigned long long)pk2(v[j].x * r2, v[j].y * r2) | ((unsigned long long)pk2(v[j].z * r2, v[j].w * r2) << 32);
        }
    }
}
__device__ __forceinline__ float gelu_tanh(float a) { const float z = 0.7978845608028654f * (a + 0.044715f * a * a * a); return a * (1.0f - 1.0f / (__expf(2.0f * z) + 1.0f)); }
__device__ __forceinline__ void p8_conv(Frame& F, int hb) {
    const int gw = F.vcu * NWAVES + F.wave, NGW = F.G * NWAVES;
    constexpr int RSEG = 32, NSEG = SEQ / RSEG;
    for (int it = gw; it < 11 * NSEG; it += NGW) {
        const int strip = it % 11, seg = it / 11, c = strip * 256 + F.lane * 4, r0 = seg * RSEG;
        f32x4 wa[3], wb[3];
#pragma unroll
        for (int j = 0; j < 3; ++j) { wa[j] = *(const GAS f32x4*)(F.conv_w + (size_t)j * NUP + c); wb[j] = *(const GAS f32x4*)(F.conv_w + (size_t)j * NUP + DFF + c); }
        const f32x4 ba = *(const GAS f32x4*)(F.conv_b + c), bb = *(const GAS f32x4*)(F.conv_b + DFF + c);
        f32x4 a2 = {0.f, 0.f, 0.f, 0.f}, a1 = a2, b2 = a2, b1 = a2;
#define P8_LD(r, ua, ub) do { const u32x2v wa_ = *(const GAS u32x2v*)(Ub + (size_t)(r) * NUP + c), wb_ = *(const GAS u32x2v*)(Ub + (size_t)(r) * NUP + DFF + c); \
            ua = (f32x4){bflo(wa_.x), bfhi(wa_.x), bflo(wa_.y), bfhi(wa_.y)}; ub = (f32x4){bflo(wb_.x), bfhi(wb_.x), bflo(wb_.y), bfhi(wb_.y)}; } while (0)
        const bf16* Ub = F.U;
        if (r0 >= 2) { P8_LD(r0 - 2, a2, b2); P8_LD(r0 - 1, a1, b1); }
        for (int r = r0; r < r0 + RSEG; ++r) {
            f32x4 ua, ub; P8_LD(r, ua, ub);
            const f32x4 av = ba + wa[0] * a2 + wa[1] * a1 + wa[2] * ua, bv = bb + wb[0] * b2 + wb[1] * b1 + wb[2] * ub;
            u32x2v o; o.x = pk2(gelu_tanh(av.x) * bv.x, gelu_tanh(av.y) * bv.y); o.y = pk2(gelu_tanh(av.z) * bv.z, gelu_tanh(av.w) * bv.w);
            *(GAS u32x2v*)(F.Fb + ((size_t)hb * SEQ + r) * DFF + c) = o;
            a2 = a1; a1 = ua; b2 = b1; b1 = ub;
        }
    }
}

constexpr int NPHASE = 13;
struct Args { const float* in[12]; float* out; unsigned char* ws; int ph_lo, ph_hi; };
__global__ void __launch_bounds__(NWAVES * 64, 2) fwd_kernel(Args args) {
    extern __shared__ __attribute__((aligned(16))) unsigned char lds[];
    Frame F;
    F.lds = (LAS unsigned char*)lds; F.MISC = (volatile LAS unsigned*)(F.lds + MISC_OFF);
    F.tid = threadIdx.x; F.lane = F.tid & 63; F.wave = __builtin_amdgcn_readfirstlane(F.tid >> 6);
    F.G = gridDim.x; { const int bx = blockIdx.x; F.vcu = (F.G % 8 == 0) ? (bx % 8) * (F.G / 8) + bx / 8 : bx; }
    unsigned char* ws = args.ws;
    F.ctl = (gu32*)(ws + WS_CTL);
    F.x = args.in[0]; F.g_mix_pre = args.in[1]; F.w_in = args.in[2]; F.rel_bias = args.in[3]; F.w_out = args.in[4]; F.g_mix_post = args.in[5];
    F.g_ffn_pre = args.in[6]; F.w_up = args.in[7]; F.conv_w = args.in[8]; F.conv_b = args.in[9]; F.w_down = args.in[10]; F.g_ffn_post = args.in[11]; F.out = args.out;
    F.Win_t = (bf16*)(ws + WS_WIN); F.Wout_t = (bf16*)(ws + WS_WOUT); F.Wup_t = (bf16*)(ws + WS_WUP); F.Wdn_t = (bf16*)(ws + WS_WDN);
    F.XN = (bf16*)(ws + WS_XN); F.PROJ = (bf16*)(ws + WS_PROJ); F.Y = (bf16*)(ws + WS_Y); F.Y1 = (bf16*)(ws + WS_Y1); F.U = (bf16*)(ws + WS_U); F.Fb = (bf16*)(ws + WS_F);
    F.cs = (float*)(ws + WS_CS); F.biasd = (float*)(ws + WS_SMALL + SM_BIASD); F.dpos = (float*)(ws + WS_SMALL + SM_DPOS); F.dneg = (float*)(ws + WS_SMALL + SM_DNEG);
    F.gam = (float*)(ws + WS_SMALL + SM_GAM); F.g256 = (float*)(ws + WS_SMALL + SM_G256);
    F.kms = (float*)(ws + WS_KMS); F.rowss = (float*)(ws + WS_ROWSS); F.KV = (float*)(ws + WS_KV); F.RP = (float*)(ws + WS_RP); F.sel = (unsigned*)(ws + WS_SEL);
    for (int u = F.tid; u < (LDS_BYTES - LDSCTL_OFF) / 4; u += NWAVES * 64) ((LAS unsigned*)(F.lds + LDSCTL_OFF))[u] = 0u;
    __syncthreads();
    XcdBarrier bar; bar.bar = (unsigned*)(F.ctl + CW_BAR); bar.x = 0; bar.st = nullptr;
    if (MK_ONE_LAUNCH) bar = xcd_barrier_post((unsigned*)(F.ctl + CW_BAR), F.MISC + 8);
    const int lo = args.ph_lo, hi = args.ph_hi;
#define IN(k) (lo <= (k) && (k) < hi)
#define SEAM(k) do { if (IN(k) && IN((k) + 1)) xcd_barrier(bar); } while (0)

    if (IN(0)) { p0_prologue(F); } SEAM(0);
    if (IN(1)) {
        pg8::Gemm g{F.XN, F.Win_t, TT, NPROJ, DM}; pg8::StaticOrder S; S.init(TT, NPROJ, F.G, (int)blockIdx.x);
        pg8::EpiProj E{F.PROJ, F.cs, F.dpos, F.dneg, F.kms};
        pg8::gemm_phase<pg8::EpiProj, pg8::StaticOrder, PG8_ALIGN, PG8_SP2>(F.lds + RING_OFF, g, S, E);
    } SEAM(1);
    if (IN(2)) { p2_gate(F); p2_kv_simple(F); } SEAM(2);
    if (IN(3)) { p3_scan(F); p3_moba_simple(F); } SEAM(3);
    if (IN(4)) { p4_ret_simple(F); } SEAM(4);
    if (IN(5)) {
        pg8::Gemm g{F.Y, F.Wout_t, TT, DM, DM}; pg8::StaticOrder S; S.init(TT, DM, F.G, (int)blockIdx.x);
        pg8::EpiY E{F.Y1, F.rowss};
        pg8::gemm_phase<pg8::EpiY, pg8::StaticOrder, PG8_ALIGN, PG8_SP2>(F.lds + RING_OFF, g, S, E);
    } SEAM(5);
    if (IN(6)) { rows_residual(F, F.x, F.Y1, F.g_mix_post, F.out, F.XN); } SEAM(6);
#pragma unroll 1
    for (int hb = 0; hb < 2; ++hb) {
        if (IN(7 + 2 * hb)) {
            pg8::Gemm g{F.XN + (size_t)hb * SEQ * DM, F.Wup_t, SEQ, NUP, DM}; pg8::StaticOrder S; S.init(SEQ, NUP, F.G, (int)blockIdx.x);
            pg8::EpiBf16<0> E{F.U, NUP, nullptr, 0, 0, 1.f};
            pg8::gemm_phase<pg8::EpiBf16<0>, pg8::StaticOrder, PG8_ALIGN, PG8_SP2>(F.lds + RING_OFF, g, S, E);
        } SEAM(7 + 2 * hb);
        if (IN(8 + 2 * hb)) { p8_conv(F, hb); } SEAM(8 + 2 * hb);
    }
    if (IN(11)) {
        pg8::Gemm g{F.Fb, F.Wdn_t, TT, DM, DFF}; pg8::StaticOrder S; S.init(TT, DM, F.G, (int)blockIdx.x);
        pg8::EpiY E{F.Y1, F.rowss};
        pg8::gemm_phase<pg8::EpiY, pg8::StaticOrder, PG8_ALIGN, PG8_SP2>(F.lds + RING_OFF, g, S, E);
    } SEAM(11);
    if (IN(12)) { rows_residual(F, F.out, F.Y1, F.g_ffn_post, F.out, nullptr); }
#undef IN
#undef SEAM
}

extern "C" void kernel_launch(void* const* d_in, const int* in_sizes, int n_in, void* d_out, int out_size, void* d_ws, size_t ws_size, hipStream_t stream) {
    static int grid = 0;
    if (grid == 0) {
        if (n_in != 12 || in_sizes[0] != TT * DM || out_size != TT * DM || ws_size < WS_END) { fprintf(stderr, "kernel_launch: unexpected shapes (n_in %d in0 %d out %d ws %zu)\n", n_in, n_in > 0 ? in_sizes[0] : -1, out_size, ws_size); grid = -1; return; }
        int dev = 0, cus = 0, per_cu = 0;
        if (hipGetDevice(&dev) != hipSuccess || hipDeviceGetAttribute(&cus, hipDeviceAttributeMultiprocessorCount, dev) != hipSuccess) { grid = -1; return; }
        if (hipFuncSetAttribute((const void*)fwd_kernel, hipFuncAttributeMaxDynamicSharedMemorySize, LDS_BYTES) != hipSuccess) { fprintf(stderr, "kernel_launch: hipFuncSetAttribute failed\n"); grid = -1; return; }
        if (hipOccupancyMaxActiveBlocksPerMultiprocessor(&per_cu, (const void*)fwd_kernel, NWAVES * 64, LDS_BYTES) != hipSuccess || per_cu < 1) { fprintf(stderr, "kernel_launch: occupancy query says %d\n", per_cu); per_cu = 1; }
        (void)hipGetLastError();
        grid = cus * (per_cu < 1 ? 1 : 1);
    }
    if (grid < 0) return;
    if (hipMemsetAsync((char*)d_ws + WS_CTL, 0, CTL_ZERO_BYTES, stream) != hipSuccess) { fprintf(stderr, "kernel_launch: memset failed\n"); return; }
    Args a{};
    for (int i = 0; i < 12; ++i) a.in[i] = (const float*)d_in[i];
    a.out = (float*)d_out; a.ws = (unsigned char*)d_ws;
#if MK_ONE_LAUNCH
    a.ph_lo = 0; a.ph_hi = NPHASE;
    void* kargs[] = {&a};
    hipError_t e = hipLaunchCooperativeKernel((const void*)fwd_kernel, dim3(grid), dim3(NWAVES * 64), kargs, LDS_BYTES, stream);
    if (e != hipSuccess) fprintf(stderr, "kernel_launch: cooperative launch failed: %s\n", hipGetErrorString(e));
#else
    for (int p = 0; p < NPHASE; ++p) { a.ph_lo = p; a.ph_hi = p + 1; hipLaunchKernelGGL(fwd_kernel, dim3(grid), dim3(NWAVES * 64), LDS_BYTES, stream, a); }
#endif
}
```

```cpp
#include <hip/hip_runtime.h>
#include <hip/hip_cooperative_groups.h>
#include <cstdio>
#include <cstdint>
#define MK_ONE_LAUNCH 1
namespace pg8 {
#define PG8_LAS __attribute__((address_space(3)))
typedef unsigned short bf16_t;
typedef short bf16x8 __attribute__((ext_vector_type(8)));
typedef float f32x4 __attribute__((ext_vector_type(4)));
typedef unsigned u32x4 __attribute__((ext_vector_type(4)));
constexpr int BM = 256, BK = 64, HALF = 128, HTB = HALF * BK * 2  , STAGE_BYTES = 8 * HTB, NXCD = 8, WGM = 8;

__host__ __device__ __forceinline__ int lds_byte(int r, int c) { const int st = (r >> 4) * 2 + (c >> 5), rr = r & 15, cc = c & 31, ob = rr * 64 + cc * 2; return st * 1024 + (ob ^ (((ob >> 9) & 1) << 5)); }
__host__ __device__ __forceinline__ void stage_rc(int b, int& R, int& C) { const int st = b / 1024, sb = b % 1024, swz = sb ^ (((sb >> 9) & 1) << 5); R = (st >> 1) * 16 + swz / 64; C = (st & 1) * 32 + (swz % 64) / 2; }
__host__ __device__ __forceinline__ int perm32(int rho) { const int n = rho >> 4, i = rho & 15; return 8 * (i >> 2) + 4 * n + (i & 3); }

struct Unit { int pm, pn; };
struct Gemm { const bf16_t* A; const bf16_t* Bt; int M, N, K; };

struct StaticOrder {
    int nM, nN, nwg, G, c;
    __host__ __device__ void init(int M, int N, int G_, int c_) { nM = M / BM; nN = N / BM; nwg = nM * nN; G = G_; c = c_; }
    __host__ __device__ bool next(int i, Unit& u) const {
        const long L = (long)i * G + c; if (L >= nwg) return false;
        int wgid = (int)L; { const int q = nwg / NXCD, r = nwg % NXCD, xcd = wgid % NXCD, off = wgid / NXCD; wgid = (xcd < r ? xcd * (q + 1) : r * (q + 1) + (xcd - r) * q) + off; }
        const int nig = WGM * nN, gid = wgid / nig, fm = gid * WGM, gsz = (nM - fm) < WGM ? (nM - fm) : WGM;
        u.pm = fm + ((wgid % nig) % gsz); u.pn = (wgid % nig) / gsz; return true;
    }
    __device__ __forceinline__ void a_ready(const Unit&) const {}
    __device__ __forceinline__ void done(const Unit&) const {}
};

__device__ __forceinline__ unsigned cvt_pk_bf16(float lo, float hi) { unsigned r; asm volatile("v_cvt_pk_bf16_f32 %0, %1, %2" : "=v"(r) : "v"(lo), "v"(hi)); return r; }
typedef float f32x2 __attribute__((ext_vector_type(2)));
__device__ __forceinline__ f32x2 gelu_pk(f32x2 v) {
    const f32x2 av = __builtin_elementwise_abs(v), d = av * 0.2316418882f + 1.0f;
    f32x2 t; t.x = __builtin_amdgcn_rcpf(d.x); t.y = __builtin_amdgcn_rcpf(d.y);
    f32x2 q = t * 0.5307027145f + (-0.7265760135f); q = q * t + 0.7107068705f; q = q * t + (-0.142248368f); q = q * t + 0.127414796f; q = q * t;
    const f32x2 s = (v * v) * (-0.72134752044f);
    f32x2 e; e.x = __builtin_amdgcn_exp2f(s.x); e.y = __builtin_amdgcn_exp2f(s.y);
    const f32x2 m = v * (q * e), r = v - m;
    f32x2 o; o.x = v.x < 0.f ? m.x : r.x; o.y = v.y < 0.f ? m.y : r.y; return o;
}

template <int ACT  > struct EpiBf16 {
    static constexpr bool PERM = true, AFTER_DRAIN = false; static_assert(ACT == 0 || ACT == 1, "EpiBf16: ACT is 0 (none) or 1 (gelu_pk)");
    bf16_t* O; int ldc; const float* bias; int split_cols; size_t split_stride; float scale0;
    __device__ __forceinline__ void operator()(const f32x4 (&acc)[2][2][4][2], const Unit& u, int wr, int wc, int fr, int fq) const {
        const int row0 = u.pm * BM + wr * 64 + fr; int colt = u.pn * BM; bf16_t* base = O;
        float sc = 1.f; if (split_cols) { const int t = colt / split_cols; base += (size_t)t * split_stride; colt -= t * split_cols; if (t == 0) sc = scale0; }
        const int col0 = colt + wc * 32 + 8 * fq, bcol0 = u.pn * BM + wc * 32 + 8 * fq;
        f32x4 bv[2][2];
#pragma unroll
        for (int bj = 0; bj < 2; ++bj)
#pragma unroll
            for (int n = 0; n < 2; ++n) bv[bj][n] = bias ? *(const f32x4*)(bias + bcol0 + bj * HALF + 4 * n) : (f32x4){0.f, 0.f, 0.f, 0.f};
#pragma unroll
        for (int ai = 0; ai < 2; ++ai)
#pragma unroll
            for (int m = 0; m < 4; ++m) { bf16_t* rowp = base + (size_t)(row0 + ai * HALF + m * 16) * ldc + col0;
#pragma unroll
                for (int bj = 0; bj < 2; ++bj) { f32x4 v0 = acc[ai][bj][m][0] + bv[bj][0], v1 = acc[ai][bj][m][1] + bv[bj][1];
                    if (ACT == 1) { f32x2 a = gelu_pk((f32x2){v0[0], v0[1]}), b = gelu_pk((f32x2){v0[2], v0[3]}), c = gelu_pk((f32x2){v1[0], v1[1]}), d = gelu_pk((f32x2){v1[2], v1[3]});
                        v0 = (f32x4){a.x, a.y, b.x, b.y}; v1 = (f32x4){c.x, c.y, d.x, d.y}; }
                    v0 = v0 * sc; v1 = v1 * sc; u32x4 w; w.x = cvt_pk_bf16(v0[0], v0[1]); w.y = cvt_pk_bf16(v0[2], v0[3]); w.z = cvt_pk_bf16(v1[0], v1[1]); w.w = cvt_pk_bf16(v1[2], v1[3]);
                    *(u32x4*)(rowp + bj * HALF) = w; } }
    }
};
template <class Epi, class Sched, bool ALIGN_EPI = false, bool SP2 = false>
__device__ __forceinline__ void gemm_phase(PG8_LAS unsigned char* lds, const Gemm g, const Sched& S, const Epi& E) {
    const int tid = threadIdx.x, wid = __builtin_amdgcn_readfirstlane(tid >> 6), lane = tid & 63, wr = wid >> 2, wc = wid & 3, fr = lane & 15, fq = lane >> 4;
    const int K = g.K, nt = K / BK;
    unsigned voffA[2], voffB[2];
#pragma unroll
    for (int i = 0; i < 2; ++i) { int R, C; stage_rc(tid * 16 + i * 8192, R, C); const int Rb = Epi::PERM ? ((R & ~31) + perm32(R & 31)) : R;
        voffA[i] = (unsigned)(R * K + C) * 2u; voffB[i] = (unsigned)(Rb * K + C) * 2u; }
    const size_t kstep = (size_t)(BK * 2);
    const size_t hstep = (size_t)HALF * K * 2;
    const size_t tstep = 2 * hstep;
    const unsigned ldsw = (unsigned)wid * 1024u;
    const int aoff = lds_byte(wr * 64 + fr, fq * 8), boff = lds_byte(wc * 32 + fr, fq * 8);
#define PG8_SA(b, h) (((b) * 2 + (h)) * HTB)
#define PG8_SB(b, h) ((4 + (b) * 2 + (h)) * HTB)
#define PG8_STAGE(bufoff, gbase, voff) do { _Pragma("unroll") for (int _i = 0; _i < 2; ++_i) \
        __builtin_amdgcn_global_load_lds((const unsigned*)((const char*)(gbase) + (voff)[_i]), (PG8_LAS unsigned*)(lds + (bufoff) + ldsw + _i * 8192), 16, 0, 0); } while (0)
#define PG8_LDA(dst, b, h) do { _Pragma("unroll") for (int m = 0; m < 4; ++m) _Pragma("unroll") for (int k = 0; k < 2; ++k) dst[m][k] = *(const PG8_LAS bf16x8*)(lds + PG8_SA(b, h) + aoff + m * 2048 + k * 1024); } while (0)
#define PG8_LDB(dst, b, h) do { _Pragma("unroll") for (int n = 0; n < 2; ++n) _Pragma("unroll") for (int k = 0; k < 2; ++k) dst[n][k] = *(const PG8_LAS bf16x8*)(lds + PG8_SB(b, h) + boff + n * 2048 + k * 1024); } while (0)
#define PG8_MMA(ai, bj, At, Bt) do { __builtin_amdgcn_s_setprio(1); _Pragma("unroll") for (int m = 0; m < 4; ++m) _Pragma("unroll") for (int n = 0; n < 2; ++n) _Pragma("unroll") for (int k = 0; k < 2; ++k) \
        acc[ai][bj][m][n] = __builtin_amdgcn_mfma_f32_16x16x32_bf16(Bt[n][k], At[m][k], acc[ai][bj][m][n], 0, 0, 0); __builtin_amdgcn_s_setprio(0); } while (0)
#define PG8_WAIT_V(n) asm volatile("s_waitcnt vmcnt(" #n ")" ::: "memory")
#define PG8_WAIT_L(n) asm volatile("s_waitcnt lgkmcnt(" #n ")" ::: "memory")
#define PG8_BAR __builtin_amdgcn_s_barrier()
#define PG8_SCHED __builtin_amdgcn_sched_barrier(0)
    Unit cur, nxt; int ui = 0;
    if (!S.next(0, cur)) return;
    f32x4 acc[2][2][4][2];
#pragma unroll
    for (int a = 0; a < 2; ++a)
#pragma unroll
        for (int b = 0; b < 2; ++b)
#pragma unroll
            for (int m = 0; m < 4; ++m)
#pragma unroll
                for (int n = 0; n < 2; ++n) acc[a][b][m][n] = (f32x4){0.f, 0.f, 0.f, 0.f};
    bf16x8 At[4][2], B0[2][2], B1[2][2];
    const char* cA = (const char*)g.A + (size_t)cur.pm * tstep; const char* cB = (const char*)g.Bt + (size_t)cur.pn * tstep;
    S.a_ready(cur);
    if constexpr (SP2) {
        PG8_STAGE(PG8_SB(0, 0), cB, voffB); PG8_STAGE(PG8_SB(0, 1), cB + hstep, voffB); PG8_STAGE(PG8_SA(0, 0), cA, voffA); PG8_STAGE(PG8_SA(0, 1), cA + hstep, voffA);
        if (wr == 1) PG8_BAR;
        PG8_WAIT_V(2); PG8_BAR;
        PG8_STAGE(PG8_SB(1, 0), cB + kstep, voffB); PG8_STAGE(PG8_SA(1, 0), cA + kstep, voffA); PG8_STAGE(PG8_SB(1, 1), cB + hstep + kstep, voffB);
        PG8_WAIT_V(6); PG8_BAR;
    } else {
        PG8_STAGE(PG8_SB(0, 0), cB, voffB); PG8_STAGE(PG8_SA(0, 0), cA, voffA); PG8_STAGE(PG8_SB(0, 1), cB + hstep, voffB); PG8_STAGE(PG8_SA(0, 1), cA + hstep, voffA);
        if (wr == 1) PG8_BAR;
        PG8_WAIT_V(4); PG8_BAR;
        PG8_STAGE(PG8_SB(1, 0), cB + kstep, voffB); PG8_STAGE(PG8_SA(1, 0), cA + kstep, voffA); PG8_STAGE(PG8_SB(1, 1), cB + hstep + kstep, voffB);
        PG8_WAIT_V(6); PG8_BAR;
    }
    for (;;) {
        const bool has_next = S.next(ui + 1, nxt);
        const char* nA = has_next ? (const char*)g.A + (size_t)nxt.pm * tstep : cA; const char* nB = has_next ? (const char*)g.Bt + (size_t)nxt.pn * tstep : cB;
        for (int t = 0; t < nt; t += 2) {
            const bool last = (t == nt - 2);
            const char* a1 = cA + (size_t)(t + 1) * kstep;
            const char* a2 = last ? nA : cA + (size_t)(t + 2) * kstep; const char* b2 = last ? nB : cB + (size_t)(t + 2) * kstep;
            const char* a3 = a2 + kstep; const char* b3 = b2 + kstep;
            if (last && has_next) S.a_ready(nxt);
            if constexpr (SP2) {
            PG8_LDB(B0, 0, 0); PG8_LDB(B1, 0, 1); PG8_SCHED; PG8_LDA(At, 0, 0); PG8_STAGE(PG8_SA(1, 1), a1 + hstep, voffA);
            PG8_WAIT_V(8); PG8_WAIT_L(0); PG8_BAR; PG8_MMA(0, 0, At, B0); PG8_MMA(0, 1, At, B1); PG8_BAR; PG8_SCHED;
            PG8_LDA(At, 0, 1); PG8_STAGE(PG8_SB(0, 0), b2, voffB); PG8_STAGE(PG8_SB(0, 1), b2 + hstep, voffB); PG8_STAGE(PG8_SA(0, 0), a2, voffA);
            PG8_WAIT_V(8); PG8_WAIT_L(0); PG8_BAR; PG8_MMA(1, 0, At, B0); PG8_MMA(1, 1, At, B1); PG8_BAR; PG8_SCHED;
            PG8_LDB(B0, 1, 0); PG8_LDB(B1, 1, 1); PG8_SCHED; PG8_LDA(At, 1, 0); PG8_STAGE(PG8_SA(0, 1), a2 + hstep, voffA);
            PG8_WAIT_V(8); PG8_WAIT_L(0); PG8_BAR; PG8_MMA(0, 0, At, B0); PG8_MMA(0, 1, At, B1); PG8_BAR; PG8_SCHED;
            PG8_LDA(At, 1, 1); PG8_STAGE(PG8_SB(1, 0), b3, voffB); PG8_STAGE(PG8_SB(1, 1), b3 + hstep, voffB); PG8_STAGE(PG8_SA(1, 0), a3, voffA);
            PG8_WAIT_V(8); PG8_WAIT_L(0); PG8_BAR; PG8_MMA(1, 0, At, B0); PG8_MMA(1, 1, At, B1); PG8_BAR; PG8_SCHED;
            } else {
            PG8_LDB(B0, 0, 0); PG8_SCHED; PG8_LDA(At, 0, 0); PG8_STAGE(PG8_SA(1, 1), a1 + hstep, voffA);
            PG8_WAIT_L(8); PG8_BAR; PG8_WAIT_L(0); PG8_MMA(0, 0, At, B0); PG8_BAR; PG8_SCHED;
            PG8_LDB(B1, 0, 1); PG8_STAGE(PG8_SB(0, 0), b2, voffB);
            PG8_BAR; PG8_WAIT_L(0); PG8_MMA(0, 1, At, B1); PG8_BAR;
            PG8_LDA(At, 0, 1); PG8_STAGE(PG8_SA(0, 0), a2, voffA);
            PG8_BAR; PG8_WAIT_L(0); PG8_MMA(1, 0, At, B0); PG8_BAR; PG8_SCHED;
            PG8_STAGE(PG8_SB(0, 1), b2 + hstep, voffB);
            PG8_WAIT_V(6); PG8_BAR; PG8_MMA(1, 1, At, B1); PG8_BAR;
            PG8_LDB(B0, 1, 0); PG8_SCHED; PG8_LDA(At, 1, 0); PG8_STAGE(PG8_SA(0, 1), a2 + hstep, voffA);
            PG8_WAIT_L(8); PG8_BAR; PG8_WAIT_L(0); PG8_MMA(0, 0, At, B0); PG8_BAR; PG8_SCHED;
            PG8_LDB(B1, 1, 1); PG8_STAGE(PG8_SB(1, 0), b3, voffB);
            PG8_BAR; PG8_WAIT_L(0); PG8_MMA(0, 1, At, B1); PG8_BAR;
            PG8_LDA(At, 1, 1); PG8_STAGE(PG8_SA(1, 0), a3, voffA);
            PG8_BAR; PG8_WAIT_L(0); PG8_MMA(1, 0, At, B0); PG8_BAR; PG8_SCHED;
            PG8_STAGE(PG8_SB(1, 1), b3 + hstep, voffB);
            PG8_WAIT_V(6); PG8_BAR; PG8_MMA(1, 1, At, B1); PG8_BAR;
            }
        }
        if constexpr (ALIGN_EPI) { if (wr == 0) PG8_BAR; }
        if constexpr (!Epi::AFTER_DRAIN) { E(acc, cur, wr, wc, fr, fq); S.done(cur); }
        if (!has_next) break;
#pragma unroll
        for (int a = 0; a < 2; ++a)
#pragma unroll
            for (int b = 0; b < 2; ++b)
#pragma unroll
                for (int m = 0; m < 4; ++m)
#pragma unroll
                    for (int n = 0; n < 2; ++n) acc[a][b][m][n] = (f32x4){0.f, 0.f, 0.f, 0.f};
        cur = nxt; cA = nA; cB = nB; ++ui;
        if constexpr (ALIGN_EPI) { if (wr == 1) PG8_BAR; }
    }
    PG8_WAIT_V(0);
    if constexpr (!ALIGN_EPI) { if (wr == 0) PG8_BAR; }
    PG8_BAR;
    if constexpr (Epi::AFTER_DRAIN) { E.fused(acc, cur, wr, wc, fr, fq, lds, wid, lane); S.done(cur); }
#undef PG8_SA
#undef PG8_SB
#undef PG8_STAGE
#undef PG8_LDA
#undef PG8_LDB
#undef PG8_MMA
#undef PG8_WAIT_V
#undef PG8_WAIT_L
#undef PG8_BAR
#undef PG8_SCHED
}
}

#ifndef PG8_SP2
#define PG8_SP2 true
#endif
#ifndef PG8_ALIGN
#define PG8_ALIGN true
#endif
#define GAS __attribute__((address_space(1)))
#define LAS __attribute__((address_space(3)))
typedef unsigned short bf16;
typedef unsigned v4u __attribute__((ext_vector_type(4)));
typedef float f32x4 __attribute__((ext_vector_type(4)));
typedef short bf16x8 __attribute__((ext_vector_type(8)));
typedef GAS unsigned gu32;
typedef GAS unsigned long long gu64;
#define RLX_AGENT __ATOMIC_RELAXED, __HIP_MEMORY_SCOPE_AGENT
#define LDS_WAIT() asm volatile("s_waitcnt lgkmcnt(0)" ::: "memory")
#define VM_WAIT() asm volatile("s_waitcnt vmcnt(0)" ::: "memory")
__device__ __forceinline__ unsigned long long rt() { return __builtin_amdgcn_s_memrealtime(); }
__device__ __forceinline__ unsigned f2bf(float f) { unsigned u = __builtin_bit_cast(unsigned, f); return (u + 0x7fffu + ((u >> 16) & 1u)) >> 16; }
__device__ __forceinline__ unsigned pk2(float lo, float hi) { return f2bf(lo) | (f2bf(hi) << 16); }

#define XB_TMO      128
#define XB_XCNT(j)  (256  + 64 * (j))
#define XB_XSUB(j)  (1280 + 64 * (j))
#define XB_XGEN(j)  (2304 + 64 * (j))
#define XB_TOP      3328
#define XB_TOPGEN   3392
#define XCD_BAR_WORDS 3456
#define XB_SPIN_CAP (1u << 18)

__device__ __forceinline__ unsigned xb_ld(unsigned* p)              { return __hip_atomic_load(p, __ATOMIC_RELAXED, __HIP_MEMORY_SCOPE_AGENT); }
__device__ __forceinline__ unsigned xb_add(unsigned* p, unsigned v) { return __hip_atomic_fetch_add(p, v, __ATOMIC_RELAXED, __HIP_MEMORY_SCOPE_AGENT); }
__device__ __forceinline__ unsigned xb_xcc_id() { return (unsigned)__builtin_amdgcn_s_getreg((3 << 11) | 20) & 0xFu; }
#define XB_SPIN(cond, bar) do { unsigned _sp = 0; while (cond) { __builtin_amdgcn_s_sleep(1); \
    if ((++_sp & 255u) == 0u) { if (xb_ld(&(bar)[XB_TMO])) break; if (_sp > XB_SPIN_CAP) { atomicAdd(&(bar)[XB_TMO], 1u); break; } } } } while (0)

struct XcdBarrier {
    unsigned* bar; unsigned x;
    volatile LAS unsigned* st;
};

__device__ __forceinline__ XcdBarrier xcd_barrier_post(unsigned* bar, volatile LAS unsigned* st) {
    XcdBarrier b; b.bar = bar; b.x = xb_xcc_id(); b.st = st;
    if (threadIdx.x == 0) (void)xb_add(&bar[XB_XCNT(b.x)], 1u);
    return b;
}
__device__ __forceinline__ void xcd_barrier_complete(unsigned* bar, unsigned x, unsigned& nloc, unsigned& nx) {
    const unsigned G = gridDim.x * gridDim.y * gridDim.z;
    unsigned sum, cnt, mine, sp = 0u;
    for (;;) {
        sum = 0u; cnt = 0u; mine = 0u;
#pragma unroll
        for (unsigned j = 0; j < 16; ++j) { const unsigned c = xb_ld(&bar[XB_XCNT(j)]); sum += c; cnt += (c > 0u) ? 1u : 0u; mine = (j == x) ? c : mine; }
        if (sum == G) break;
        __builtin_amdgcn_s_sleep(1);
        if ((++sp & 255u) == 0u) { if (xb_ld(&bar[XB_TMO])) break; if (sp > XB_SPIN_CAP) { atomicAdd(&bar[XB_TMO], 1u); break; } }
    }
    nloc = mine > 0u ? mine : 1u; nx = cnt > 0u ? cnt : 1u;
}

__device__ __forceinline__ void xcd_barrier(const XcdBarrier& b) {
    asm volatile("s_waitcnt vmcnt(0)" ::: "memory");
    __syncthreads();
    if (threadIdx.x == 0) {
        unsigned* bar = b.bar;
        __builtin_amdgcn_s_waitcnt(0);
        unsigned nloc = b.st[0], nx = b.st[1];
        if (nloc == 0u) { xcd_barrier_complete(bar, b.x, nloc, nx); b.st[0] = nloc; b.st[1] = nx; }
        const unsigned old = xb_add(&bar[XB_XSUB(b.x)], 1u);
        const unsigned gen = old / nloc;
        if (old + 1u == (gen + 1u) * nloc) {
            __builtin_amdgcn_fence(__ATOMIC_RELEASE, "agent");
            asm volatile("s_waitcnt vmcnt(0)" ::: "memory");
            const unsigned og = xb_add(&bar[XB_TOP], 1u);
            const unsigned tg = og / nx;
            if (og + 1u == (tg + 1u) * nx) xb_add(&bar[XB_TOPGEN], 1u);
            else XB_SPIN(xb_ld(&bar[XB_TOPGEN]) == tg, bar);
            __builtin_amdgcn_fence(__ATOMIC_ACQUIRE, "agent");
            xb_add(&bar[XB_XGEN(b.x)], 1u);
            asm volatile("s_waitcnt vmcnt(0)" ::: "memory");
        } else {
            XB_SPIN(xb_ld(&bar[XB_XGEN(b.x)]) == gen, bar);
            __builtin_amdgcn_fence(__ATOMIC_ACQUIRE, "agent");
            asm volatile("s_waitcnt vmcnt(0)" ::: "memory");
        }
    }
    __syncthreads();
}

constexpr int BATCH = 2, SEQ = 16384, DM = 1024, TT = BATCH * SEQ, NPROJ = 3584, DFF = 2816, NUP = 2 * DFF, NPANEL = TT / 256;
constexpr int NH = 8, HD = 64, HW = 512;
constexpr float EPS = 1e-6f;
#ifndef MK_ONE_LAUNCH
#define MK_ONE_LAUNCH 0
#endif

constexpr size_t MiB = 1u << 20;
constexpr size_t WS_CTL = 0, CTL_ZERO_BYTES = 1 * MiB;
constexpr size_t WS_WIN = 1 * MiB, WS_WOUT = 8 * MiB, WS_WUP = 10 * MiB, WS_WDN = 21 * MiB;
constexpr size_t WS_CS = 27 * MiB;
constexpr size_t WS_SMALL = 31 * MiB;
constexpr size_t SM_BIASD = 0, SM_DPOS = 8192, SM_DNEG = 16384, SM_GAM = 24576, SM_G256 = 24576 + 64;
constexpr size_t WS_KMS = 32 * MiB;
constexpr size_t WS_ROWSS = 33 * MiB;
constexpr size_t WS_SEL = 35 * MiB;
constexpr size_t WS_KV = 40 * MiB, WS_RP = 56 * MiB;
constexpr size_t WS_XN = 72 * MiB;
constexpr size_t WS_PROJ = 136 * MiB;
constexpr size_t PROJ_SEG = (size_t)TT * 512 * 2;
constexpr size_t WS_Y = 360 * MiB;
constexpr size_t WS_Y1 = 136 * MiB;
constexpr size_t WS_U = 136 * MiB;
constexpr size_t WS_F = 312 * MiB;
constexpr size_t WS_END = 496 * MiB;
constexpr int CW_BAR = 4096;

typedef unsigned u32x4v __attribute__((ext_vector_type(4)));
typedef unsigned u32x2v __attribute__((ext_vector_type(2)));

__device__ __forceinline__ float bflo(unsigned w) { return __uint_as_float(w << 16); }
__device__ __forceinline__ float bfhi(unsigned w) { return __uint_as_float(w & 0xffff0000u); }
__device__ __forceinline__ float bf1(bf16 b) { return __uint_as_float((unsigned)b << 16); }

namespace pg8 {
struct EpiProj {
    static constexpr bool PERM = true, AFTER_DRAIN = false;
    bf16_t* proj; const float* cs; const float* dpos; const float* dneg; float* kms;
    __device__ __forceinline__ void operator()(const f32x4 (&acc)[2][2][4][2], const Unit& u, int wr, int wc, int fr, int fq) const {
        const int seg = u.pn >> 1, cb = (u.pn & 1) * 256;
        bf16_t* base = proj + (size_t)seg * ((size_t)TT * 512);
        const int row0 = u.pm * BM + wr * 64 + fr, colw = cb + wc * 32 + 8 * fq;
        if (seg == 3 || seg == 4) {
            const int i0 = 16 * (wc & 1) + 4 * fq;
#pragma unroll
            for (int ai = 0; ai < 2; ++ai)
#pragma unroll
                for (int m = 0; m < 4; ++m) {
                    const int row = row0 + ai * HALF + m * 16, t = row & (SEQ - 1), tl = t & 255;
                    const f32x4 c01 = *(const f32x4*)(cs + ((size_t)t * 32 + i0) * 2), c23 = *(const f32x4*)(cs + ((size_t)t * 32 + i0) * 2 + 4);
                    bf16_t* rowp = base + (size_t)row * 512 + colw;
#pragma unroll
                    for (int bj = 0; bj < 2; ++bj) {
                        const int head = (cb >> 6) + bj * 2 + (wc >> 1);
                        const float ds = (seg == 3) ? dpos[head * 256 + tl] : 0.125f * dneg[head * 256 + tl];
                        const f32x4 v0 = acc[ai][bj][m][0], v1 = acc[ai][bj][m][1];
                        u32x4 w;
                        w.x = cvt_pk_bf16((v0[0] * c01[0] - v0[1] * c01[1]) * ds, (v0[0] * c01[1] + v0[1] * c01[0]) * ds);
                        w.y = cvt_pk_bf16((v0[2] * c01[2] - v0[3] * c01[3]) * ds, (v0[2] * c01[3] + v0[3] * c01[2]) * ds);
                        w.z = cvt_pk_bf16((v1[0] * c23[0] - v1[1] * c23[1]) * ds, (v1[0] * c23[1] + v1[1] * c23[0]) * ds);
                        w.w = cvt_pk_bf16((v1[2] * c23[2] - v1[3] * c23[3]) * ds, (v1[2] * c23[3] + v1[3] * c23[2]) * ds);
                        *(u32x4*)(rowp + bj * HALF) = w;
                    }
                }
        } else {
            const float sc = (seg == 0) ? 0.125f : 1.0f;
#pragma unroll
            for (int ai = 0; ai < 2; ++ai)
#pragma unroll
                for (int m = 0; m < 4; ++m) {
                    bf16_t* rowp = base + (size_t)(row0 + ai * HALF + m * 16) * 512 + colw;
#pragma unroll
                    for (int bj = 0; bj < 2; ++bj) {
                        const f32x4 v0 = acc[ai][bj][m][0] * sc, v1 = acc[ai][bj][m][1] * sc;
                        u32x4 w; w.x = cvt_pk_bf16(v0[0], v0[1]); w.y = cvt_pk_bf16(v0[2], v0[3]); w.z = cvt_pk_bf16(v1[0], v1[1]); w.w = cvt_pk_bf16(v1[2], v1[3]);
                        *(u32x4*)(rowp + bj * HALF) = w;
                    }
                }
            if (seg == 1) {
#pragma unroll
                for (int bj = 0; bj < 2; ++bj)
#pragma unroll
                    for (int n = 0; n < 2; ++n) {
                        f32x4 s = acc[0][bj][0][n];
#pragma unroll
                        for (int m = 1; m < 4; ++m) s += acc[0][bj][m][n];
#pragma unroll
                        for (int m = 0; m < 4; ++m) s += acc[1][bj][m][n];
#pragma unroll
                        for (int o = 1; o < 16; o <<= 1) { s[0] += __shfl_xor(s[0], o); s[1] += __shfl_xor(s[1], o); s[2] += __shfl_xor(s[2], o); s[3] += __shfl_xor(s[3], o); }
                        if (fr == 0) *(f32x4*)(kms + ((size_t)wr * NPANEL + u.pm) * 512 + colw + bj * HALF + 4 * n) = s;
                    }
            }
        }
    }
};
struct EpiY {
    static constexpr bool PERM = true, AFTER_DRAIN = false;
    bf16_t* Y; float* rowss;
    __device__ __forceinline__ void operator()(const f32x4 (&acc)[2][2][4][2], const Unit& u, int wr, int wc, int fr, int fq) const {
        const int row0 = u.pm * BM + wr * 64 + fr, colw = u.pn * BM + wc * 32 + 8 * fq;
#pragma unroll
        for (int ai = 0; ai < 2; ++ai)
#pragma unroll
            for (int m = 0; m < 4; ++m) {
                const int row = row0 + ai * HALF + m * 16;
                bf16_t* rowp = Y + (size_t)row * 1024 + colw; float ss = 0.f;
#pragma unroll
                for (int bj = 0; bj < 2; ++bj) {
                    const f32x4 v0 = acc[ai][bj][m][0], v1 = acc[ai][bj][m][1];
                    ss += (v0[0] * v0[0] + v0[1] * v0[1]) + (v0[2] * v0[2] + v0[3] * v0[3]) + (v1[0] * v1[0] + v1[1] * v1[1]) + (v1[2] * v1[2] + v1[3] * v1[3]);
                    u32x4 w; w.x = cvt_pk_bf16(v0[0], v0[1]); w.y = cvt_pk_bf16(v0[2], v0[3]); w.z = cvt_pk_bf16(v1[0], v1[1]); w.w = cvt_pk_bf16(v1[2], v1[3]);
                    *(u32x4*)(rowp + bj * HALF) = w;
                }
                ss += __shfl_xor(ss, 16); ss += __shfl_xor(ss, 32);
                if (fq == 0) rowss[(size_t)row * 16 + u.pn * 4 + wc] = ss;
            }
    }
};
}

constexpr int RING_OFF = 0, RING_BYTES = 131072;
constexpr int LDSCTL_OFF = RING_BYTES, MISC_OFF = LDSCTL_OFF + 320;
constexpr int LDS_BYTES = 147456;
constexpr int NWAVES = 8;

struct Frame {
    LAS unsigned char* lds; volatile LAS unsigned* MISC; gu32* ctl;
    int tid, lane, wave, vcu, G;
    const float *x, *g_mix_pre, *w_in, *rel_bias, *w_out, *g_mix_post, *g_ffn_pre, *w_up, *conv_w, *conv_b, *w_down, *g_ffn_post;
    float* out;
    bf16 *Win_t, *Wout_t, *Wup_t, *Wdn_t, *XN, *PROJ, *Y, *Y1, *U, *Fb;
    float *cs, *biasd, *dpos, *dneg, *gam, *g256, *kms, *rowss, *KV, *RP;
    unsigned* sel;
};

__device__ __forceinline__ float wave_sum(float v) {
#pragma unroll
    for (int o = 1; o < 64; o <<= 1) v += __shfl_xor(v, o);
    return v;
}

template <int MODE> __device__ __forceinline__ int src_col(int n) {
    if (MODE == 1) { const int seg = n >> 9; if (seg == 3 || seg == 4) { const int p = n & 63; return (n & ~63) + (p >> 1) + 32 * (p & 1); } }
    return n;
}
template <int MODE> __device__ __forceinline__ void p0_transpose_item(const float* W, const float* gain, int K, int N, bf16* WT, LAS float* scr, int item, int lane) {
    const int nblk = N / 32, kb = item / nblk, nb = item % nblk, k0 = 64 * kb, n0 = 32 * nb;
    const int sc = src_col<MODE>(n0 + (lane & 31));
#pragma unroll 8
    for (int i = 0; i < 32; ++i) { const int kk = 2 * i + (lane >> 5); const float g = gain ? gain[k0 + kk] : 1.0f; scr[kk * 33 + (lane & 31)] = W[(size_t)(k0 + kk) * N + sc] * g; }
    LDS_WAIT(); asm volatile("" ::: "memory");
    const int c = lane & 7;
#pragma unroll
    for (int j = 0; j < 4; ++j) { const int n = (lane >> 3) + 8 * j; const LAS float* s = scr + (8 * c) * 33 + n;
        v4u o; o.x = pk2(s[0 * 33], s[1 * 33]); o.y = pk2(s[2 * 33], s[3 * 33]); o.z = pk2(s[4 * 33], s[5 * 33]); o.w = pk2(s[6 * 33], s[7 * 33]);
        *(GAS v4u*)(WT + (size_t)(n0 + n) * K + k0 + 8 * c) = o; }
    LDS_WAIT(); asm volatile("" ::: "memory");
}
__device__ __forceinline__ int t5_bucket(int n) {
    if (n < 16) return n;
    int l = 16 + (int)(__logf((float)n * (1.0f / 16.0f)) / __logf(8.0f) * 16.0f);
    return l < 31 ? l : 31;
}
__device__ __forceinline__ void p0_prologue(Frame& F) {
    LAS float* scr = (LAS float*)(F.lds + RING_OFF + F.wave * 16384);
    const int gw = F.vcu * NWAVES + F.wave, NGW = F.G * NWAVES;
    constexpr int I_IN = (DM / 64) * (NPROJ / 32), I_OUT = (DM / 64) * (DM / 32), I_UP = (DM / 64) * (NUP / 32), I_DN = (DFF / 64) * (DM / 32);
    for (int it = gw; it < I_IN + I_OUT + I_UP + I_DN; it += NGW) {
        int r = it;
        if (r < I_IN) { p0_transpose_item<1>(F.w_in, F.g_mix_pre, DM, NPROJ, F.Win_t, scr, r, F.lane); continue; } r -= I_IN;
        if (r < I_OUT) { p0_transpose_item<0>(F.w_out, nullptr, DM, DM, F.Wout_t, scr, r, F.lane); continue; } r -= I_OUT;
        if (r < I_UP) { p0_transpose_item<0>(F.w_up, F.g_ffn_pre, DM, NUP, F.Wup_t, scr, r, F.lane); continue; } r -= I_UP;
        p0_transpose_item<0>(F.w_down, nullptr, DFF, DM, F.Wdn_t, scr, r, F.lane);
    }
    for (int m = gw; m < TT; m += NGW) {
        const GAS f32x4* xr = (const GAS f32x4*)(F.x + (size_t)m * DM) + F.lane;
        f32x4 v[4]; float s = 0.f;
#pragma unroll
        for (int j = 0; j < 4; ++j) { v[j] = xr[64 * j]; s += (v[j].x * v[j].x + v[j].y * v[j].y) + (v[j].z * v[j].z + v[j].w * v[j].w); }
        const float rstd = 1.0f / sqrtf(wave_sum(s) * (1.f / DM) + EPS);
        GAS unsigned long long* o8 = (GAS unsigned long long*)(F.XN + (size_t)m * DM) + F.lane;
#pragma unroll
        for (int j = 0; j < 4; ++j) o8[64 * j] = (unsigned long long)pk2(v[j].x * rstd, v[j].y * rstd) | ((unsigned long long)pk2(v[j].z * rstd, v[j].w * rstd) << 32);
    }
    const int gt = blockIdx.x * (NWAVES * 64) + F.tid, NT = F.G * NWAVES * 64;
    for (int i = gt; i < SEQ * 32; i += NT) {
        const int t = i >> 5, k = i & 31;
        double inv = 1.0; for (int q = 0; q < k; ++q) inv *= 0.74989420933245582730;
        const float ang = (float)t * (float)inv;
        const double rev = (double)ang * 0.15915494309189533577; const double fr = rev - __builtin_rint(rev);
        F.cs[2 * i] = __builtin_amdgcn_cosf((float)fr); F.cs[2 * i + 1] = __builtin_amdgcn_sinf((float)fr);
    }
    for (int i = gt; i < NH * 256; i += NT) {
        const int h = i >> 8, n = i & 255; const double g = 1.0 - 1.0 / (double)(32 << h);
        double p = 1.0; for (int q = 0; q < n; ++q) p *= g;
        F.dpos[i] = (float)p; F.dneg[i] = (float)(1.0 / p);
        if (n == 255) { F.gam[h] = (float)g; F.g256[h] = (float)(p * g); }
    }
    for (int i = gt; i < NH * 132; i += NT) { const int h = i / 132, d = i % 132; F.biasd[i] = F.rel_bias[t5_bucket(d < 128 ? d : 128) * NH + h]; }
}

__device__ __forceinline__ void p2_gate(Frame& F) {
    LAS float* km = (LAS float*)(F.lds + RING_OFF);
    const bf16* QA = F.PROJ;
    for (int it = blockIdx.x; it < 512; it += F.G) {
        const int cp = 31 - (it & 31), bh = it >> 5, b = bh >> 3, h = bh & 7, c0 = 2 * cp, nj = c0 + 1;
        __syncthreads();
        for (int i = F.tid; i < nj * 64; i += NWAVES * 64) { const int j = i >> 6, d = i & 63; const size_t o = (size_t)(b * 64 + j) * 512 + h * 64 + d;
            km[i] = (F.kms[o] + F.kms[(size_t)NPANEL * 512 + o]) * (1.0f / 256.0f); }
        __syncthreads();
        const int t = c0 * 256 + F.tid, c = t >> 8; const size_t row = (size_t)b * SEQ + t;
        float q[64];
        { const GAS u32x4v* qp = (const GAS u32x4v*)(QA + row * 512 + h * 64);
#pragma unroll
          for (int i = 0; i < 8; ++i) { const u32x4v w = qp[i]; q[8 * i] = bflo(w.x); q[8 * i + 1] = bfhi(w.x); q[8 * i + 2] = bflo(w.y); q[8 * i + 3] = bfhi(w.y); q[8 * i + 4] = bflo(w.z); q[8 * i + 5] = bfhi(w.z); q[8 * i + 6] = bflo(w.w); q[8 * i + 7] = bfhi(w.w); } }
        float v0 = -INFINITY, v1 = -INFINITY, v2 = -INFINITY; unsigned i0 = 255u, i1 = 255u, i2 = 255u;
        for (int j = 0; j < c; ++j) {
            const LAS f32x4* kp = (const LAS f32x4*)(km + j * 64); float g = 0.f;
#pragma unroll
            for (int i = 0; i < 16; ++i) { const f32x4 k4 = kp[i]; g += q[4 * i] * k4.x + q[4 * i + 1] * k4.y + q[4 * i + 2] * k4.z + q[4 * i + 3] * k4.w; }
            if (g > v0) { v2 = v1; i2 = i1; v1 = v0; i1 = i0; v0 = g; i0 = (unsigned)j; }
            else if (g > v1) { v2 = v1; i2 = i1; v1 = g; i1 = (unsigned)j; }
            else if (g > v2) { v2 = g; i2 = (unsigned)j; }
        }
        F.sel[row * 8 + h] = i0 | (i1 << 8) | (i2 << 16);
    }
}
__device__ __forceinline__ void p2_kv_simple(Frame& F) {
    const bf16* KR = F.PROJ + 4 * (size_t)TT * 512; const bf16* VR = F.PROJ + 5 * (size_t)TT * 512;
    for (int it = blockIdx.x; it < 1024; it += F.G) {
        const int b = it >> 9, h = (it >> 6) & 7, c = it & 63; const size_t row0 = (size_t)b * SEQ + c * 256;
        const int d = F.tid >> 3, e0 = (F.tid & 7) * 8; float a[8];
#pragma unroll
        for (int i = 0; i < 8; ++i) a[i] = 0.f;
        for (int m = 0; m < 256; ++m) {
            const float kk = bf1(KR[(row0 + m) * 512 + h * 64 + d]);
            const u32x4v w = *(const GAS u32x4v*)(VR + (row0 + m) * 512 + h * 64 + e0);
            a[0] += kk * bflo(w.x); a[1] += kk * bfhi(w.x); a[2] += kk * bflo(w.y); a[3] += kk * bfhi(w.y); a[4] += kk * bflo(w.z); a[5] += kk * bfhi(w.z); a[6] += kk * bflo(w.w); a[7] += kk * bfhi(w.w);
        }
        const float sc = F.dpos[h * 256 + 255];
#pragma unroll
        for (int i = 0; i < 8; ++i) F.KV[(size_t)it * 4096 + d * 64 + e0 + i] = a[i] * sc;
    }
}
__device__ __forceinline__ void p3_scan(Frame& F) {
    const int gt = blockIdx.x * (NWAVES * 64) + F.tid;
    if (gt < 16 * 4096) {
        const int bh = gt >> 12, idx = gt & 4095, h = bh & 7; const float g = F.g256[h]; float st = 0.f;
        for (int c = 0; c < 64; ++c) { const size_t o = ((size_t)(bh * 64 + c)) * 4096 + idx; F.RP[o] = st; st = st * g + F.KV[o]; }
    }
}
__device__ __forceinline__ void p3_moba_simple(Frame& F) {
    const bf16* QA = F.PROJ; const bf16* KA = F.PROJ + (size_t)TT * 512; const bf16* VA = F.PROJ + 2 * (size_t)TT * 512;
    const int gt = blockIdx.x * (NWAVES * 64) + F.tid, NT = F.G * NWAVES * 64;
    for (int idx = gt; idx < TT * NH; idx += NT) {
        const int h = idx >> 15, row = idx & (TT - 1), b = row >> 14, t = row & (SEQ - 1), c = t >> 8;
        float q[64], o[64];
        { const GAS u32x4v* qp = (const GAS u32x4v*)(QA + (size_t)row * 512 + h * 64);
#pragma unroll
          for (int i = 0; i < 8; ++i) { const u32x4v w = qp[i]; q[8 * i] = bflo(w.x); q[8 * i + 1] = bfhi(w.x); q[8 * i + 2] = bflo(w.y); q[8 * i + 3] = bfhi(w.y); q[8 * i + 4] = bflo(w.z); q[8 * i + 5] = bfhi(w.z); q[8 * i + 6] = bflo(w.w); q[8 * i + 7] = bfhi(w.w); } }
#pragma unroll
        for (int i = 0; i < 64; ++i) o[i] = 0.f;
        const unsigned sw = F.sel[(size_t)row * 8 + h]; const float* bd = F.biasd + h * 132;
        float mrun = -3.0e38f, l = 0.f;
        for (int slot = 0; slot < 4; ++slot) {
            const int j = slot < 3 ? (int)((sw >> (8 * slot)) & 255u) : c;
            if (slot < 3 && j >= c) continue;
            const size_t r0 = (size_t)b * SEQ + j * 256;
            for (int s = 0; s < 256; ++s) {
                const int pos = j * 256 + s; if (pos > t) break;
                const GAS u32x4v* kp = (const GAS u32x4v*)(KA + (r0 + s) * 512 + h * 64); float dot = 0.f;
#pragma unroll
                for (int i = 0; i < 8; ++i) { const u32x4v w = kp[i]; dot += q[8 * i] * bflo(w.x) + q[8 * i + 1] * bfhi(w.x) + q[8 * i + 2] * bflo(w.y) + q[8 * i + 3] * bfhi(w.y) + q[8 * i + 4] * bflo(w.z) + q[8 * i + 5] * bfhi(w.z) + q[8 * i + 6] * bflo(w.w) + q[8 * i + 7] * bfhi(w.w); }
                const int dist = t - pos; const float sc = dot + bd[dist < 128 ? dist : 128];
                if (sc > mrun) { const float a = __expf(mrun - sc); l *= a;
#pragma unroll
                    for (int i = 0; i < 64; ++i) o[i] *= a;
                    mrun = sc; }
                const float p = __expf(sc - mrun); l += p;
                const GAS u32x4v* vp = (const GAS u32x4v*)(VA + (r0 + s) * 512 + h * 64);
#pragma unroll
                for (int i = 0; i < 8; ++i) { const u32x4v w = vp[i]; o[8 * i] += p * bflo(w.x); o[8 * i + 1] += p * bfhi(w.x); o[8 * i + 2] += p * bflo(w.y); o[8 * i + 3] += p * bfhi(w.y); o[8 * i + 4] += p * bflo(w.z); o[8 * i + 5] += p * bfhi(w.z); o[8 * i + 6] += p * bflo(w.w); o[8 * i + 7] += p * bfhi(w.w); }
            }
        }
        const float il = 1.0f / l;
        GAS u32x4v* yp = (GAS u32x4v*)(F.Y + (size_t)row * 1024 + h * 64);
#pragma unroll
        for (int i = 0; i < 8; ++i) { u32x4v w; w.x = pk2(o[8 * i] * il, o[8 * i + 1] * il); w.y = pk2(o[8 * i + 2] * il, o[8 * i + 3] * il); w.z = pk2(o[8 * i + 4] * il, o[8 * i + 5] * il); w.w = pk2(o[8 * i + 6] * il, o[8 * i + 7] * il); yp[i] = w; }
    }
}
__device__ __forceinline__ void p4_ret_simple(Frame& F) {
    const bf16* QR = F.PROJ + 3 * (size_t)TT * 512; const bf16* KR = F.PROJ + 4 * (size_t)TT * 512; const bf16* VR = F.PROJ + 5 * (size_t)TT * 512; const bf16* GR = F.PROJ + 6 * (size_t)TT * 512;
    const int gt = blockIdx.x * (NWAVES * 64) + F.tid, NT = F.G * NWAVES * 64;
    for (int idx = gt; idx < TT * NH; idx += NT) {
        const int h = idx >> 15, row = idx & (TT - 1), b = row >> 14, t = row & (SEQ - 1), c = t >> 8, n = t & 255;
        float q[64], y[64];
        { const GAS u32x4v* qp = (const GAS u32x4v*)(QR + (size_t)row * 512 + h * 64);
#pragma unroll
          for (int i = 0; i < 8; ++i) { const u32x4v w = qp[i]; q[8 * i] = bflo(w.x); q[8 * i + 1] = bfhi(w.x); q[8 * i + 2] = bflo(w.y); q[8 * i + 3] = bfhi(w.y); q[8 * i + 4] = bflo(w.z); q[8 * i + 5] = bfhi(w.z); q[8 * i + 6] = bflo(w.w); q[8 * i + 7] = bfhi(w.w); } }
#pragma unroll
        for (int i = 0; i < 64; ++i) y[i] = 0.f;
        const size_t r0 = (size_t)row - n;
        for (int m = 0; m <= n; ++m) {
            const GAS u32x4v* kp = (const GAS u32x4v*)(KR + (r0 + m) * 512 + h * 64); float dot = 0.f;
#pragma unroll
            for (int i = 0; i < 8; ++i) { const u32x4v w = kp[i]; dot += q[8 * i] * bflo(w.x) + q[8 * i + 1] * bfhi(w.x) + q[8 * i + 2] * bflo(w.y) + q[8 * i + 3] * bfhi(w.y) + q[8 * i + 4] * bflo(w.z) + q[8 * i + 5] * bfhi(w.z) + q[8 * i + 6] * bflo(w.w) + q[8 * i + 7] * bfhi(w.w); }
            const GAS u32x4v* vp = (const GAS u32x4v*)(VR + (r0 + m) * 512 + h * 64);
#pragma unroll
            for (int i = 0; i < 8; ++i) { const u32x4v w = vp[i]; y[8 * i] += dot * bflo(w.x); y[8 * i + 1] += dot * bfhi(w.x); y[8 * i + 2] += dot * bflo(w.y); y[8 * i + 3] += dot * bfhi(w.y); y[8 * i + 4] += dot * bflo(w.z); y[8 * i + 5] += dot * bfhi(w.z); y[8 * i + 6] += dot * bflo(w.w); y[8 * i + 7] += dot * bfhi(w.w); }
        }
        const float* R = F.RP + ((size_t)((b * 8 + h) * 64 + c)) * 4096; const float gam = F.gam[h];
        const bf16* qrow = QR + (size_t)row * 512 + h * 64;
        for (int d = 0; d < 64; ++d) {
            const float qd = bf1(qrow[d]) * gam; const GAS f32x4* rp = (const GAS f32x4*)(R + d * 64);
#pragma unroll
            for (int i = 0; i < 16; ++i) { const f32x4 r4 = rp[i]; y[4 * i] += qd * r4.x; y[4 * i + 1] += qd * r4.y; y[4 * i + 2] += qd * r4.z; y[4 * i + 3] += qd * r4.w; }
        }
        float mu = 0.f;
#pragma unroll
        for (int i = 0; i < 64; ++i) mu += y[i];
        mu *= (1.f / 64.f); float var = 0.f;
#pragma unroll
        for (int i = 0; i < 64; ++i) { y[i] -= mu; var += y[i] * y[i]; }
        const float rs = 1.0f / sqrtf(var * (1.f / 64.f) + EPS);
        const GAS u32x4v* gp = (const GAS u32x4v*)(GR + (size_t)row * 512 + h * 64);
        GAS u32x4v* yp = (GAS u32x4v*)(F.Y + (size_t)row * 1024 + 512 + h * 64);
#pragma unroll
        for (int i = 0; i < 8; ++i) { const u32x4v w = gp[i]; float g[8] = {bflo(w.x), bfhi(w.x), bflo(w.y), bfhi(w.y), bflo(w.z), bfhi(w.z), bflo(w.w), bfhi(w.w)}; float r[8];
#pragma unroll
            for (int k = 0; k < 8; ++k) r[k] = g[k] / (1.0f + __expf(-g[k])) * (y[8 * i + k] * rs);
            u32x4v ow; ow.x = pk2(r[0], r[1]); ow.y = pk2(r[2], r[3]); ow.z = pk2(r[4], r[5]); ow.w = pk2(r[6], r[7]); yp[i] = ow; }
    }
}
__device__ __forceinline__ void rows_residual(Frame& F, const float* xin, const bf16* Yb, const float* gpost, float* xout, bf16* XNo) {
    const int gw = F.vcu * NWAVES + F.wave, NGW = F.G * NWAVES;
    for (int m = gw; m < TT; m += NGW) {
        float ss = 0.f;
        { const GAS f32x4* rp = (const GAS f32x4*)(F.rowss + (size_t)m * 16);
#pragma unroll
          for (int i = 0; i < 4; ++i) { const f32x4 r = rp[i]; ss += (r.x + r.y) + (r.z + r.w); } }
        const float rstd = 1.0f / sqrtf(ss * (1.f / DM) + EPS);
        const GAS f32x4* xr = (const GAS f32x4*)(xin + (size_t)m * DM) + F.lane;
        const GAS u32x2v* yr = (const GAS u32x2v*)(Yb + (size_t)m * DM) + F.lane;
        const GAS f32x4* gr = (const GAS f32x4*)gpost + F.lane;
        GAS f32x4* orow = (GAS f32x4*)(xout + (size_t)m * DM) + F.lane;
        f32x4 v[4]; float s2 = 0.f;
#pragma unroll
        for (int j = 0; j < 4; ++j) { const f32x4 xv = xr[64 * j]; const u32x2v yw = yr[64 * j]; const f32x4 g = gr[64 * j];
            v[j].x = xv.x + bflo(yw.x) * rstd * g.x; v[j].y = xv.y + bfhi(yw.x) * rstd * g.y; v[j].z = xv.z + bflo(yw.y) * rstd * g.z; v[j].w = xv.w + bfhi(yw.y) * rstd * g.w;
            orow[64 * j] = v[j]; s2 += (v[j].x * v[j].x + v[j].y * v[j].y) + (v[j].z * v[j].z + v[j].w * v[j].w); }
        if (XNo) {
            const float r2 = 1.0f / sqrtf(wave_sum(s2) * (1.f / DM) + EPS);
            GAS unsigned long long* o8 = (GAS unsigned long long*)(XNo + (size_t)m * DM) + F.lane;
#pragma unroll
            for (int j = 0; j < 4; ++j) o8[64 * j] = (unsigned long long)pk2(v[j].x * r2, v[j].y * r2) | ((unsigned long long)pk2(v[j].z * r2, v[j].w * r2) << 32);
        }
    }
}
__device__ __forceinline__ float gelu_tanh(float a) { const float z = 0.7978845608028654f * (a + 0.044715f * a * a * a); return a * (1.0f - 1.0f / (__expf(2.0f * z) + 1.0f)); }
__device__ __forceinline__ void p8_conv(Frame& F, int hb) {
    const int gw = F.vcu * NWAVES + F.wave, NGW = F.G * NWAVES;
    constexpr int RSEG = 32, NSEG = SEQ / RSEG;
    for (int it = gw; it < 11 * NSEG; it += NGW) {
        const int strip = it % 11, seg = it / 11, c = strip * 256 + F.lane * 4, r0 = seg * RSEG;
        f32x4 wa[3], wb[3];
#pragma unroll
        for (int j = 0; j < 3; ++j) { wa[j] = *(const GAS f32x4*)(F.conv_w + (size_t)j * NUP + c); wb[j] = *(const GAS f32x4*)(F.conv_w + (size_t)j * NUP + DFF + c); }
        const f32x4 ba = *(const GAS f32x4*)(F.conv_b + c), bb = *(const GAS f32x4*)(F.conv_b + DFF + c);
        f32x4 a2 = {0.f, 0.f, 0.f, 0.f}, a1 = a2, b2 = a2, b1 = a2;
#define P8_LD(r, ua, ub) do { const u32x2v wa_ = *(const GAS u32x2v*)(Ub + (size_t)(r) * NUP + c), wb_ = *(const GAS u32x2v*)(Ub + (size_t)(r) * NUP + DFF + c); \
            ua = (f32x4){bflo(wa_.x), bfhi(wa_.x), bflo(wa_.y), bfhi(wa_.y)}; ub = (f32x4){bflo(wb_.x), bfhi(wb_.x), bflo(wb_.y), bfhi(wb_.y)}; } while (0)
        const bf16* Ub = F.U;
        if (r0 >= 2) { P8_LD(r0 - 2, a2, b2); P8_LD(r0 - 1, a1, b1); }
        for (int r = r0; r < r0 + RSEG; ++r) {
            f32x4 ua, ub; P8_LD(r, ua, ub);
            const f32x4 av = ba + wa[0] * a2 + wa[1] * a1 + wa[2] * ua, bv = bb + wb[0] * b2 + wb[1] * b1 + wb[2] * ub;
            u32x2v o; o.x = pk2(gelu_tanh(av.x) * bv.x, gelu_tanh(av.y) * bv.y); o.y = pk2(gelu_tanh(av.z) * bv.z, gelu_tanh(av.w) * bv.w);
            *(GAS u32x2v*)(F.Fb + ((size_t)hb * SEQ + r) * DFF + c) = o;
            a2 = a1; a1 = ua; b2 = b1; b1 = ub;
        }
    }
}

constexpr int NPHASE = 13;
struct Args { const float* in[12]; float* out; unsigned char* ws; int ph_lo, ph_hi; };
__global__ void __launch_bounds__(NWAVES * 64, 2) fwd_kernel(Args args) {
    extern __shared__ __attribute__((aligned(16))) unsigned char lds[];
    Frame F;
    F.lds = (LAS unsigned char*)lds; F.MISC = (volatile LAS unsigned*)(F.lds + MISC_OFF);
    F.tid = threadIdx.x; F.lane = F.tid & 63; F.wave = __builtin_amdgcn_readfirstlane(F.tid >> 6);
    F.G = gridDim.x; { const int bx = blockIdx.x; F.vcu = (F.G % 8 == 0) ? (bx % 8) * (F.G / 8) + bx / 8 : bx; }
    unsigned char* ws = args.ws;
    F.ctl = (gu32*)(ws + WS_CTL);
    F.x = args.in[0]; F.g_mix_pre = args.in[1]; F.w_in = args.in[2]; F.rel_bias = args.in[3]; F.w_out = args.in[4]; F.g_mix_post = args.in[5];
    F.g_ffn_pre = args.in[6]; F.w_up = args.in[7]; F.conv_w = args.in[8]; F.conv_b = args.in[9]; F.w_down = args.in[10]; F.g_ffn_post = args.in[11]; F.out = args.out;
    F.Win_t = (bf16*)(ws + WS_WIN); F.Wout_t = (bf16*)(ws + WS_WOUT); F.Wup_t = (bf16*)(ws + WS_WUP); F.Wdn_t = (bf16*)(ws + WS_WDN);
    F.XN = (bf16*)(ws + WS_XN); F.PROJ = (bf16*)(ws + WS_PROJ); F.Y = (bf16*)(ws + WS_Y); F.Y1 = (bf16*)(ws + WS_Y1); F.U = (bf16*)(ws + WS_U); F.Fb = (bf16*)(ws + WS_F);
    F.cs = (float*)(ws + WS_CS); F.biasd = (float*)(ws + WS_SMALL + SM_BIASD); F.dpos = (float*)(ws + WS_SMALL + SM_DPOS); F.dneg = (float*)(ws + WS_SMALL + SM_DNEG);
    F.gam = (float*)(ws + WS_SMALL + SM_GAM); F.g256 = (float*)(ws + WS_SMALL + SM_G256);
    F.kms = (float*)(ws + WS_KMS); F.rowss = (float*)(ws + WS_ROWSS); F.KV = (float*)(ws + WS_KV); F.RP = (float*)(ws + WS_RP); F.sel = (unsigned*)(ws + WS_SEL);
    for (int u = F.tid; u < (LDS_BYTES - LDSCTL_OFF) / 4; u += NWAVES * 64) ((LAS unsigned*)(F.lds + LDSCTL_OFF))[u] = 0u;
    __syncthreads();
    XcdBarrier bar; bar.bar = (unsigned*)(F.ctl + CW_BAR); bar.x = 0; bar.st = nullptr;
    if (MK_ONE_LAUNCH) bar = xcd_barrier_post((unsigned*)(F.ctl + CW_BAR), F.MISC + 8);
    const int lo = args.ph_lo, hi = args.ph_hi;
#define IN(k) (lo <= (k) && (k) < hi)
#define SEAM(k) do { if (IN(k) && IN((k) + 1)) xcd_barrier(bar); } while (0)

    if (IN(0)) { p0_prologue(F); }
#if MK_ONE_LAUNCH
    if (IN(0) && IN(1)) { cooperative_groups::this_grid().sync(); }
#endif
    if (IN(1)) {
        pg8::Gemm g{F.XN, F.Win_t, TT, NPROJ, DM}; pg8::StaticOrder S; S.init(TT, NPROJ, F.G, (int)blockIdx.x);
        pg8::EpiProj E{F.PROJ, F.cs, F.dpos, F.dneg, F.kms};
        pg8::gemm_phase<pg8::EpiProj, pg8::StaticOrder, PG8_ALIGN, PG8_SP2>(F.lds + RING_OFF, g, S, E);
    } SEAM(1);
    if (IN(2)) { p2_gate(F); p2_kv_simple(F); } SEAM(2);
    if (IN(3)) { p3_scan(F); p3_moba_simple(F); } SEAM(3);
    if (IN(4)) { p4_ret_simple(F); } SEAM(4);
    if (IN(5)) {
        pg8::Gemm g{F.Y, F.Wout_t, TT, DM, DM}; pg8::StaticOrder S; S.init(TT, DM, F.G, (int)blockIdx.x);
        pg8::EpiY E{F.Y1, F.rowss};
        pg8::gemm_phase<pg8::EpiY, pg8::StaticOrder, PG8_ALIGN, PG8_SP2>(F.lds + RING_OFF, g, S, E);
    } SEAM(5);
    if (IN(6)) { rows_residual(F, F.x, F.Y1, F.g_mix_post, F.out, F.XN); } SEAM(6);
#pragma unroll 1
    for (int hb = 0; hb < 2; ++hb) {
        if (IN(7 + 2 * hb)) {
            pg8::Gemm g{F.XN + (size_t)hb * SEQ * DM, F.Wup_t, SEQ, NUP, DM}; pg8::StaticOrder S; S.init(SEQ, NUP, F.G, (int)blockIdx.x);
            pg8::EpiBf16<0> E{F.U, NUP, nullptr, 0, 0, 1.f};
            pg8::gemm_phase<pg8::EpiBf16<0>, pg8::StaticOrder, PG8_ALIGN, PG8_SP2>(F.lds + RING_OFF, g, S, E);
        } SEAM(7 + 2 * hb);
        if (IN(8 + 2 * hb)) { p8_conv(F, hb); } SEAM(8 + 2 * hb);
    }
    if (IN(11)) {
        pg8::Gemm g{F.Fb, F.Wdn_t, TT, DM, DFF}; pg8::StaticOrder S; S.init(TT, DM, F.G, (int)blockIdx.x);
        pg8::EpiY E{F.Y1, F.rowss};
        pg8::gemm_phase<pg8::EpiY, pg8::StaticOrder, PG8_ALIGN, PG8_SP2>(F.lds + RING_OFF, g, S, E);
    } SEAM(11);
    if (IN(12)) { rows_residual(F, F.out, F.Y1, F.g_ffn_post, F.out, nullptr); }
#undef IN
#undef SEAM
}

extern "C" void kernel_launch(void* const* d_in, const int* in_sizes, int n_in, void* d_out, int out_size, void* d_ws, size_t ws_size, hipStream_t stream) {
    static int grid = 0;
    if (grid == 0) {
        if (n_in != 12 || in_sizes[0] != TT * DM || out_size != TT * DM || ws_size < WS_END) { fprintf(stderr, "kernel_launch: unexpected shapes (n_in %d in0 %d out %d ws %zu)\n", n_in, n_in > 0 ? in_sizes[0] : -1, out_size, ws_size); grid = -1; return; }
        int dev = 0, cus = 0, per_cu = 0;
        if (hipGetDevice(&dev) != hipSuccess || hipDeviceGetAttribute(&cus, hipDeviceAttributeMultiprocessorCount, dev) != hipSuccess) { grid = -1; return; }
        if (hipFuncSetAttribute((const void*)fwd_kernel, hipFuncAttributeMaxDynamicSharedMemorySize, LDS_BYTES) != hipSuccess) { fprintf(stderr, "kernel_launch: hipFuncSetAttribute failed\n"); grid = -1; return; }
        if (hipOccupancyMaxActiveBlocksPerMultiprocessor(&per_cu, (const void*)fwd_kernel, NWAVES * 64, LDS_BYTES) != hipSuccess || per_cu < 1) { fprintf(stderr, "kernel_launch: occupancy query says %d\n", per_cu); per_cu = 1; }
        (void)hipGetLastError();
        grid = cus * (per_cu < 1 ? 1 : 1);
    }
    if (grid < 0) return;
    if (hipMemsetAsync((char*)d_ws + WS_CTL, 0, CTL_ZERO_BYTES, stream) != hipSuccess) { fprintf(stderr, "kernel_launch: memset failed\n"); return; }
    Args a{};
    for (int i = 0; i < 12; ++i) a.in[i] = (const float*)d_in[i];
    a.out = (float*)d_out; a.ws = (unsigned char*)d_ws;
#if MK_ONE_LAUNCH
    a.ph_lo = 0; a.ph_hi = NPHASE;
    void* kargs[] = {&a};
    hipError_t e = hipLaunchCooperativeKernel((const void*)fwd_kernel, dim3(grid), dim3(NWAVES * 64), kargs, LDS_BYTES, stream);
    if (e != hipSuccess) fprintf(stderr, "kernel_launch: cooperative launch failed: %s\n", hipGetErrorString(e));
#else
    for (int p = 0; p < NPHASE; ++p) { a.ph_lo = p; a.ph_hi = p + 1; hipLaunchKernelGGL(fwd_kernel, dim3(grid), dim3(NWAVES * 64), LDS_BYTES, stream, a); }
#endif
}
```

```cpp
#include <hip/hip_runtime.h>
#include <hip/hip_cooperative_groups.h>
#include <cstdio>
#include <cstdint>
#define MK_ONE_LAUNCH 1
namespace pg8 {
#define PG8_LAS __attribute__((address_space(3)))
typedef unsigned short bf16_t;
typedef short bf16x8 __attribute__((ext_vector_type(8)));
typedef float f32x4 __attribute__((ext_vector_type(4)));
typedef unsigned u32x4 __attribute__((ext_vector_type(4)));
constexpr int BM = 256, BK = 64, HALF = 128, HTB = HALF * BK * 2  , STAGE_BYTES = 8 * HTB, NXCD = 8, WGM = 8;

__host__ __device__ __forceinline__ int lds_byte(int r, int c) { const int st = (r >> 4) * 2 + (c >> 5), rr = r & 15, cc = c & 31, ob = rr * 64 + cc * 2; return st * 1024 + (ob ^ (((ob >> 9) & 1) << 5)); }
__host__ __device__ __forceinline__ void stage_rc(int b, int& R, int& C) { const int st = b / 1024, sb = b % 1024, swz = sb ^ (((sb >> 9) & 1) << 5); R = (st >> 1) * 16 + swz / 64; C = (st & 1) * 32 + (swz % 64) / 2; }
__host__ __device__ __forceinline__ int perm32(int rho) { const int n = rho >> 4, i = rho & 15; return 8 * (i >> 2) + 4 * n + (i & 3); }

struct Unit { int pm, pn; };
struct Gemm { const bf16_t* A; const bf16_t* Bt; int M, N, K; };

struct StaticOrder {
    int nM, nN, nwg, G, c;
    __host__ __device__ void init(int M, int N, int G_, int c_) { nM = M / BM; nN = N / BM; nwg = nM * nN; G = G_; c = c_; }
    __host__ __device__ bool next(int i, Unit& u) const {
        const long L = (long)i * G + c; if (L >= nwg) return false;
        int wgid = (int)L; { const int q = nwg / NXCD, r = nwg % NXCD, xcd = wgid % NXCD, off = wgid / NXCD; wgid = (xcd < r ? xcd * (q + 1) : r * (q + 1) + (xcd - r) * q) + off; }
        const int nig = WGM * nN, gid = wgid / nig, fm = gid * WGM, gsz = (nM - fm) < WGM ? (nM - fm) : WGM;
        u.pm = fm + ((wgid % nig) % gsz); u.pn = (wgid % nig) / gsz; return true;
    }
    __device__ __forceinline__ void a_ready(const Unit&) const {}
    __device__ __forceinline__ void done(const Unit&) const {}
};

__device__ __forceinline__ unsigned cvt_pk_bf16(float lo, float hi) { unsigned r; asm volatile("v_cvt_pk_bf16_f32 %0, %1, %2" : "=v"(r) : "v"(lo), "v"(hi)); return r; }
typedef float f32x2 __attribute__((ext_vector_type(2)));
__device__ __forceinline__ f32x2 gelu_pk(f32x2 v) {
    const f32x2 av = __builtin_elementwise_abs(v), d = av * 0.2316418882f + 1.0f;
    f32x2 t; t.x = __builtin_amdgcn_rcpf(d.x); t.y = __builtin_amdgcn_rcpf(d.y);
    f32x2 q = t * 0.5307027145f + (-0.7265760135f); q = q * t + 0.7107068705f; q = q * t + (-0.142248368f); q = q * t + 0.127414796f; q = q * t;
    const f32x2 s = (v * v) * (-0.72134752044f);
    f32x2 e; e.x = __builtin_amdgcn_exp2f(s.x); e.y = __builtin_amdgcn_exp2f(s.y);
    const f32x2 m = v * (q * e), r = v - m;
    f32x2 o; o.x = v.x < 0.f ? m.x : r.x; o.y = v.y < 0.f ? m.y : r.y; return o;
}

template <int ACT  > struct EpiBf16 {
    static constexpr bool PERM = true, AFTER_DRAIN = false; static_assert(ACT == 0 || ACT == 1, "EpiBf16: ACT is 0 (none) or 1 (gelu_pk)");
    bf16_t* O; int ldc; const float* bias; int split_cols; size_t split_stride; float scale0;
    __device__ __forceinline__ void operator()(const f32x4 (&acc)[2][2][4][2], const Unit& u, int wr, int wc, int fr, int fq) const {
        const int row0 = u.pm * BM + wr * 64 + fr; int colt = u.pn * BM; bf16_t* base = O;
        float sc = 1.f; if (split_cols) { const int t = colt / split_cols; base += (size_t)t * split_stride; colt -= t * split_cols; if (t == 0) sc = scale0; }
        const int col0 = colt + wc * 32 + 8 * fq, bcol0 = u.pn * BM + wc * 32 + 8 * fq;
        f32x4 bv[2][2];
#pragma unroll
        for (int bj = 0; bj < 2; ++bj)
#pragma unroll
            for (int n = 0; n < 2; ++n) bv[bj][n] = bias ? *(const f32x4*)(bias + bcol0 + bj * HALF + 4 * n) : (f32x4){0.f, 0.f, 0.f, 0.f};
#pragma unroll
        for (int ai = 0; ai < 2; ++ai)
#pragma unroll
            for (int m = 0; m < 4; ++m) { bf16_t* rowp = base + (size_t)(row0 + ai * HALF + m * 16) * ldc + col0;
#pragma unroll
                for (int bj = 0; bj < 2; ++bj) { f32x4 v0 = acc[ai][bj][m][0] + bv[bj][0], v1 = acc[ai][bj][m][1] + bv[bj][1];
                    if (ACT == 1) { f32x2 a = gelu_pk((f32x2){v0[0], v0[1]}), b = gelu_pk((f32x2){v0[2], v0[3]}), c = gelu_pk((f32x2){v1[0], v1[1]}), d = gelu_pk((f32x2){v1[2], v1[3]});
                        v0 = (f32x4){a.x, a.y, b.x, b.y}; v1 = (f32x4){c.x, c.y, d.x, d.y}; }
                    v0 = v0 * sc; v1 = v1 * sc; u32x4 w; w.x = cvt_pk_bf16(v0[0], v0[1]); w.y = cvt_pk_bf16(v0[2], v0[3]); w.z = cvt_pk_bf16(v1[0], v1[1]); w.w = cvt_pk_bf16(v1[2], v1[3]);
                    *(u32x4*)(rowp + bj * HALF) = w; } }
    }
};
template <class Epi, class Sched, bool ALIGN_EPI = false, bool SP2 = false>
__device__ __forceinline__ void gemm_phase(PG8_LAS unsigned char* lds, const Gemm g, const Sched& S, const Epi& E) {
    const int tid = threadIdx.x, wid = __builtin_amdgcn_readfirstlane(tid >> 6), lane = tid & 63, wr = wid >> 2, wc = wid & 3, fr = lane & 15, fq = lane >> 4;
    const int K = g.K, nt = K / BK;
    unsigned voffA[2], voffB[2];
#pragma unroll
    for (int i = 0; i < 2; ++i) { int R, C; stage_rc(tid * 16 + i * 8192, R, C); const int Rb = Epi::PERM ? ((R & ~31) + perm32(R & 31)) : R;
        voffA[i] = (unsigned)(R * K + C) * 2u; voffB[i] = (unsigned)(Rb * K + C) * 2u; }
    const size_t kstep = (size_t)(BK * 2);
    const size_t hstep = (size_t)HALF * K * 2;
    const size_t tstep = 2 * hstep;
    const unsigned ldsw = (unsigned)wid * 1024u;
    const int aoff = lds_byte(wr * 64 + fr, fq * 8), boff = lds_byte(wc * 32 + fr, fq * 8);
#define PG8_SA(b, h) (((b) * 2 + (h)) * HTB)
#define PG8_SB(b, h) ((4 + (b) * 2 + (h)) * HTB)
#define PG8_STAGE(bufoff, gbase, voff) do { _Pragma("unroll") for (int _i = 0; _i < 2; ++_i) \
        __builtin_amdgcn_global_load_lds((const unsigned*)((const char*)(gbase) + (voff)[_i]), (PG8_LAS unsigned*)(lds + (bufoff) + ldsw + _i * 8192), 16, 0, 0); } while (0)
#define PG8_LDA(dst, b, h) do { _Pragma("unroll") for (int m = 0; m < 4; ++m) _Pragma("unroll") for (int k = 0; k < 2; ++k) dst[m][k] = *(const PG8_LAS bf16x8*)(lds + PG8_SA(b, h) + aoff + m * 2048 + k * 1024); } while (0)
#define PG8_LDB(dst, b, h) do { _Pragma("unroll") for (int n = 0; n < 2; ++n) _Pragma("unroll") for (int k = 0; k < 2; ++k) dst[n][k] = *(const PG8_LAS bf16x8*)(lds + PG8_SB(b, h) + boff + n * 2048 + k * 1024); } while (0)
#define PG8_MMA(ai, bj, At, Bt) do { __builtin_amdgcn_s_setprio(1); _Pragma("unroll") for (int m = 0; m < 4; ++m) _Pragma("unroll") for (int n = 0; n < 2; ++n) _Pragma("unroll") for (int k = 0; k < 2; ++k) \
        acc[ai][bj][m][n] = __builtin_amdgcn_mfma_f32_16x16x32_bf16(Bt[n][k], At[m][k], acc[ai][bj][m][n], 0, 0, 0); __builtin_amdgcn_s_setprio(0); } while (0)
#define PG8_WAIT_V(n) asm volatile("s_waitcnt vmcnt(" #n ")" ::: "memory")
#define PG8_WAIT_L(n) asm volatile("s_waitcnt lgkmcnt(" #n ")" ::: "memory")
#define PG8_BAR __builtin_amdgcn_s_barrier()
#define PG8_SCHED __builtin_amdgcn_sched_barrier(0)
    Unit cur, nxt; int ui = 0;
    if (!S.next(0, cur)) return;
    f32x4 acc[2][2][4][2];
#pragma unroll
    for (int a = 0; a < 2; ++a)
#pragma unroll
        for (int b = 0; b < 2; ++b)
#pragma unroll
            for (int m = 0; m < 4; ++m)
#pragma unroll
                for (int n = 0; n < 2; ++n) acc[a][b][m][n] = (f32x4){0.f, 0.f, 0.f, 0.f};
    bf16x8 At[4][2], B0[2][2], B1[2][2];
    const char* cA = (const char*)g.A + (size_t)cur.pm * tstep; const char* cB = (const char*)g.Bt + (size_t)cur.pn * tstep;
    S.a_ready(cur);
    if constexpr (SP2) {
        PG8_STAGE(PG8_SB(0, 0), cB, voffB); PG8_STAGE(PG8_SB(0, 1), cB + hstep, voffB); PG8_STAGE(PG8_SA(0, 0), cA, voffA); PG8_STAGE(PG8_SA(0, 1), cA + hstep, voffA);
        if (wr == 1) PG8_BAR;
        PG8_WAIT_V(2); PG8_BAR;
        PG8_STAGE(PG8_SB(1, 0), cB + kstep, voffB); PG8_STAGE(PG8_SA(1, 0), cA + kstep, voffA); PG8_STAGE(PG8_SB(1, 1), cB + hstep + kstep, voffB);
        PG8_WAIT_V(6); PG8_BAR;
    } else {
        PG8_STAGE(PG8_SB(0, 0), cB, voffB); PG8_STAGE(PG8_SA(0, 0), cA, voffA); PG8_STAGE(PG8_SB(0, 1), cB + hstep, voffB); PG8_STAGE(PG8_SA(0, 1), cA + hstep, voffA);
        if (wr == 1) PG8_BAR;
        PG8_WAIT_V(4); PG8_BAR;
        PG8_STAGE(PG8_SB(1, 0), cB + kstep, voffB); PG8_STAGE(PG8_SA(1, 0), cA + kstep, voffA); PG8_STAGE(PG8_SB(1, 1), cB + hstep + kstep, voffB);
        PG8_WAIT_V(6); PG8_BAR;
    }
    for (;;) {
        const bool has_next = S.next(ui + 1, nxt);
        const char* nA = has_next ? (const char*)g.A + (size_t)nxt.pm * tstep : cA; const char* nB = has_next ? (const char*)g.Bt + (size_t)nxt.pn * tstep : cB;
        for (int t = 0; t < nt; t += 2) {
            const bool last = (t == nt - 2);
            const char* a1 = cA + (size_t)(t + 1) * kstep;
            const char* a2 = last ? nA : cA + (size_t)(t + 2) * kstep; const char* b2 = last ? nB : cB + (size_t)(t + 2) * kstep;
            const char* a3 = a2 + kstep; const char* b3 = b2 + kstep;
            if (last && has_next) S.a_ready(nxt);
            if constexpr (SP2) {
            PG8_LDB(B0, 0, 0); PG8_LDB(B1, 0, 1); PG8_SCHED; PG8_LDA(At, 0, 0); PG8_STAGE(PG8_SA(1, 1), a1 + hstep, voffA);
            PG8_WAIT_V(8); PG8_WAIT_L(0); PG8_BAR; PG8_MMA(0, 0, At, B0); PG8_MMA(0, 1, At, B1); PG8_BAR; PG8_SCHED;
            PG8_LDA(At, 0, 1); PG8_STAGE(PG8_SB(0, 0), b2, voffB); PG8_STAGE(PG8_SB(0, 1), b2 + hstep, voffB); PG8_STAGE(PG8_SA(0, 0), a2, voffA);
            PG8_WAIT_V(8); PG8_WAIT_L(0); PG8_BAR; PG8_MMA(1, 0, At, B0); PG8_MMA(1, 1, At, B1); PG8_BAR; PG8_SCHED;
            PG8_LDB(B0, 1, 0); PG8_LDB(B1, 1, 1); PG8_SCHED; PG8_LDA(At, 1, 0); PG8_STAGE(PG8_SA(0, 1), a2 + hstep, voffA);
            PG8_WAIT_V(8); PG8_WAIT_L(0); PG8_BAR; PG8_MMA(0, 0, At, B0); PG8_MMA(0, 1, At, B1); PG8_BAR; PG8_SCHED;
            PG8_LDA(At, 1, 1); PG8_STAGE(PG8_SB(1, 0), b3, voffB); PG8_STAGE(PG8_SB(1, 1), b3 + hstep, voffB); PG8_STAGE(PG8_SA(1, 0), a3, voffA);
            PG8_WAIT_V(8); PG8_WAIT_L(0); PG8_BAR; PG8_MMA(1, 0, At, B0); PG8_MMA(1, 1, At, B1); PG8_BAR; PG8_SCHED;
            } else {
            PG8_LDB(B0, 0, 0); PG8_SCHED; PG8_LDA(At, 0, 0); PG8_STAGE(PG8_SA(1, 1), a1 + hstep, voffA);
            PG8_WAIT_L(8); PG8_BAR; PG8_WAIT_L(0); PG8_MMA(0, 0, At, B0); PG8_BAR; PG8_SCHED;
            PG8_LDB(B1, 0, 1); PG8_STAGE(PG8_SB(0, 0), b2, voffB);
            PG8_BAR; PG8_WAIT_L(0); PG8_MMA(0, 1, At, B1); PG8_BAR;
            PG8_LDA(At, 0, 1); PG8_STAGE(PG8_SA(0, 0), a2, voffA);
            PG8_BAR; PG8_WAIT_L(0); PG8_MMA(1, 0, At, B0); PG8_BAR; PG8_SCHED;
            PG8_STAGE(PG8_SB(0, 1), b2 + hstep, voffB);
            PG8_WAIT_V(6); PG8_BAR; PG8_MMA(1, 1, At, B1); PG8_BAR;
            PG8_LDB(B0, 1, 0); PG8_SCHED; PG8_LDA(At, 1, 0); PG8_STAGE(PG8_SA(0, 1), a2 + hstep, voffA);
            PG8_WAIT_L(8); PG8_BAR; PG8_WAIT_L(0); PG8_MMA(0, 0, At, B0); PG8_BAR; PG8_SCHED;
            PG8_LDB(B1, 1, 1); PG8_STAGE(PG8_SB(1, 0), b3, voffB);
            PG8_BAR; PG8_WAIT_L(0); PG8_MMA(0, 1, At, B1); PG8_BAR;
            PG8_LDA(At, 1, 1); PG8_STAGE(PG8_SA(1, 0), a3, voffA);
            PG8_BAR; PG8_WAIT_L(0); PG8_MMA(1, 0, At, B0); PG8_BAR; PG8_SCHED;
            PG8_STAGE(PG8_SB(1, 1), b3 + hstep, voffB);
            PG8_WAIT_V(6); PG8_BAR; PG8_MMA(1, 1, At, B1); PG8_BAR;
            }
        }
        if constexpr (ALIGN_EPI) { if (wr == 0) PG8_BAR; }
        if constexpr (!Epi::AFTER_DRAIN) { E(acc, cur, wr, wc, fr, fq); S.done(cur); }
        if (!has_next) break;
#pragma unroll
        for (int a = 0; a < 2; ++a)
#pragma unroll
            for (int b = 0; b < 2; ++b)
#pragma unroll
                for (int m = 0; m < 4; ++m)
#pragma unroll
                    for (int n = 0; n < 2; ++n) acc[a][b][m][n] = (f32x4){0.f, 0.f, 0.f, 0.f};
        cur = nxt; cA = nA; cB = nB; ++ui;
        if constexpr (ALIGN_EPI) { if (wr == 1) PG8_BAR; }
    }
    PG8_WAIT_V(0);
    if constexpr (!ALIGN_EPI) { if (wr == 0) PG8_BAR; }
    PG8_BAR;
    if constexpr (Epi::AFTER_DRAIN) { E.fused(acc, cur, wr, wc, fr, fq, lds, wid, lane); S.done(cur); }
#undef PG8_SA
#undef PG8_SB
#undef PG8_STAGE
#undef PG8_LDA
#undef PG8_LDB
#undef PG8_MMA
#undef PG8_WAIT_V
#undef PG8_WAIT_L
#undef PG8_BAR
#undef PG8_SCHED
}
}

#ifndef PG8_SP2
#define PG8_SP2 true
#endif
#ifndef PG8_ALIGN
#define PG8_ALIGN true
#endif
#define GAS __attribute__((address_space(1)))
#define LAS __attribute__((address_space(3)))
typedef unsigned short bf16;
typedef unsigned v4u __attribute__((ext_vector_type(4)));
typedef float f32x4 __attribute__((ext_vector_type(4)));
typedef short bf16x8 __attribute__((ext_vector_type(8)));
typedef GAS unsigned gu32;
typedef GAS unsigned long long gu64;
#define RLX_AGENT __ATOMIC_RELAXED, __HIP_MEMORY_SCOPE_AGENT
#define LDS_WAIT() asm volatile("s_waitcnt lgkmcnt(0)" ::: "memory")
#define VM_WAIT() asm volatile("s_waitcnt vmcnt(0)" ::: "memory")
__device__ __forceinline__ unsigned long long rt() { return __builtin_amdgcn_s_memrealtime(); }
__device__ __forceinline__ unsigned f2bf(float f) { unsigned u = __builtin_bit_cast(unsigned, f); return (u + 0x7fffu + ((u >> 16) & 1u)) >> 16; }
__device__ __forceinline__ unsigned pk2(float lo, float hi) { return f2bf(lo) | (f2bf(hi) << 16); }

#define XB_TMO      128
#define XB_XCNT(j)  (256  + 64 * (j))
#define XB_XSUB(j)  (1280 + 64 * (j))
#define XB_XGEN(j)  (2304 + 64 * (j))
#define XB_TOP      3328
#define XB_TOPGEN   3392
#define XCD_BAR_WORDS 3456
#define XB_SPIN_CAP (1u << 18)

__device__ __forceinline__ unsigned xb_ld(unsigned* p)              { return __hip_atomic_load(p, __ATOMIC_RELAXED, __HIP_MEMORY_SCOPE_AGENT); }
__device__ __forceinline__ unsigned xb_add(unsigned* p, unsigned v) { return __hip_atomic_fetch_add(p, v, __ATOMIC_RELAXED, __HIP_MEMORY_SCOPE_AGENT); }
__device__ __forceinline__ unsigned xb_xcc_id() { return (unsigned)__builtin_amdgcn_s_getreg((3 << 11) | 20) & 0xFu; }
#define XB_SPIN(cond, bar) do { unsigned _sp = 0; while (cond) { __builtin_amdgcn_s_sleep(1); \
    if ((++_sp & 255u) == 0u) { if (xb_ld(&(bar)[XB_TMO])) break; if (_sp > XB_SPIN_CAP) { atomicAdd(&(bar)[XB_TMO], 1u); break; } } } } while (0)

struct XcdBarrier {
    unsigned* bar; unsigned x;
    volatile LAS unsigned* st;
};

__device__ __forceinline__ XcdBarrier xcd_barrier_post(unsigned* bar, volatile LAS unsigned* st) {
    XcdBarrier b; b.bar = bar; b.x = xb_xcc_id(); b.st = st;
    if (threadIdx.x == 0) (void)xb_add(&bar[XB_XCNT(b.x)], 1u);
    return b;
}
__device__ __forceinline__ void xcd_barrier_complete(unsigned* bar, unsigned x, unsigned& nloc, unsigned& nx) {
    const unsigned G = gridDim.x * gridDim.y * gridDim.z;
    unsigned sum, cnt, mine, sp = 0u;
    for (;;) {
        sum = 0u; cnt = 0u; mine = 0u;
#pragma unroll
        for (unsigned j = 0; j < 16; ++j) { const unsigned c = xb_ld(&bar[XB_XCNT(j)]); sum += c; cnt += (c > 0u) ? 1u : 0u; mine = (j == x) ? c : mine; }
        if (sum == G) break;
        __builtin_amdgcn_s_sleep(1);
        if ((++sp & 255u) == 0u) { if (xb_ld(&bar[XB_TMO])) break; if (sp > XB_SPIN_CAP) { atomicAdd(&bar[XB_TMO], 1u); break; } }
    }
    nloc = mine > 0u ? mine : 1u; nx = cnt > 0u ? cnt : 1u;
}

__device__ __forceinline__ void xcd_barrier(const XcdBarrier& b) {
    asm volatile("s_waitcnt vmcnt(0)" ::: "memory");
    __syncthreads();
    if (threadIdx.x == 0) {
        unsigned* bar = b.bar;
        __builtin_amdgcn_s_waitcnt(0);
        unsigned nloc = b.st[0], nx = b.st[1];
        if (nloc == 0u) { xcd_barrier_complete(bar, b.x, nloc, nx); b.st[0] = nloc; b.st[1] = nx; }
        const unsigned old = xb_add(&bar[XB_XSUB(b.x)], 1u);
        const unsigned gen = old / nloc;
        if (old + 1u == (gen + 1u) * nloc) {
            __builtin_amdgcn_fence(__ATOMIC_RELEASE, "agent");
            asm volatile("s_waitcnt vmcnt(0)" ::: "memory");
            const unsigned og = xb_add(&bar[XB_TOP], 1u);
            const unsigned tg = og / nx;
            if (og + 1u == (tg + 1u) * nx) xb_add(&bar[XB_TOPGEN], 1u);
            else XB_SPIN(xb_ld(&bar[XB_TOPGEN]) == tg, bar);
            __builtin_amdgcn_fence(__ATOMIC_ACQUIRE, "agent");
            xb_add(&bar[XB_XGEN(b.x)], 1u);
            asm volatile("s_waitcnt vmcnt(0)" ::: "memory");
        } else {
            XB_SPIN(xb_ld(&bar[XB_XGEN(b.x)]) == gen, bar);
            __builtin_amdgcn_fence(__ATOMIC_ACQUIRE, "agent");
            asm volatile("s_waitcnt vmcnt(0)" ::: "memory");
        }
    }
    __syncthreads();
}

constexpr int BATCH = 2, SEQ = 16384, DM = 1024, TT = BATCH * SEQ, NPROJ = 3584, DFF = 2816, NUP = 2 * DFF, NPANEL = TT / 256;
constexpr int NH = 8, HD = 64, HW = 512;
constexpr float EPS = 1e-6f;
#ifndef MK_ONE_LAUNCH
#define MK_ONE_LAUNCH 0
#endif

constexpr size_t MiB = 1u << 20;
constexpr size_t WS_CTL = 0, CTL_ZERO_BYTES = 1 * MiB;
constexpr size_t WS_WIN = 1 * MiB, WS_WOUT = 8 * MiB, WS_WUP = 10 * MiB, WS_WDN = 21 * MiB;
constexpr size_t WS_CS = 27 * MiB;
constexpr size_t WS_SMALL = 31 * MiB;
constexpr size_t SM_BIASD = 0, SM_DPOS = 8192, SM_DNEG = 16384, SM_GAM = 24576, SM_G256 = 24576 + 64;
constexpr size_t WS_KMS = 32 * MiB;
constexpr size_t WS_ROWSS = 33 * MiB;
constexpr size_t WS_SEL = 35 * MiB;
constexpr size_t WS_KV = 40 * MiB, WS_RP = 56 * MiB;
constexpr size_t WS_XN = 72 * MiB;
constexpr size_t WS_PROJ = 136 * MiB;
constexpr size_t PROJ_SEG = (size_t)TT * 512 * 2;
constexpr size_t WS_Y = 360 * MiB;
constexpr size_t WS_Y1 = 136 * MiB;
constexpr size_t WS_U = 136 * MiB;
constexpr size_t WS_F = 312 * MiB;
constexpr size_t WS_END = 496 * MiB;
constexpr int CW_BAR = 4096;

typedef unsigned u32x4v __attribute__((ext_vector_type(4)));
typedef unsigned u32x2v __attribute__((ext_vector_type(2)));

__device__ __forceinline__ float bflo(unsigned w) { return __uint_as_float(w << 16); }
__device__ __forceinline__ float bfhi(unsigned w) { return __uint_as_float(w & 0xffff0000u); }
__device__ __forceinline__ float bf1(bf16 b) { return __uint_as_float((unsigned)b << 16); }

namespace pg8 {
struct EpiProj {
    static constexpr bool PERM = true, AFTER_DRAIN = false;
    bf16_t* proj; const float* cs; const float* dpos; const float* dneg; float* kms;
    __device__ __forceinline__ void operator()(const f32x4 (&acc)[2][2][4][2], const Unit& u, int wr, int wc, int fr, int fq) const {
        const int seg = u.pn >> 1, cb = (u.pn & 1) * 256;
        bf16_t* base = proj + (size_t)seg * ((size_t)TT * 512);
        const int row0 = u.pm * BM + wr * 64 + fr, colw = cb + wc * 32 + 8 * fq;
        if (seg == 3 || seg == 4) {
            const int i0 = 16 * (wc & 1) + 4 * fq;
#pragma unroll
            for (int ai = 0; ai < 2; ++ai)
#pragma unroll
                for (int m = 0; m < 4; ++m) {
                    const int row = row0 + ai * HALF + m * 16, t = row & (SEQ - 1), tl = t & 255;
                    const f32x4 c01 = *(const f32x4*)(cs + ((size_t)t * 32 + i0) * 2), c23 = *(const f32x4*)(cs + ((size_t)t * 32 + i0) * 2 + 4);
                    bf16_t* rowp = base + (size_t)row * 512 + colw;
#pragma unroll
                    for (int bj = 0; bj < 2; ++bj) {
                        const int head = (cb >> 6) + bj * 2 + (wc >> 1);
                        const float ds = (seg == 3) ? dpos[head * 256 + tl] : 0.125f * dneg[head * 256 + tl];
                        const f32x4 v0 = acc[ai][bj][m][0], v1 = acc[ai][bj][m][1];
                        u32x4 w;
                        w.x = cvt_pk_bf16((v0[0] * c01[0] - v0[1] * c01[1]) * ds, (v0[0] * c01[1] + v0[1] * c01[0]) * ds);
                        w.y = cvt_pk_bf16((v0[2] * c01[2] - v0[3] * c01[3]) * ds, (v0[2] * c01[3] + v0[3] * c01[2]) * ds);
                        w.z = cvt_pk_bf16((v1[0] * c23[0] - v1[1] * c23[1]) * ds, (v1[0] * c23[1] + v1[1] * c23[0]) * ds);
                        w.w = cvt_pk_bf16((v1[2] * c23[2] - v1[3] * c23[3]) * ds, (v1[2] * c23[3] + v1[3] * c23[2]) * ds);
                        *(u32x4*)(rowp + bj * HALF) = w;
                    }
                }
        } else {
            const float sc = (seg == 0) ? 0.125f : 1.0f;
#pragma unroll
            for (int ai = 0; ai < 2; ++ai)
#pragma unroll
                for (int m = 0; m < 4; ++m) {
                    bf16_t* rowp = base + (size_t)(row0 + ai * HALF + m * 16) * 512 + colw;
#pragma unroll
                    for (int bj = 0; bj < 2; ++bj) {
                        const f32x4 v0 = acc[ai][bj][m][0] * sc, v1 = acc[ai][bj][m][1] * sc;
                        u32x4 w; w.x = cvt_pk_bf16(v0[0], v0[1]); w.y = cvt_pk_bf16(v0[2], v0[3]); w.z = cvt_pk_bf16(v1[0], v1[1]); w.w = cvt_pk_bf16(v1[2], v1[3]);
                        *(u32x4*)(rowp + bj * HALF) = w;
                    }
                }
            if (seg == 1) {
#pragma unroll
                for (int bj = 0; bj < 2; ++bj)
#pragma unroll
                    for (int n = 0; n < 2; ++n) {
                        f32x4 s = acc[0][bj][0][n];
#pragma unroll
                        for (int m = 1; m < 4; ++m) s += acc[0][bj][m][n];
#pragma unroll
                        for (int m = 0; m < 4; ++m) s += acc[1][bj][m][n];
#pragma unroll
                        for (int o = 1; o < 16; o <<= 1) { s[0] += __shfl_xor(s[0], o); s[1] += __shfl_xor(s[1], o); s[2] += __shfl_xor(s[2], o); s[3] += __shfl_xor(s[3], o); }
                        if (fr == 0) *(f32x4*)(kms + ((size_t)wr * NPANEL + u.pm) * 512 + colw + bj * HALF + 4 * n) = s;
                    }
            }
        }
    }
};
struct EpiY {
    static constexpr bool PERM = true, AFTER_DRAIN = false;
    bf16_t* Y; float* rowss;
    __device__ __forceinline__ void operator()(const f32x4 (&acc)[2][2][4][2], const Unit& u, int wr, int wc, int fr, int fq) const {
        const int row0 = u.pm * BM + wr * 64 + fr, colw = u.pn * BM + wc * 32 + 8 * fq;
#pragma unroll
        for (int ai = 0; ai < 2; ++ai)
#pragma unroll
            for (int m = 0; m < 4; ++m) {
                const int row = row0 + ai * HALF + m * 16;
                bf16_t* rowp = Y + (size_t)row * 1024 + colw; float ss = 0.f;
#pragma unroll
                for (int bj = 0; bj < 2; ++bj) {
                    const f32x4 v0 = acc[ai][bj][m][0], v1 = acc[ai][bj][m][1];
                    ss += (v0[0] * v0[0] + v0[1] * v0[1]) + (v0[2] * v0[2] + v0[3] * v0[3]) + (v1[0] * v1[0] + v1[1] * v1[1]) + (v1[2] * v1[2] + v1[3] * v1[3]);
                    u32x4 w; w.x = cvt_pk_bf16(v0[0], v0[1]); w.y = cvt_pk_bf16(v0[2], v0[3]); w.z = cvt_pk_bf16(v1[0], v1[1]); w.w = cvt_pk_bf16(v1[2], v1[3]);
                    *(u32x4*)(rowp + bj * HALF) = w;
                }
                ss += __shfl_xor(ss, 16); ss += __shfl_xor(ss, 32);
                if (fq == 0) rowss[(size_t)row * 16 + u.pn * 4 + wc] = ss;
            }
    }
};
}

constexpr int RING_OFF = 0, RING_BYTES = 131072;
constexpr int LDSCTL_OFF = RING_BYTES, MISC_OFF = LDSCTL_OFF + 320;
constexpr int LDS_BYTES = 147456;
constexpr int NWAVES = 8;

struct Frame {
    LAS unsigned char* lds; volatile LAS unsigned* MISC; gu32* ctl;
    int tid, lane, wave, vcu, G;
    const float *x, *g_mix_pre, *w_in, *rel_bias, *w_out, *g_mix_post, *g_ffn_pre, *w_up, *conv_w, *conv_b, *w_down, *g_ffn_post;
    float* out;
    bf16 *Win_t, *Wout_t, *Wup_t, *Wdn_t, *XN, *PROJ, *Y, *Y1, *U, *Fb;
    float *cs, *biasd, *dpos, *dneg, *gam, *g256, *kms, *rowss, *KV, *RP;
    unsigned* sel;
};

__device__ __forceinline__ float wave_sum(float v) {
#pragma unroll
    for (int o = 1; o < 64; o <<= 1) v += __shfl_xor(v, o);
    return v;
}

template <int MODE> __device__ __forceinline__ int src_col(int n) {
    if (MODE == 1) { const int seg = n >> 9; if (seg == 3 || seg == 4) { const int p = n & 63; return (n & ~63) + (p >> 1) + 32 * (p & 1); } }
    return n;
}
template <int MODE> __device__ __forceinline__ void p0_transpose_item(const float* W, const float* gain, int K, int N, bf16* WT, LAS float* scr, int item, int lane) {
    const int nblk = N / 32, kb = item / nblk, nb = item % nblk, k0 = 64 * kb, n0 = 32 * nb;
    const int sc = src_col<MODE>(n0 + (lane & 31));
#pragma unroll 8
    for (int i = 0; i < 32; ++i) { const int kk = 2 * i + (lane >> 5); const float g = gain ? gain[k0 + kk] : 1.0f; scr[kk * 33 + (lane & 31)] = W[(size_t)(k0 + kk) * N + sc] * g; }
    LDS_WAIT(); asm volatile("" ::: "memory");
    const int c = lane & 7;
#pragma unroll
    for (int j = 0; j < 4; ++j) { const int n = (lane >> 3) + 8 * j; const LAS float* s = scr + (8 * c) * 33 + n;
        v4u o; o.x = pk2(s[0 * 33], s[1 * 33]); o.y = pk2(s[2 * 33], s[3 * 33]); o.z = pk2(s[4 * 33], s[5 * 33]); o.w = pk2(s[6 * 33], s[7 * 33]);
        *(GAS v4u*)(WT + (size_t)(n0 + n) * K + k0 + 8 * c) = o; }
    LDS_WAIT(); asm volatile("" ::: "memory");
}
__device__ __forceinline__ int t5_bucket(int n) {
    if (n < 16) return n;
    int l = 16 + (int)(__logf((float)n * (1.0f / 16.0f)) / __logf(8.0f) * 16.0f);
    return l < 31 ? l : 31;
}
__device__ __forceinline__ void p0_prologue(Frame& F) {
    LAS float* scr = (LAS float*)(F.lds + RING_OFF + F.wave * 16384);
    const int gw = F.vcu * NWAVES + F.wave, NGW = F.G * NWAVES;
    constexpr int I_IN = (DM / 64) * (NPROJ / 32), I_OUT = (DM / 64) * (DM / 32), I_UP = (DM / 64) * (NUP / 32), I_DN = (DFF / 64) * (DM / 32);
    for (int it = gw; it < I_IN + I_OUT + I_UP + I_DN; it += NGW) {
        int r = it;
        if (r < I_IN) { p0_transpose_item<1>(F.w_in, F.g_mix_pre, DM, NPROJ, F.Win_t, scr, r, F.lane); continue; } r -= I_IN;
        if (r < I_OUT) { p0_transpose_item<0>(F.w_out, nullptr, DM, DM, F.Wout_t, scr, r, F.lane); continue; } r -= I_OUT;
        if (r < I_UP) { p0_transpose_item<0>(F.w_up, F.g_ffn_pre, DM, NUP, F.Wup_t, scr, r, F.lane); continue; } r -= I_UP;
        p0_transpose_item<0>(F.w_down, nullptr, DFF, DM, F.Wdn_t, scr, r, F.lane);
    }
    for (int m = gw; m < TT; m += NGW) {
        const GAS f32x4* xr = (const GAS f32x4*)(F.x + (size_t)m * DM) + F.lane;
        f32x4 v[4]; float s = 0.f;
#pragma unroll
        for (int j = 0; j < 4; ++j) { v[j] = xr[64 * j]; s += (v[j].x * v[j].x + v[j].y * v[j].y) + (v[j].z * v[j].z + v[j].w * v[j].w); }
        const float rstd = 1.0f / sqrtf(wave_sum(s) * (1.f / DM) + EPS);
        GAS unsigned long long* o8 = (GAS unsigned long long*)(F.XN + (size_t)m * DM) + F.lane;
#pragma unroll
        for (int j = 0; j < 4; ++j) o8[64 * j] = (unsigned long long)pk2(v[j].x * rstd, v[j].y * rstd) | ((unsigned long long)pk2(v[j].z * rstd, v[j].w * rstd) << 32);
    }
    const int gt = blockIdx.x * (NWAVES * 64) + F.tid, NT = F.G * NWAVES * 64;
    for (int i = gt; i < SEQ * 32; i += NT) {
        const int t = i >> 5, k = i & 31;
        double inv = 1.0; for (int q = 0; q < k; ++q) inv *= 0.74989420933245582730;
        const float ang = (float)t * (float)inv;
        const double rev = (double)ang * 0.15915494309189533577; const double fr = rev - __builtin_rint(rev);
        F.cs[2 * i] = __builtin_amdgcn_cosf((float)fr); F.cs[2 * i + 1] = __builtin_amdgcn_sinf((float)fr);
    }
    for (int i = gt; i < NH * 256; i += NT) {
        const int h = i >> 8, n = i & 255; const double g = 1.0 - 1.0 / (double)(32 << h);
        double p = 1.0; for (int q = 0; q < n; ++q) p *= g;
        F.dpos[i] = (float)p; F.dneg[i] = (float)(1.0 / p);
        if (n == 255) { F.gam[h] = (float)g; F.g256[h] = (float)(p * g); }
    }
    for (int i = gt; i < NH * 132; i += NT) { const int h = i / 132, d = i % 132; F.biasd[i] = F.rel_bias[t5_bucket(d < 128 ? d : 128) * NH + h]; }
}

__device__ __forceinline__ void p2_gate(Frame& F) {
    LAS float* km = (LAS float*)(F.lds + RING_OFF);
    const bf16* QA = F.PROJ;
    for (int it = blockIdx.x; it < 512; it += F.G) {
        const int cp = 31 - (it & 31), bh = it >> 5, b = bh >> 3, h = bh & 7, c0 = 2 * cp, nj = c0 + 1;
        __syncthreads();
        for (int i = F.tid; i < nj * 64; i += NWAVES * 64) { const int j = i >> 6, d = i & 63; const size_t o = (size_t)(b * 64 + j) * 512 + h * 64 + d;
            km[i] = (F.kms[o] + F.kms[(size_t)NPANEL * 512 + o]) * (1.0f / 256.0f); }
        __syncthreads();
        const int t = c0 * 256 + F.tid, c = t >> 8; const size_t row = (size_t)b * SEQ + t;
        float q[64];
        { const GAS u32x4v* qp = (const GAS u32x4v*)(QA + row * 512 + h * 64);
#pragma unroll
          for (int i = 0; i < 8; ++i) { const u32x4v w = qp[i]; q[8 * i] = bflo(w.x); q[8 * i + 1] = bfhi(w.x); q[8 * i + 2] = bflo(w.y); q[8 * i + 3] = bfhi(w.y); q[8 * i + 4] = bflo(w.z); q[8 * i + 5] = bfhi(w.z); q[8 * i + 6] = bflo(w.w); q[8 * i + 7] = bfhi(w.w); } }
        float v0 = -INFINITY, v1 = -INFINITY, v2 = -INFINITY; unsigned i0 = 255u, i1 = 255u, i2 = 255u;
        for (int j = 0; j < c; ++j) {
            const LAS f32x4* kp = (const LAS f32x4*)(km + j * 64); float g = 0.f;
#pragma unroll
            for (int i = 0; i < 16; ++i) { const f32x4 k4 = kp[i]; g += q[4 * i] * k4.x + q[4 * i + 1] * k4.y + q[4 * i + 2] * k4.z + q[4 * i + 3] * k4.w; }
            if (g > v0) { v2 = v1; i2 = i1; v1 = v0; i1 = i0; v0 = g; i0 = (unsigned)j; }
            else if (g > v1) { v2 = v1; i2 = i1; v1 = g; i1 = (unsigned)j; }
            else if (g > v2) { v2 = g; i2 = (unsigned)j; }
        }
        F.sel[row * 8 + h] = i0 | (i1 << 8) | (i2 << 16);
    }
}
__device__ __forceinline__ void p2_kv_simple(Frame& F) {
    const bf16* KR = F.PROJ + 4 * (size_t)TT * 512; const bf16* VR = F.PROJ + 5 * (size_t)TT * 512;
    for (int it = blockIdx.x; it < 1024; it += F.G) {
        const int b = it >> 9, h = (it >> 6) & 7, c = it & 63; const size_t row0 = (size_t)b * SEQ + c * 256;
        const int d = F.tid >> 3, e0 = (F.tid & 7) * 8; float a[8];
#pragma unroll
        for (int i = 0; i < 8; ++i) a[i] = 0.f;
        for (int m = 0; m < 256; ++m) {
            const float kk = bf1(KR[(row0 + m) * 512 + h * 64 + d]);
            const u32x4v w = *(const GAS u32x4v*)(VR + (row0 + m) * 512 + h * 64 + e0);
            a[0] += kk * bflo(w.x); a[1] += kk * bfhi(w.x); a[2] += kk * bflo(w.y); a[3] += kk * bfhi(w.y); a[4] += kk * bflo(w.z); a[5] += kk * bfhi(w.z); a[6] += kk * bflo(w.w); a[7] += kk * bfhi(w.w);
        }
        const float sc = F.dpos[h * 256 + 255];
#pragma unroll
        for (int i = 0; i < 8; ++i) F.KV[(size_t)it * 4096 + d * 64 + e0 + i] = a[i] * sc;
    }
}
__device__ __forceinline__ void p3_scan(Frame& F) {
    const int gt = blockIdx.x * (NWAVES * 64) + F.tid;
    if (gt < 16 * 4096) {
        const int bh = gt >> 12, idx = gt & 4095, h = bh & 7; const float g = F.g256[h]; float st = 0.f;
        for (int c = 0; c < 64; ++c) { const size_t o = ((size_t)(bh * 64 + c)) * 4096 + idx; F.RP[o] = st; st = st * g + F.KV[o]; }
    }
}
__device__ __forceinline__ void p3_moba_simple(Frame& F) {
    const bf16* QA = F.PROJ; const bf16* KA = F.PROJ + (size_t)TT * 512; const bf16* VA = F.PROJ + 2 * (size_t)TT * 512;
    const int gt = blockIdx.x * (NWAVES * 64) + F.tid, NT = F.G * NWAVES * 64;
    for (int idx = gt; idx < TT * NH; idx += NT) {
        const int h = idx >> 15, row = idx & (TT - 1), b = row >> 14, t = row & (SEQ - 1), c = t >> 8;
        float q[64], o[64];
        { const GAS u32x4v* qp = (const GAS u32x4v*)(QA + (size_t)row * 512 + h * 64);
#pragma unroll
          for (int i = 0; i < 8; ++i) { const u32x4v w = qp[i]; q[8 * i] = bflo(w.x); q[8 * i + 1] = bfhi(w.x); q[8 * i + 2] = bflo(w.y); q[8 * i + 3] = bfhi(w.y); q[8 * i + 4] = bflo(w.z); q[8 * i + 5] = bfhi(w.z); q[8 * i + 6] = bflo(w.w); q[8 * i + 7] = bfhi(w.w); } }
#pragma unroll
        for (int i = 0; i < 64; ++i) o[i] = 0.f;
        const unsigned sw = F.sel[(size_t)row * 8 + h]; const float* bd = F.biasd + h * 132;
        float mrun = -3.0e38f, l = 0.f;
        for (int slot = 0; slot < 4; ++slot) {
            const int j = slot < 3 ? (int)((sw >> (8 * slot)) & 255u) : c;
            if (slot < 3 && j >= c) continue;
            const size_t r0 = (size_t)b * SEQ + j * 256;
            for (int s = 0; s < 256; ++s) {
                const int pos = j * 256 + s; if (pos > t) break;
                const GAS u32x4v* kp = (const GAS u32x4v*)(KA + (r0 + s) * 512 + h * 64); float dot = 0.f;
#pragma unroll
                for (int i = 0; i < 8; ++i) { const u32x4v w = kp[i]; dot += q[8 * i] * bflo(w.x) + q[8 * i + 1] * bfhi(w.x) + q[8 * i + 2] * bflo(w.y) + q[8 * i + 3] * bfhi(w.y) + q[8 * i + 4] * bflo(w.z) + q[8 * i + 5] * bfhi(w.z) + q[8 * i + 6] * bflo(w.w) + q[8 * i + 7] * bfhi(w.w); }
                const int dist = t - pos; const float sc = dot + bd[dist < 128 ? dist : 128];
                if (sc > mrun) { const float a = __expf(mrun - sc); l *= a;
#pragma unroll
                    for (int i = 0; i < 64; ++i) o[i] *= a;
                    mrun = sc; }
                const float p = __expf(sc - mrun); l += p;
                const GAS u32x4v* vp = (const GAS u32x4v*)(VA + (r0 + s) * 512 + h * 64);
#pragma unroll
                for (int i = 0; i < 8; ++i) { const u32x4v w = vp[i]; o[8 * i] += p * bflo(w.x); o[8 * i + 1] += p * bfhi(w.x); o[8 * i + 2] += p * bflo(w.y); o[8 * i + 3] += p * bfhi(w.y); o[8 * i + 4] += p * bflo(w.z); o[8 * i + 5] += p * bfhi(w.z); o[8 * i + 6] += p * bflo(w.w); o[8 * i + 7] += p * bfhi(w.w); }
            }
        }
        const float il = 1.0f / l;
        GAS u32x4v* yp = (GAS u32x4v*)(F.Y + (size_t)row * 1024 + h * 64);
#pragma unroll
        for (int i = 0; i < 8; ++i) { u32x4v w; w.x = pk2(o[8 * i] * il, o[8 * i + 1] * il); w.y = pk2(o[8 * i + 2] * il, o[8 * i + 3] * il); w.z = pk2(o[8 * i + 4] * il, o[8 * i + 5] * il); w.w = pk2(o[8 * i + 6] * il, o[8 * i + 7] * il); yp[i] = w; }
    }
}
__device__ __forceinline__ void p4_ret_simple(Frame& F) {
    const bf16* QR = F.PROJ + 3 * (size_t)TT * 512; const bf16* KR = F.PROJ + 4 * (size_t)TT * 512; const bf16* VR = F.PROJ + 5 * (size_t)TT * 512; const bf16* GR = F.PROJ + 6 * (size_t)TT * 512;
    const int gt = blockIdx.x * (NWAVES * 64) + F.tid, NT = F.G * NWAVES * 64;
    for (int idx = gt; idx < TT * NH; idx += NT) {
        const int h = idx >> 15, row = idx & (TT - 1), b = row >> 14, t = row & (SEQ - 1), c = t >> 8, n = t & 255;
        float q[64], y[64];
        { const GAS u32x4v* qp = (const GAS u32x4v*)(QR + (size_t)row * 512 + h * 64);
#pragma unroll
          for (int i = 0; i < 8; ++i) { const u32x4v w = qp[i]; q[8 * i] = bflo(w.x); q[8 * i + 1] = bfhi(w.x); q[8 * i + 2] = bflo(w.y); q[8 * i + 3] = bfhi(w.y); q[8 * i + 4] = bflo(w.z); q[8 * i + 5] = bfhi(w.z); q[8 * i + 6] = bflo(w.w); q[8 * i + 7] = bfhi(w.w); } }
#pragma unroll
        for (int i = 0; i < 64; ++i) y[i] = 0.f;
        const size_t r0 = (size_t)row - n;
        for (int m = 0; m <= n; ++m) {
            const GAS u32x4v* kp = (const GAS u32x4v*)(KR + (r0 + m) * 512 + h * 64); float dot = 0.f;
#pragma unroll
            for (int i = 0; i < 8; ++i) { const u32x4v w = kp[i]; dot += q[8 * i] * bflo(w.x) + q[8 * i + 1] * bfhi(w.x) + q[8 * i + 2] * bflo(w.y) + q[8 * i + 3] * bfhi(w.y) + q[8 * i + 4] * bflo(w.z) + q[8 * i + 5] * bfhi(w.z) + q[8 * i + 6] * bflo(w.w) + q[8 * i + 7] * bfhi(w.w); }
            const GAS u32x4v* vp = (const GAS u32x4v*)(VR + (r0 + m) * 512 + h * 64);
#pragma unroll
            for (int i = 0; i < 8; ++i) { const u32x4v w = vp[i]; y[8 * i] += dot * bflo(w.x); y[8 * i + 1] += dot * bfhi(w.x); y[8 * i + 2] += dot * bflo(w.y); y[8 * i + 3] += dot * bfhi(w.y); y[8 * i + 4] += dot * bflo(w.z); y[8 * i + 5] += dot * bfhi(w.z); y[8 * i + 6] += dot * bflo(w.w); y[8 * i + 7] += dot * bfhi(w.w); }
        }
        const float* R = F.RP + ((size_t)((b * 8 + h) * 64 + c)) * 4096; const float gam = F.gam[h];
        const bf16* qrow = QR + (size_t)row * 512 + h * 64;
        for (int d = 0; d < 64; ++d) {
            const float qd = bf1(qrow[d]) * gam; const GAS f32x4* rp = (const GAS f32x4*)(R + d * 64);
#pragma unroll
            for (int i = 0; i < 16; ++i) { const f32x4 r4 = rp[i]; y[4 * i] += qd * r4.x; y[4 * i + 1] += qd * r4.y; y[4 * i + 2] += qd * r4.z; y[4 * i + 3] += qd * r4.w; }
        }
        float mu = 0.f;
#pragma unroll
        for (int i = 0; i < 64; ++i) mu += y[i];
        mu *= (1.f / 64.f); float var = 0.f;
#pragma unroll
        for (int i = 0; i < 64; ++i) { y[i] -= mu; var += y[i] * y[i]; }
        const float rs = 1.0f / sqrtf(var * (1.f / 64.f) + EPS);
        const GAS u32x4v* gp = (const GAS u32x4v*)(GR + (size_t)row * 512 + h * 64);
        GAS u32x4v* yp = (GAS u32x4v*)(F.Y + (size_t)row * 1024 + 512 + h * 64);
#pragma unroll
        for (int i = 0; i < 8; ++i) { const u32x4v w = gp[i]; float g[8] = {bflo(w.x), bfhi(w.x), bflo(w.y), bfhi(w.y), bflo(w.z), bfhi(w.z), bflo(w.w), bfhi(w.w)}; float r[8];
#pragma unroll
            for (int k = 0; k < 8; ++k) r[k] = g[k] / (1.0f + __expf(-g[k])) * (y[8 * i + k] * rs);
            u32x4v ow; ow.x = pk2(r[0], r[1]); ow.y = pk2(r[2], r[3]); ow.z = pk2(r[4], r[5]); ow.w = pk2(r[6], r[7]); yp[i] = ow; }
    }
}

namespace mx {
typedef __attribute__((ext_vector_type(8))) short bf16x8;
typedef __attribute__((ext_vector_type(4))) short s16x4;
typedef __attribute__((ext_vector_type(16))) float f32x16;
typedef __attribute__((ext_vector_type(4))) unsigned u32x4;
typedef short v4i16_t __attribute__((ext_vector_type(4)));
typedef __attribute__((address_space(3))) const char* lds_cptr;
typedef float f32x2_t __attribute__((ext_vector_type(2))); typedef __bf16 bf16x2_t __attribute__((ext_vector_type(2)));
__device__ __forceinline__ int crow(int r, int hi) { return (r & 3) + 8 * (r >> 2) + 4 * hi; }
__device__ __forceinline__ unsigned cvtpk(float lo, float hi) { f32x2_t v = {lo, hi}; bf16x2_t b = __builtin_convertvector(v, bf16x2_t); return __builtin_bit_cast(unsigned, b); }
__device__ __forceinline__ void glds16(const void* gsrc, unsigned lds_dst) { unsigned keep;
    asm volatile("s_mov_b32 %0, m0\n\ts_mov_b32 m0, %2\n\ts_nop 0\n\tglobal_load_lds_dwordx4 %1, off\n\ts_mov_b32 m0, %0" : "=&s"(keep) : "v"(gsrc), "s"(lds_dst) : "memory"); }
__device__ __forceinline__ s16x4 vtr(lds_cptr p) { return __builtin_bit_cast(s16x4, __builtin_amdgcn_ds_read_tr16_b64_v4i16((__attribute__((address_space(3))) v4i16_t*)p)); }
#define MX_WAIT_BAR() asm volatile("s_waitcnt vmcnt(0) lgkmcnt(0)\n\ts_barrier" ::: "memory")
#define MX_LBAR() asm volatile("s_waitcnt lgkmcnt(0)\n\ts_barrier" ::: "memory")
__device__ __forceinline__ void dma_kimg(const bf16* tile, unsigned lds_img, int wid, int lane) { glds16(tile + (size_t)lane * 512 + wid * 8, (unsigned)__builtin_amdgcn_readfirstlane(lds_img + wid * 1024)); }
__device__ __forceinline__ void dma_timg(const bf16* tile, unsigned lds_img, int wid, int lane) { glds16(tile + (size_t)(16 * (wid & 3) + (lane >> 2)) * 512 + (wid >> 2) * 32 + (lane & 3) * 8, (unsigned)__builtin_amdgcn_readfirstlane(lds_img + wid * 1024)); }
__device__ __forceinline__ void qkt(f32x16& p0, f32x16& p1, lds_cptr kimg, const bf16x8* qr, int r32, int hi) {
    const lds_cptr kb = kimg + hi * 1024 + r32 * 16; const f32x16 z = {};
#pragma unroll
    for (int d0 = 0; d0 < 4; ++d0) {
        const bf16x8 b0 = *(const __attribute__((address_space(3))) bf16x8*)(kb + d0 * 2048), b1 = *(const __attribute__((address_space(3))) bf16x8*)(kb + d0 * 2048 + 512);
        p0 = __builtin_amdgcn_mfma_f32_32x32x16_bf16(b0, qr[d0], d0 == 0 ? z : p0, 0, 0, 0); p1 = __builtin_amdgcn_mfma_f32_32x32x16_bf16(b1, qr[d0], d0 == 0 ? z : p1, 0, 0, 0); }
}
__device__ __forceinline__ bf16x8 tfrag_perm(lds_cptr timg, int ks, int d0, int lane, int hi) {
    const lds_cptr p = timg + ((lane >> 4) & 1) * 32 + (lane & 3) * 8 + (4 * hi + ((lane & 15) >> 2)) * 64 + d0 * 4096 + ks * 1024;
    const s16x4 lo = vtr(p), hh = vtr(p + 512); return (bf16x8){lo[0], lo[1], lo[2], lo[3], hh[0], hh[1], hh[2], hh[3]};
}
__device__ __forceinline__ bf16x8 tfrag_nat(lds_cptr timg, int ks, int d0, int lane, int hi) {
    const lds_cptr p = timg + ((lane >> 4) & 1) * 32 + (lane & 3) * 8 + (8 * hi + ((lane & 15) >> 2)) * 64 + d0 * 4096 + ks * 1024;
    const s16x4 lo = vtr(p), hh = vtr(p + 256); return (bf16x8){lo[0], lo[1], lo[2], lo[3], hh[0], hh[1], hh[2], hh[3]};
}
__device__ __forceinline__ void pv64(f32x16* o, const f32x16& p0, const f32x16& p1, lds_cptr vimg, int lane, int hi) {
    u32x4 w0 = {cvtpk(p0[0], p0[1]), cvtpk(p0[2], p0[3]), cvtpk(p0[4], p0[5]), cvtpk(p0[6], p0[7])}, w1 = {cvtpk(p0[8], p0[9]), cvtpk(p0[10], p0[11]), cvtpk(p0[12], p0[13]), cvtpk(p0[14], p0[15])};
    u32x4 w2 = {cvtpk(p1[0], p1[1]), cvtpk(p1[2], p1[3]), cvtpk(p1[4], p1[5]), cvtpk(p1[6], p1[7])}, w3 = {cvtpk(p1[8], p1[9]), cvtpk(p1[10], p1[11]), cvtpk(p1[12], p1[13]), cvtpk(p1[14], p1[15])};
#pragma unroll
    for (int d0 = 0; d0 < 2; ++d0) {
        o[d0] = __builtin_amdgcn_mfma_f32_32x32x16_bf16(__builtin_bit_cast(bf16x8, w0), tfrag_perm(vimg, 0, d0, lane, hi), o[d0], 0, 0, 0);
        o[d0] = __builtin_amdgcn_mfma_f32_32x32x16_bf16(__builtin_bit_cast(bf16x8, w1), tfrag_perm(vimg, 1, d0, lane, hi), o[d0], 0, 0, 0);
        o[d0] = __builtin_amdgcn_mfma_f32_32x32x16_bf16(__builtin_bit_cast(bf16x8, w2), tfrag_perm(vimg, 2, d0, lane, hi), o[d0], 0, 0, 0);
        o[d0] = __builtin_amdgcn_mfma_f32_32x32x16_bf16(__builtin_bit_cast(bf16x8, w3), tfrag_perm(vimg, 3, d0, lane, hi), o[d0], 0, 0, 0);
    }
}
constexpr int L_K = 0, L_V = 32768, L_R = 65536, L_LIST = 65536, L_STG = 98304;
}

__device__ __forceinline__ void p2_kv_mfma(Frame& F) {
    using namespace mx;
    const bf16* KR = F.PROJ + 4 * (size_t)TT * 512; const bf16* VR = F.PROJ + 5 * (size_t)TT * 512;
    const int wid = F.wave, lane = F.lane, r32 = lane & 31, hi = lane >> 5;
    const unsigned lds0 = (unsigned)(size_t)F.lds; const lds_cptr L = (lds_cptr)F.lds;
    for (int it = blockIdx.x; it < 1024; it += F.G) {
        const int b = it >> 9, h = (it >> 6) & 7, c = it & 63; const size_t row0 = (size_t)b * SEQ + c * 256;
        MX_LBAR();
#pragma unroll
        for (int kt = 0; kt < 4; ++kt) { dma_timg(KR + (row0 + 64 * kt) * 512 + h * 64, lds0 + L_K + kt * 8192, wid, lane); dma_timg(VR + (row0 + 64 * kt) * 512 + h * 64, lds0 + L_V + kt * 8192, wid, lane); }
        MX_WAIT_BAR();
        const int dt = wid & 1, et = (wid >> 1) & 1, kh = wid >> 2; f32x16 acc = {};
#pragma unroll
        for (int k = 0; k < 8; ++k) { const int kt = 2 * kh + (k >> 2), ks = k & 3;
            acc = __builtin_amdgcn_mfma_f32_32x32x16_bf16(tfrag_perm(L + L_K + kt * 8192, ks, dt, lane, hi), tfrag_perm(L + L_V + kt * 8192, ks, et, lane, hi), acc, 0, 0, 0); }
        LAS float* red = (LAS float*)(F.lds + L_STG) + (wid & 3) * 1024;
        if (kh == 1) {
#pragma unroll
            for (int r = 0; r < 16; ++r) red[r * 64 + lane] = acc[r];
        }
        MX_LBAR();
        if (kh == 0) { const float sc = F.dpos[h * 256 + 255]; float* dst = F.KV + (size_t)it * 4096 + (32 * dt + 4 * hi) * 64 + 32 * et + r32;
#pragma unroll
            for (int r = 0; r < 16; ++r) dst[((r & 3) + 8 * (r >> 2)) * 64] = (acc[r] + red[r * 64 + lane]) * sc; }
    }
    MX_LBAR();
}
__device__ __forceinline__ void p4_ret_mfma(Frame& F) {
    using namespace mx;
    const bf16* QR = F.PROJ + 3 * (size_t)TT * 512; const bf16* KR = F.PROJ + 4 * (size_t)TT * 512; const bf16* VR = F.PROJ + 5 * (size_t)TT * 512; const bf16* GR = F.PROJ + 6 * (size_t)TT * 512;
    const int wid = F.wave, lane = F.lane, r32 = lane & 31, hi = lane >> 5;
    const unsigned lds0 = (unsigned)(size_t)F.lds; const lds_cptr L = (lds_cptr)F.lds;
    for (int it = blockIdx.x; it < 1024; it += F.G) {
        const int b = it >> 9, h = (it >> 6) & 7, c = it & 63; const size_t row0 = (size_t)b * SEQ + c * 256;
        MX_LBAR();
#pragma unroll
        for (int kt = 0; kt < 4; ++kt) { dma_kimg(KR + (row0 + 64 * kt) * 512 + h * 64, lds0 + L_K + kt * 8192, wid, lane); dma_timg(VR + (row0 + 64 * kt) * 512 + h * 64, lds0 + L_V + kt * 8192, wid, lane); }
        {
            const int d = F.tid >> 3, e0 = (F.tid & 7) * 8; const float g = F.gam[h];
            const GAS f32x4* rp = (const GAS f32x4*)(F.RP + (size_t)it * 4096 + d * 64 + e0); const f32x4 a = rp[0], bq = rp[1];
            u32x4 w = {cvtpk(a.x * g, a.y * g), cvtpk(a.z * g, a.w * g), cvtpk(bq.x * g, bq.y * g), cvtpk(bq.z * g, bq.w * g)};
            *(LAS u32x4*)(F.lds + L_R + ((e0 >> 5) * 4 + (d >> 4)) * 1024 + (d & 15) * 64 + (e0 & 31) * 2) = w; }
        bf16x8 qr[4];
        { const bf16* qp = QR + (row0 + 32 * wid + r32) * 512 + h * 64 + hi * 8;
#pragma unroll
          for (int d0 = 0; d0 < 4; ++d0) qr[d0] = *(const bf16x8*)(qp + d0 * 16); }
        MX_WAIT_BAR();
        f32x16 o[2]; o[0] = f32x16{}; o[1] = f32x16{};
        const int ktd = wid >> 1;
        for (int kt = 0; kt <= ktd; ++kt) {
            f32x16 p0, p1; qkt(p0, p1, L + L_K + kt * 8192, qr, r32, hi);
            if (kt == ktd) { const int qrel = 32 * (wid & 1) + r32;
#pragma unroll
                for (int r = 0; r < 16; ++r) { const int kv = crow(r, hi); if (kv > qrel) p0[r] = 0.f; if (kv + 32 > qrel) p1[r] = 0.f; } }
            pv64(o, p0, p1, L + L_V + kt * 8192, lane, hi);
        }
#pragma unroll
        for (int d0 = 0; d0 < 2; ++d0)
#pragma unroll
            for (int ks = 0; ks < 4; ++ks) o[d0] = __builtin_amdgcn_mfma_f32_32x32x16_bf16(qr[ks], tfrag_nat(L + L_R, ks, d0, lane, hi), o[d0], 0, 0, 0);
        LAS bf16* stg = (LAS bf16*)(F.lds + L_STG) + wid * 2048;
#pragma unroll
        for (int r = 0; r < 16; ++r) {
            float s1 = o[0][r] + o[1][r], s2 = o[0][r] * o[0][r] + o[1][r] * o[1][r];
#pragma unroll
            for (int x = 1; x < 32; x <<= 1) { s1 += __shfl_xor(s1, x); s2 += __shfl_xor(s2, x); }
            const float mu = s1 * (1.f / 64.f), var = s2 * (1.f / 64.f) - mu * mu, rs = 1.0f / sqrtf(fmaxf(var, 0.f) + EPS);
            const int orow = crow(r, hi);
            stg[orow * 64 + r32] = (bf16)(cvtpk((o[0][r] - mu) * rs, 0.f) & 0xffffu); stg[orow * 64 + 32 + r32] = (bf16)(cvtpk((o[1][r] - mu) * rs, 0.f) & 0xffffu);
        }
        LDS_WAIT();
#pragma unroll
        for (int i = 0; i < 4; ++i) { const int row = i * 8 + (lane >> 3), ch = lane & 7; const size_t grow = row0 + 32 * wid + row;
            const u32x4 yv = *(const LAS u32x4*)(stg + row * 64 + ch * 8); const u32x4 gv = *(const GAS u32x4*)(GR + grow * 512 + h * 64 + ch * 8);
            u32x4 ov;
#define P4_G(yw, gw) cvtpk(bflo(gw) / (1.0f + __expf(-bflo(gw))) * bflo(yw), bfhi(gw) / (1.0f + __expf(-bfhi(gw))) * bfhi(yw))
            ov.x = P4_G(yv.x, gv.x); ov.y = P4_G(yv.y, gv.y); ov.z = P4_G(yv.z, gv.z); ov.w = P4_G(yv.w, gv.w);
#undef P4_G
            *(GAS u32x4*)(F.Y + grow * 1024 + 512 + h * 64 + ch * 8) = ov; }
    }
    MX_LBAR();
}

__device__ __forceinline__ void rows_residual(Frame& F, const float* xin, const bf16* Yb, const float* gpost, float* xout, bf16* XNo) {
    const int gw = F.vcu * NWAVES + F.wave, NGW = F.G * NWAVES;
    for (int m = gw; m < TT; m += NGW) {
        float ss = 0.f;
        { const GAS f32x4* rp = (const GAS f32x4*)(F.rowss + (size_t)m * 16);
#pragma unroll
          for (int i = 0; i < 4; ++i) { const f32x4 r = rp[i]; ss += (r.x + r.y) + (r.z + r.w); } }
        const float rstd = 1.0f / sqrtf(ss * (1.f / DM) + EPS);
        const GAS f32x4* xr = (const GAS f32x4*)(xin + (size_t)m * DM) + F.lane;
        const GAS u32x2v* yr = (const GAS u32x2v*)(Yb + (size_t)m * DM) + F.lane;
        const GAS f32x4* gr = (const GAS f32x4*)gpost + F.lane;
        GAS f32x4* orow = (GAS f32x4*)(xout + (size_t)m * DM) + F.lane;
        f32x4 v[4]; float s2 = 0.f;
#pragma unroll
        for (int j = 0; j < 4; ++j) { const f32x4 xv = xr[64 * j]; const u32x2v yw = yr[64 * j]; const f32x4 g = gr[64 * j];
            v[j].x = xv.x + bflo(yw.x) * rstd * g.x; v[j].y = xv.y + bfhi(yw.x) * rstd * g.y; v[j].z = xv.z + bflo(yw.y) * rstd * g.z; v[j].w = xv.w + bfhi(yw.y) * rstd * g.w;
            orow[64 * j] = v[j]; s2 += (v[j].x * v[j].x + v[j].y * v[j].y) + (v[j].z * v[j].z + v[j].w * v[j].w); }
        if (XNo) {
            const float r2 = 1.0f / sqrtf(wave_sum(s2) * (1.f / DM) + EPS);
            GAS unsigned long long* o8 = (GAS unsigned long long*)(XNo + (size_t)m * DM) + F.lane;
#pragma unroll
            for (int j = 0; j < 4; ++j) o8[64 * j] = (unsigned long long)pk2(v[j].x * r2, v[j].y * r2) | ((unsigned long long)pk2(v[j].z * r2, v[j].w * r2) << 32);
        }
    }
}
__device__ __forceinline__ float gelu_tanh(float a) { const float z = 0.7978845608028654f * (a + 0.044715f * a * a * a); return a * (1.0f - 1.0f / (__expf(2.0f * z) + 1.0f)); }
__device__ __forceinline__ void p8_conv(Frame& F, int hb) {
    const int gw = F.vcu * NWAVES + F.wave, NGW = F.G * NWAVES;
    constexpr int RSEG = 32, NSEG = SEQ / RSEG;
    for (int it = gw; it < 11 * NSEG; it += NGW) {
        const int strip = it % 11, seg = it / 11, c = strip * 256 + F.lane * 4, r0 = seg * RSEG;
        f32x4 wa[3], wb[3];
#pragma unroll
        for (int j = 0; j < 3; ++j) { wa[j] = *(const GAS f32x4*)(F.conv_w + (size_t)j * NUP + c); wb[j] = *(const GAS f32x4*)(F.conv_w + (size_t)j * NUP + DFF + c); }
        const f32x4 ba = *(const GAS f32x4*)(F.conv_b + c), bb = *(const GAS f32x4*)(F.conv_b + DFF + c);
        f32x4 a2 = {0.f, 0.f, 0.f, 0.f}, a1 = a2, b2 = a2, b1 = a2;
#define P8_LD(r, ua, ub) do { const u32x2v wa_ = *(const GAS u32x2v*)(Ub + (size_t)(r) * NUP + c), wb_ = *(const GAS u32x2v*)(Ub + (size_t)(r) * NUP + DFF + c); \
            ua = (f32x4){bflo(wa_.x), bfhi(wa_.x), bflo(wa_.y), bfhi(wa_.y)}; ub = (f32x4){bflo(wb_.x), bfhi(wb_.x), bflo(wb_.y), bfhi(wb_.y)}; } while (0)
        const bf16* Ub = F.U;
        if (r0 >= 2) { P8_LD(r0 - 2, a2, b2); P8_LD(r0 - 1, a1, b1); }
        for (int r = r0; r < r0 + RSEG; ++r) {
            f32x4 ua, ub; P8_LD(r, ua, ub);
            const f32x4 av = ba + wa[0] * a2 + wa[1] * a1 + wa[2] * ua, bv = bb + wb[0] * b2 + wb[1] * b1 + wb[2] * ub;
            u32x2v o; o.x = pk2(gelu_tanh(av.x) * bv.x, gelu_tanh(av.y) * bv.y); o.y = pk2(gelu_tanh(av.z) * bv.z, gelu_tanh(av.w) * bv.w);
            *(GAS u32x2v*)(F.Fb + ((size_t)hb * SEQ + r) * DFF + c) = o;
            a2 = a1; a1 = ua; b2 = b1; b1 = ub;
        }
    }
}

constexpr int NPHASE = 13;
struct Args { const float* in[12]; float* out; unsigned char* ws; int ph_lo, ph_hi; };
__global__ void __launch_bounds__(NWAVES * 64, 2) fwd_kernel(Args args) {
    extern __shared__ __attribute__((aligned(16))) unsigned char lds[];
    Frame F;
    F.lds = (LAS unsigned char*)lds; F.MISC = (volatile LAS unsigned*)(F.lds + MISC_OFF);
    F.tid = threadIdx.x; F.lane = F.tid & 63; F.wave = __builtin_amdgcn_readfirstlane(F.tid >> 6);
    F.G = gridDim.x; { const int bx = blockIdx.x; F.vcu = (F.G % 8 == 0) ? (bx % 8) * (F.G / 8) + bx / 8 : bx; }
    unsigned char* ws = args.ws;
    F.ctl = (gu32*)(ws + WS_CTL);
    F.x = args.in[0]; F.g_mix_pre = args.in[1]; F.w_in = args.in[2]; F.rel_bias = args.in[3]; F.w_out = args.in[4]; F.g_mix_post = args.in[5];
    F.g_ffn_pre = args.in[6]; F.w_up = args.in[7]; F.conv_w = args.in[8]; F.conv_b = args.in[9]; F.w_down = args.in[10]; F.g_ffn_post = args.in[11]; F.out = args.out;
    F.Win_t = (bf16*)(ws + WS_WIN); F.Wout_t = (bf16*)(ws + WS_WOUT); F.Wup_t = (bf16*)(ws + WS_WUP); F.Wdn_t = (bf16*)(ws + WS_WDN);
    F.XN = (bf16*)(ws + WS_XN); F.PROJ = (bf16*)(ws + WS_PROJ); F.Y = (bf16*)(ws + WS_Y); F.Y1 = (bf16*)(ws + WS_Y1); F.U = (bf16*)(ws + WS_U); F.Fb = (bf16*)(ws + WS_F);
    F.cs = (float*)(ws + WS_CS); F.biasd = (float*)(ws + WS_SMALL + SM_BIASD); F.dpos = (float*)(ws + WS_SMALL + SM_DPOS); F.dneg = (float*)(ws + WS_SMALL + SM_DNEG);
    F.gam = (float*)(ws + WS_SMALL + SM_GAM); F.g256 = (float*)(ws + WS_SMALL + SM_G256);
    F.kms = (float*)(ws + WS_KMS); F.rowss = (float*)(ws + WS_ROWSS); F.KV = (float*)(ws + WS_KV); F.RP = (float*)(ws + WS_RP); F.sel = (unsigned*)(ws + WS_SEL);
    for (int u = F.tid; u < (LDS_BYTES - LDSCTL_OFF) / 4; u += NWAVES * 64) ((LAS unsigned*)(F.lds + LDSCTL_OFF))[u] = 0u;
    __syncthreads();
    XcdBarrier bar; bar.bar = (unsigned*)(F.ctl + CW_BAR); bar.x = 0; bar.st = nullptr;
    if (MK_ONE_LAUNCH) bar = xcd_barrier_post((unsigned*)(F.ctl + CW_BAR), F.MISC + 8);
    const int lo = args.ph_lo, hi = args.ph_hi;
#define IN(k) (lo <= (k) && (k) < hi)
#define SEAM(k) do { if (IN(k) && IN((k) + 1)) xcd_barrier(bar); } while (0)

    if (IN(0)) { p0_prologue(F); }
#if MK_ONE_LAUNCH
    if (IN(0) && IN(1)) { cooperative_groups::this_grid().sync(); }
#endif
    if (IN(1)) {
        pg8::Gemm g{F.XN, F.Win_t, TT, NPROJ, DM}; pg8::StaticOrder S; S.init(TT, NPROJ, F.G, (int)blockIdx.x);
        pg8::EpiProj E{F.PROJ, F.cs, F.dpos, F.dneg, F.kms};
        pg8::gemm_phase<pg8::EpiProj, pg8::StaticOrder, PG8_ALIGN, PG8_SP2>(F.lds + RING_OFF, g, S, E);
    } SEAM(1);
    if (IN(2)) { p2_gate(F); __syncthreads(); p2_kv_mfma(F); } SEAM(2);
    if (IN(3)) { p3_scan(F); p3_moba_simple(F); } SEAM(3);
    if (IN(4)) { p4_ret_mfma(F); } SEAM(4);
    if (IN(5)) {
        pg8::Gemm g{F.Y, F.Wout_t, TT, DM, DM}; pg8::StaticOrder S; S.init(TT, DM, F.G, (int)blockIdx.x);
        pg8::EpiY E{F.Y1, F.rowss};
        pg8::gemm_phase<pg8::EpiY, pg8::StaticOrder, PG8_ALIGN, PG8_SP2>(F.lds + RING_OFF, g, S, E);
    } SEAM(5);
    if (IN(6)) { rows_residual(F, F.x, F.Y1, F.g_mix_post, F.out, F.XN); } SEAM(6);
#pragma unroll 1
    for (int hb = 0; hb < 2; ++hb) {
        if (IN(7 + 2 * hb)) {
            pg8::Gemm g{F.XN + (size_t)hb * SEQ * DM, F.Wup_t, SEQ, NUP, DM}; pg8::StaticOrder S; S.init(SEQ, NUP, F.G, (int)blockIdx.x);
            pg8::EpiBf16<0> E{F.U, NUP, nullptr, 0, 0, 1.f};
            pg8::gemm_phase<pg8::EpiBf16<0>, pg8::StaticOrder, PG8_ALIGN, PG8_SP2>(F.lds + RING_OFF, g, S, E);
        } SEAM(7 + 2 * hb);
        if (IN(8 + 2 * hb)) { p8_conv(F, hb); } SEAM(8 + 2 * hb);
    }
    if (IN(11)) {
        pg8::Gemm g{F.Fb, F.Wdn_t, TT, DM, DFF}; pg8::StaticOrder S; S.init(TT, DM, F.G, (int)blockIdx.x);
        pg8::EpiY E{F.Y1, F.rowss};
        pg8::gemm_phase<pg8::EpiY, pg8::StaticOrder, PG8_ALIGN, PG8_SP2>(F.lds + RING_OFF, g, S, E);
    } SEAM(11);
    if (IN(12)) { rows_residual(F, F.out, F.Y1, F.g_ffn_post, F.out, nullptr); }
#undef IN
#undef SEAM
}

extern "C" void kernel_launch(void* const* d_in, const int* in_sizes, int n_in, void* d_out, int out_size, void* d_ws, size_t ws_size, hipStream_t stream) {
    static int grid = 0;
    if (grid == 0) {
        if (n_in != 12 || in_sizes[0] != TT * DM || out_size != TT * DM || ws_size < WS_END) { fprintf(stderr, "kernel_launch: unexpected shapes (n_in %d in0 %d out %d ws %zu)\n", n_in, n_in > 0 ? in_sizes[0] : -1, out_size, ws_size); grid = -1; return; }
        int dev = 0, cus = 0, per_cu = 0;
        if (hipGetDevice(&dev) != hipSuccess || hipDeviceGetAttribute(&cus, hipDeviceAttributeMultiprocessorCount, dev) != hipSuccess) { grid = -1; return; }
        if (hipFuncSetAttribute((const void*)fwd_kernel, hipFuncAttributeMaxDynamicSharedMemorySize, LDS_BYTES) != hipSuccess) { fprintf(stderr, "kernel_launch: hipFuncSetAttribute failed\n"); grid = -1; return; }
        if (hipOccupancyMaxActiveBlocksPerMultiprocessor(&per_cu, (const void*)fwd_kernel, NWAVES * 64, LDS_BYTES) != hipSuccess || per_cu < 1) { fprintf(stderr, "kernel_launch: occupancy query says %d\n", per_cu); per_cu = 1; }
        (void)hipGetLastError();
        grid = cus * (per_cu < 1 ? 1 : 1);
    }
    if (grid < 0) return;
    if (hipMemsetAsync((char*)d_ws + WS_CTL, 0, CTL_ZERO_BYTES, stream) != hipSuccess) { fprintf(stderr, "kernel_launch: memset failed\n"); return; }
    Args a{};
    for (int i = 0; i < 12; ++i) a.in[i] = (const float*)d_in[i];
    a.out = (float*)d_out; a.ws = (unsigned char*)d_ws;
#if MK_ONE_LAUNCH
    a.ph_lo = 0; a.ph_hi = NPHASE;
    void* kargs[] = {&a};
    hipError_t e = hipLaunchCooperativeKernel((const void*)fwd_kernel, dim3(grid), dim3(NWAVES * 64), kargs, LDS_BYTES, stream);
    if (e != hipSuccess) fprintf(stderr, "kernel_launch: cooperative launch failed: %s\n", hipGetErrorString(e));
#else
    for (int p = 0; p < NPHASE; ++p) { a.ph_lo = p; a.ph_hi = p + 1; hipLaunchKernelGGL(fwd_kernel, dim3(grid), dim3(NWAVES * 64), LDS_BYTES, stream, a); }
#endif
}
```

```cpp
#include <hip/hip_runtime.h>
#include <hip/hip_cooperative_groups.h>
#include <cstdio>
#include <cstdint>
#define MK_ONE_LAUNCH 1
namespace pg8 {
#define PG8_LAS __attribute__((address_space(3)))
typedef unsigned short bf16_t;
typedef short bf16x8 __attribute__((ext_vector_type(8)));
typedef float f32x4 __attribute__((ext_vector_type(4)));
typedef unsigned u32x4 __attribute__((ext_vector_type(4)));
constexpr int BM = 256, BK = 64, HALF = 128, HTB = HALF * BK * 2  , STAGE_BYTES = 8 * HTB, NXCD = 8, WGM = 8;

__host__ __device__ __forceinline__ int lds_byte(int r, int c) { const int st = (r >> 4) * 2 + (c >> 5), rr = r & 15, cc = c & 31, ob = rr * 64 + cc * 2; return st * 1024 + (ob ^ (((ob >> 9) & 1) << 5)); }
__host__ __device__ __forceinline__ void stage_rc(int b, int& R, int& C) { const int st = b / 1024, sb = b % 1024, swz = sb ^ (((sb >> 9) & 1) << 5); R = (st >> 1) * 16 + swz / 64; C = (st & 1) * 32 + (swz % 64) / 2; }
__host__ __device__ __forceinline__ int perm32(int rho) { const int n = rho >> 4, i = rho & 15; return 8 * (i >> 2) + 4 * n + (i & 3); }

struct Unit { int pm, pn; };
struct Gemm { const bf16_t* A; const bf16_t* Bt; int M, N, K; };

struct StaticOrder {
    int nM, nN, nwg, G, c;
    __host__ __device__ void init(int M, int N, int G_, int c_) { nM = M / BM; nN = N / BM; nwg = nM * nN; G = G_; c = c_; }
    __host__ __device__ bool next(int i, Unit& u) const {
        const long L = (long)i * G + c; if (L >= nwg) return false;
        int wgid = (int)L; { const int q = nwg / NXCD, r = nwg % NXCD, xcd = wgid % NXCD, off = wgid / NXCD; wgid = (xcd < r ? xcd * (q + 1) : r * (q + 1) + (xcd - r) * q) + off; }
        const int nig = WGM * nN, gid = wgid / nig, fm = gid * WGM, gsz = (nM - fm) < WGM ? (nM - fm) : WGM;
        u.pm = fm + ((wgid % nig) % gsz); u.pn = (wgid % nig) / gsz; return true;
    }
    __device__ __forceinline__ void a_ready(const Unit&) const {}
    __device__ __forceinline__ void done(const Unit&) const {}
};

__device__ __forceinline__ unsigned cvt_pk_bf16(float lo, float hi) { unsigned r; asm volatile("v_cvt_pk_bf16_f32 %0, %1, %2" : "=v"(r) : "v"(lo), "v"(hi)); return r; }
typedef float f32x2 __attribute__((ext_vector_type(2)));
__device__ __forceinline__ f32x2 gelu_pk(f32x2 v) {
    const f32x2 av = __builtin_elementwise_abs(v), d = av * 0.2316418882f + 1.0f;
    f32x2 t; t.x = __builtin_amdgcn_rcpf(d.x); t.y = __builtin_amdgcn_rcpf(d.y);
    f32x2 q = t * 0.5307027145f + (-0.7265760135f); q = q * t + 0.7107068705f; q = q * t + (-0.142248368f); q = q * t + 0.127414796f; q = q * t;
    const f32x2 s = (v * v) * (-0.72134752044f);
    f32x2 e; e.x = __builtin_amdgcn_exp2f(s.x); e.y = __builtin_amdgcn_exp2f(s.y);
    const f32x2 m = v * (q * e), r = v - m;
    f32x2 o; o.x = v.x < 0.f ? m.x : r.x; o.y = v.y < 0.f ? m.y : r.y; return o;
}

template <int ACT  > struct EpiBf16 {
    static constexpr bool PERM = true, AFTER_DRAIN = false; static_assert(ACT == 0 || ACT == 1, "EpiBf16: ACT is 0 (none) or 1 (gelu_pk)");
    bf16_t* O; int ldc; const float* bias; int split_cols; size_t split_stride; float scale0;
    __device__ __forceinline__ void operator()(const f32x4 (&acc)[2][2][4][2], const Unit& u, int wr, int wc, int fr, int fq) const {
        const int row0 = u.pm * BM + wr * 64 + fr; int colt = u.pn * BM; bf16_t* base = O;
        float sc = 1.f; if (split_cols) { const int t = colt / split_cols; base += (size_t)t * split_stride; colt -= t * split_cols; if (t == 0) sc = scale0; }
        const int col0 = colt + wc * 32 + 8 * fq, bcol0 = u.pn * BM + wc * 32 + 8 * fq;
        f32x4 bv[2][2];
#pragma unroll
        for (int bj = 0; bj < 2; ++bj)
#pragma unroll
            for (int n = 0; n < 2; ++n) bv[bj][n] = bias ? *(const f32x4*)(bias + bcol0 + bj * HALF + 4 * n) : (f32x4){0.f, 0.f, 0.f, 0.f};
#pragma unroll
        for (int ai = 0; ai < 2; ++ai)
#pragma unroll
            for (int m = 0; m < 4; ++m) { bf16_t* rowp = base + (size_t)(row0 + ai * HALF + m * 16) * ldc + col0;
#pragma unroll
                for (int bj = 0; bj < 2; ++bj) { f32x4 v0 = acc[ai][bj][m][0] + bv[bj][0], v1 = acc[ai][bj][m][1] + bv[bj][1];
                    if (ACT == 1) { f32x2 a = gelu_pk((f32x2){v0[0], v0[1]}), b = gelu_pk((f32x2){v0[2], v0[3]}), c = gelu_pk((f32x2){v1[0], v1[1]}), d = gelu_pk((f32x2){v1[2], v1[3]});
                        v0 = (f32x4){a.x, a.y, b.x, b.y}; v1 = (f32x4){c.x, c.y, d.x, d.y}; }
                    v0 = v0 * sc; v1 = v1 * sc; u32x4 w; w.x = cvt_pk_bf16(v0[0], v0[1]); w.y = cvt_pk_bf16(v0[2], v0[3]); w.z = cvt_pk_bf16(v1[0], v1[1]); w.w = cvt_pk_bf16(v1[2], v1[3]);
                    *(u32x4*)(rowp + bj * HALF) = w; } }
    }
};
template <class Epi, class Sched, bool ALIGN_EPI = false, bool SP2 = false>
__device__ __forceinline__ void gemm_phase(PG8_LAS unsigned char* lds, const Gemm g, const Sched& S, const Epi& E) {
    const int tid = threadIdx.x, wid = __builtin_amdgcn_readfirstlane(tid >> 6), lane = tid & 63, wr = wid >> 2, wc = wid & 3, fr = lane & 15, fq = lane >> 4;
    const int K = g.K, nt = K / BK;
    unsigned voffA[2], voffB[2];
#pragma unroll
    for (int i = 0; i < 2; ++i) { int R, C; stage_rc(tid * 16 + i * 8192, R, C); const int Rb = Epi::PERM ? ((R & ~31) + perm32(R & 31)) : R;
        voffA[i] = (unsigned)(R * K + C) * 2u; voffB[i] = (unsigned)(Rb * K + C) * 2u; }
    const size_t kstep = (size_t)(BK * 2);
    const size_t hstep = (size_t)HALF * K * 2;
    const size_t tstep = 2 * hstep;
    const unsigned ldsw = (unsigned)wid * 1024u;
    const int aoff = lds_byte(wr * 64 + fr, fq * 8), boff = lds_byte(wc * 32 + fr, fq * 8);
#define PG8_SA(b, h) (((b) * 2 + (h)) * HTB)
#define PG8_SB(b, h) ((4 + (b) * 2 + (h)) * HTB)
#define PG8_STAGE(bufoff, gbase, voff) do { _Pragma("unroll") for (int _i = 0; _i < 2; ++_i) \
        __builtin_amdgcn_global_load_lds((const unsigned*)((const char*)(gbase) + (voff)[_i]), (PG8_LAS unsigned*)(lds + (bufoff) + ldsw + _i * 8192), 16, 0, 0); } while (0)
#define PG8_LDA(dst, b, h) do { _Pragma("unroll") for (int m = 0; m < 4; ++m) _Pragma("unroll") for (int k = 0; k < 2; ++k) dst[m][k] = *(const PG8_LAS bf16x8*)(lds + PG8_SA(b, h) + aoff + m * 2048 + k * 1024); } while (0)
#define PG8_LDB(dst, b, h) do { _Pragma("unroll") for (int n = 0; n < 2; ++n) _Pragma("unroll") for (int k = 0; k < 2; ++k) dst[n][k] = *(const PG8_LAS bf16x8*)(lds + PG8_SB(b, h) + boff + n * 2048 + k * 1024); } while (0)
#define PG8_MMA(ai, bj, At, Bt) do { __builtin_amdgcn_s_setprio(1); _Pragma("unroll") for (int m = 0; m < 4; ++m) _Pragma("unroll") for (int n = 0; n < 2; ++n) _Pragma("unroll") for (int k = 0; k < 2; ++k) \
        acc[ai][bj][m][n] = __builtin_amdgcn_mfma_f32_16x16x32_bf16(Bt[n][k], At[m][k], acc[ai][bj][m][n], 0, 0, 0); __builtin_amdgcn_s_setprio(0); } while (0)
#define PG8_WAIT_V(n) asm volatile("s_waitcnt vmcnt(" #n ")" ::: "memory")
#define PG8_WAIT_L(n) asm volatile("s_waitcnt lgkmcnt(" #n ")" ::: "memory")
#define PG8_BAR __builtin_amdgcn_s_barrier()
#define PG8_SCHED __builtin_amdgcn_sched_barrier(0)
    Unit cur, nxt; int ui = 0;
    if (!S.next(0, cur)) return;
    f32x4 acc[2][2][4][2];
#pragma unroll
    for (int a = 0; a < 2; ++a)
#pragma unroll
        for (int b = 0; b < 2; ++b)
#pragma unroll
            for (int m = 0; m < 4; ++m)
#pragma unroll
                for (int n = 0; n < 2; ++n) acc[a][b][m][n] = (f32x4){0.f, 0.f, 0.f, 0.f};
    bf16x8 At[4][2], B0[2][2], B1[2][2];
    const char* cA = (const char*)g.A + (size_t)cur.pm * tstep; const char* cB = (const char*)g.Bt + (size_t)cur.pn * tstep;
    S.a_ready(cur);
    if constexpr (SP2) {
        PG8_STAGE(PG8_SB(0, 0), cB, voffB); PG8_STAGE(PG8_SB(0, 1), cB + hstep, voffB); PG8_STAGE(PG8_SA(0, 0), cA, voffA); PG8_STAGE(PG8_SA(0, 1), cA + hstep, voffA);
        if (wr == 1) PG8_BAR;
        PG8_WAIT_V(2); PG8_BAR;
        PG8_STAGE(PG8_SB(1, 0), cB + kstep, voffB); PG8_STAGE(PG8_SA(1, 0), cA + kstep, voffA); PG8_STAGE(PG8_SB(1, 1), cB + hstep + kstep, voffB);
        PG8_WAIT_V(6); PG8_BAR;
    } else {
        PG8_STAGE(PG8_SB(0, 0), cB, voffB); PG8_STAGE(PG8_SA(0, 0), cA, voffA); PG8_STAGE(PG8_SB(0, 1), cB + hstep, voffB); PG8_STAGE(PG8_SA(0, 1), cA + hstep, voffA);
        if (wr == 1) PG8_BAR;
        PG8_WAIT_V(4); PG8_BAR;
        PG8_STAGE(PG8_SB(1, 0), cB + kstep, voffB); PG8_STAGE(PG8_SA(1, 0), cA + kstep, voffA); PG8_STAGE(PG8_SB(1, 1), cB + hstep + kstep, voffB);
        PG8_WAIT_V(6); PG8_BAR;
    }
    for (;;) {
        const bool has_next = S.next(ui + 1, nxt);
        const char* nA = has_next ? (const char*)g.A + (size_t)nxt.pm * tstep : cA; const char* nB = has_next ? (const char*)g.Bt + (size_t)nxt.pn * tstep : cB;
        for (int t = 0; t < nt; t += 2) {
            const bool last = (t == nt - 2);
            const char* a1 = cA + (size_t)(t + 1) * kstep;
            const char* a2 = last ? nA : cA + (size_t)(t + 2) * kstep; const char* b2 = last ? nB : cB + (size_t)(t + 2) * kstep;
            const char* a3 = a2 + kstep; const char* b3 = b2 + kstep;
            if (last && has_next) S.a_ready(nxt);
            if constexpr (SP2) {
            PG8_LDB(B0, 0, 0); PG8_LDB(B1, 0, 1); PG8_SCHED; PG8_LDA(At, 0, 0); PG8_STAGE(PG8_SA(1, 1), a1 + hstep, voffA);
            PG8_WAIT_V(8); PG8_WAIT_L(0); PG8_BAR; PG8_MMA(0, 0, At, B0); PG8_MMA(0, 1, At, B1); PG8_BAR; PG8_SCHED;
            PG8_LDA(At, 0, 1); PG8_STAGE(PG8_SB(0, 0), b2, voffB); PG8_STAGE(PG8_SB(0, 1), b2 + hstep, voffB); PG8_STAGE(PG8_SA(0, 0), a2, voffA);
            PG8_WAIT_V(8); PG8_WAIT_L(0); PG8_BAR; PG8_MMA(1, 0, At, B0); PG8_MMA(1, 1, At, B1); PG8_BAR; PG8_SCHED;
            PG8_LDB(B0, 1, 0); PG8_LDB(B1, 1, 1); PG8_SCHED; PG8_LDA(At, 1, 0); PG8_STAGE(PG8_SA(0, 1), a2 + hstep, voffA);
            PG8_WAIT_V(8); PG8_WAIT_L(0); PG8_BAR; PG8_MMA(0, 0, At, B0); PG8_MMA(0, 1, At, B1); PG8_BAR; PG8_SCHED;
            PG8_LDA(At, 1, 1); PG8_STAGE(PG8_SB(1, 0), b3, voffB); PG8_STAGE(PG8_SB(1, 1), b3 + hstep, voffB); PG8_STAGE(PG8_SA(1, 0), a3, voffA);
            PG8_WAIT_V(8); PG8_WAIT_L(0); PG8_BAR; PG8_MMA(1, 0, At, B0); PG8_MMA(1, 1, At, B1); PG8_BAR; PG8_SCHED;
            } else {
            PG8_LDB(B0, 0, 0); PG8_SCHED; PG8_LDA(At, 0, 0); PG8_STAGE(PG8_SA(1, 1), a1 + hstep, voffA);
            PG8_WAIT_L(8); PG8_BAR; PG8_WAIT_L(0); PG8_MMA(0, 0, At, B0); PG8_BAR; PG8_SCHED;
            PG8_LDB(B1, 0, 1); PG8_STAGE(PG8_SB(0, 0), b2, voffB);
            PG8_BAR; PG8_WAIT_L(0); PG8_MMA(0, 1, At, B1); PG8_BAR;
            PG8_LDA(At, 0, 1); PG8_STAGE(PG8_SA(0, 0), a2, voffA);
            PG8_BAR; PG8_WAIT_L(0); PG8_MMA(1, 0, At, B0); PG8_BAR; PG8_SCHED;
            PG8_STAGE(PG8_SB(0, 1), b2 + hstep, voffB);
            PG8_WAIT_V(6); PG8_BAR; PG8_MMA(1, 1, At, B1); PG8_BAR;
            PG8_LDB(B0, 1, 0); PG8_SCHED; PG8_LDA(At, 1, 0); PG8_STAGE(PG8_SA(0, 1), a2 + hstep, voffA);
            PG8_WAIT_L(8); PG8_BAR; PG8_WAIT_L(0); PG8_MMA(0, 0, At, B0); PG8_BAR; PG8_SCHED;
            PG8_LDB(B1, 1, 1); PG8_STAGE(PG8_SB(1, 0), b3, voffB);
            PG8_BAR; PG8_WAIT_L(0); PG8_MMA(0, 1, At, B1); PG8_BAR;
            PG8_LDA(At, 1, 1); PG8_STAGE(PG8_SA(1, 0), a3, voffA);
            PG8_BAR; PG8_WAIT_L(0); PG8_MMA(1, 0, At, B0); PG8_BAR; PG8_SCHED;
            PG8_STAGE(PG8_SB(1, 1), b3 + hstep, voffB);
            PG8_WAIT_V(6); PG8_BAR; PG8_MMA(1, 1, At, B1); PG8_BAR;
            }
        }
        if constexpr (ALIGN_EPI) { if (wr == 0) PG8_BAR; }
        if constexpr (!Epi::AFTER_DRAIN) { E(acc, cur, wr, wc, fr, fq); S.done(cur); }
        if (!has_next) break;
#pragma unroll
        for (int a = 0; a < 2; ++a)
#pragma unroll
            for (int b = 0; b < 2; ++b)
#pragma unroll
                for (int m = 0; m < 4; ++m)
#pragma unroll
                    for (int n = 0; n < 2; ++n) acc[a][b][m][n] = (f32x4){0.f, 0.f, 0.f, 0.f};
        cur = nxt; cA = nA; cB = nB; ++ui;
        if constexpr (ALIGN_EPI) { if (wr == 1) PG8_BAR; }
    }
    PG8_WAIT_V(0);
    if constexpr (!ALIGN_EPI) { if (wr == 0) PG8_BAR; }
    PG8_BAR;
    if constexpr (Epi::AFTER_DRAIN) { E.fused(acc, cur, wr, wc, fr, fq, lds, wid, lane); S.done(cur); }
#undef PG8_SA
#undef PG8_SB
#undef PG8_STAGE
#undef PG8_LDA
#undef PG8_LDB
#undef PG8_MMA
#undef PG8_WAIT_V
#undef PG8_WAIT_L
#undef PG8_BAR
#undef PG8_SCHED
}
}

#ifndef PG8_SP2
#define PG8_SP2 true
#endif
#ifndef PG8_ALIGN
#define PG8_ALIGN true
#endif
#define GAS __attribute__((address_space(1)))
#define LAS __attribute__((address_space(3)))
typedef unsigned short bf16;
typedef unsigned v4u __attribute__((ext_vector_type(4)));
typedef float f32x4 __attribute__((ext_vector_type(4)));
typedef short bf16x8 __attribute__((ext_vector_type(8)));
typedef GAS unsigned gu32;
typedef GAS unsigned long long gu64;
#define RLX_AGENT __ATOMIC_RELAXED, __HIP_MEMORY_SCOPE_AGENT
#define LDS_WAIT() asm volatile("s_waitcnt lgkmcnt(0)" ::: "memory")
#define VM_WAIT() asm volatile("s_waitcnt vmcnt(0)" ::: "memory")
__device__ __forceinline__ unsigned long long rt() { return __builtin_amdgcn_s_memrealtime(); }
__device__ __forceinline__ unsigned f2bf(float f) { unsigned u = __builtin_bit_cast(unsigned, f); return (u + 0x7fffu + ((u >> 16) & 1u)) >> 16; }
__device__ __forceinline__ unsigned pk2(float lo, float hi) { return f2bf(lo) | (f2bf(hi) << 16); }

#define XB_TMO      128
#define XB_XCNT(j)  (256  + 64 * (j))
#define XB_XSUB(j)  (1280 + 64 * (j))
#define XB_XGEN(j)  (2304 + 64 * (j))
#define XB_TOP      3328
#define XB_TOPGEN   3392
#define XCD_BAR_WORDS 3456
#define XB_SPIN_CAP (1u << 18)

__device__ __forceinline__ unsigned xb_ld(unsigned* p)              { return __hip_atomic_load(p, __ATOMIC_RELAXED, __HIP_MEMORY_SCOPE_AGENT); }
__device__ __forceinline__ unsigned xb_add(unsigned* p, unsigned v) { return __hip_atomic_fetch_add(p, v, __ATOMIC_RELAXED, __HIP_MEMORY_SCOPE_AGENT); }
__device__ __forceinline__ unsigned xb_xcc_id() { return (unsigned)__builtin_amdgcn_s_getreg((3 << 11) | 20) & 0xFu; }
#define XB_SPIN(cond, bar) do { unsigned _sp = 0; while (cond) { __builtin_amdgcn_s_sleep(1); \
    if ((++_sp & 255u) == 0u) { if (xb_ld(&(bar)[XB_TMO])) break; if (_sp > XB_SPIN_CAP) { atomicAdd(&(bar)[XB_TMO], 1u); break; } } } } while (0)

struct XcdBarrier {
    unsigned* bar; unsigned x;
    volatile LAS unsigned* st;
};

__device__ __forceinline__ XcdBarrier xcd_barrier_post(unsigned* bar, volatile LAS unsigned* st) {
    XcdBarrier b; b.bar = bar; b.x = xb_xcc_id(); b.st = st;
    if (threadIdx.x == 0) (void)xb_add(&bar[XB_XCNT(b.x)], 1u);
    return b;
}
__device__ __forceinline__ void xcd_barrier_complete(unsigned* bar, unsigned x, unsigned& nloc, unsigned& nx) {
    const unsigned G = gridDim.x * gridDim.y * gridDim.z;
    unsigned sum, cnt, mine, sp = 0u;
    for (;;) {
        sum = 0u; cnt = 0u; mine = 0u;
#pragma unroll
        for (unsigned j = 0; j < 16; ++j) { const unsigned c = xb_ld(&bar[XB_XCNT(j)]); sum += c; cnt += (c > 0u) ? 1u : 0u; mine = (j == x) ? c : mine; }
        if (sum == G) break;
        __builtin_amdgcn_s_sleep(1);
        if ((++sp & 255u) == 0u) { if (xb_ld(&bar[XB_TMO])) break; if (sp > XB_SPIN_CAP) { atomicAdd(&bar[XB_TMO], 1u); break; } }
    }
    nloc = mine > 0u ? mine : 1u; nx = cnt > 0u ? cnt : 1u;
}

__device__ __forceinline__ void xcd_barrier(const XcdBarrier& b) {
    asm volatile("s_waitcnt vmcnt(0)" ::: "memory");
    __syncthreads();
    if (threadIdx.x == 0) {
        unsigned* bar = b.bar;
        __builtin_amdgcn_s_waitcnt(0);
        unsigned nloc = b.st[0], nx = b.st[1];
        if (nloc == 0u) { xcd_barrier_complete(bar, b.x, nloc, nx); b.st[0] = nloc; b.st[1] = nx; }
        const unsigned old = xb_add(&bar[XB_XSUB(b.x)], 1u);
        const unsigned gen = old / nloc;
        if (old + 1u == (gen + 1u) * nloc) {
            __builtin_amdgcn_fence(__ATOMIC_RELEASE, "agent");
            asm volatile("s_waitcnt vmcnt(0)" ::: "memory");
            const unsigned og = xb_add(&bar[XB_TOP], 1u);
            const unsigned tg = og / nx;
            if (og + 1u == (tg + 1u) * nx) xb_add(&bar[XB_TOPGEN], 1u);
            else XB_SPIN(xb_ld(&bar[XB_TOPGEN]) == tg, bar);
            __builtin_amdgcn_fence(__ATOMIC_ACQUIRE, "agent");
            xb_add(&bar[XB_XGEN(b.x)], 1u);
            asm volatile("s_waitcnt vmcnt(0)" ::: "memory");
        } else {
            XB_SPIN(xb_ld(&bar[XB_XGEN(b.x)]) == gen, bar);
            __builtin_amdgcn_fence(__ATOMIC_ACQUIRE, "agent");
            asm volatile("s_waitcnt vmcnt(0)" ::: "memory");
        }
    }
    __syncthreads();
}

constexpr int BATCH = 2, SEQ = 16384, DM = 1024, TT = BATCH * SEQ, NPROJ = 3584, DFF = 2816, NUP = 2 * DFF, NPANEL = TT / 256;
constexpr int NH = 8, HD = 64, HW = 512;
constexpr float EPS = 1e-6f;
#ifndef MK_ONE_LAUNCH
#define MK_ONE_LAUNCH 0
#endif

constexpr size_t MiB = 1u << 20;
constexpr size_t WS_CTL = 0, CTL_ZERO_BYTES = 1 * MiB;
constexpr size_t WS_WIN = 1 * MiB, WS_WOUT = 8 * MiB, WS_WUP = 10 * MiB, WS_WDN = 21 * MiB;
constexpr size_t WS_CS = 27 * MiB;
constexpr size_t WS_SMALL = 31 * MiB;
constexpr size_t SM_BIASD = 0, SM_DPOS = 8192, SM_DNEG = 16384, SM_GAM = 24576, SM_G256 = 24576 + 64;
constexpr size_t WS_KMS = 32 * MiB;
constexpr size_t WS_ROWSS = 33 * MiB;
constexpr size_t WS_SEL = 35 * MiB;
constexpr size_t WS_RUNS = 36 * MiB, WS_CNTW = 38 * MiB;
constexpr size_t WS_KV = 40 * MiB, WS_RP = 56 * MiB;
constexpr size_t WS_XN = 72 * MiB;
constexpr size_t WS_PROJ = 136 * MiB;
constexpr size_t PROJ_SEG = (size_t)TT * 512 * 2;
constexpr size_t WS_Y = 360 * MiB;
constexpr size_t WS_Y1 = 136 * MiB;
constexpr size_t WS_U = 136 * MiB;
constexpr size_t WS_F = 312 * MiB;
constexpr size_t WS_PO01 = 72 * MiB, WS_PO23 = 424 * MiB, PO_SLOT = (size_t)TT * 512 * 2;
constexpr size_t WS_ML = 488 * MiB;
constexpr size_t WS_END = 496 * MiB;
constexpr int CW_Q = 8192;
constexpr int CW_BAR = 4096;

typedef unsigned u32x4v __attribute__((ext_vector_type(4)));
typedef unsigned u32x2v __attribute__((ext_vector_type(2)));

__device__ __forceinline__ float bflo(unsigned w) { return __uint_as_float(w << 16); }
__device__ __forceinline__ float bfhi(unsigned w) { return __uint_as_float(w & 0xffff0000u); }
__device__ __forceinline__ float bf1(bf16 b) { return __uint_as_float((unsigned)b << 16); }

namespace pg8 {
struct EpiProj {
    static constexpr bool PERM = true, AFTER_DRAIN = false;
    bf16_t* proj; const float* cs; const float* dpos; const float* dneg; float* kms;
    __device__ __forceinline__ void operator()(const f32x4 (&acc)[2][2][4][2], const Unit& u, int wr, int wc, int fr, int fq) const {
        const int seg = u.pn >> 1, cb = (u.pn & 1) * 256;
        bf16_t* base = proj + (size_t)seg * ((size_t)TT * 512);
        const int row0 = u.pm * BM + wr * 64 + fr, colw = cb + wc * 32 + 8 * fq;
        if (seg == 3 || seg == 4) {
            const int i0 = 16 * (wc & 1) + 4 * fq;
#pragma unroll
            for (int ai = 0; ai < 2; ++ai)
#pragma unroll
                for (int m = 0; m < 4; ++m) {
                    const int row = row0 + ai * HALF + m * 16, t = row & (SEQ - 1), tl = t & 255;
                    const f32x4 c01 = *(const f32x4*)(cs + ((size_t)t * 32 + i0) * 2), c23 = *(const f32x4*)(cs + ((size_t)t * 32 + i0) * 2 + 4);
                    bf16_t* rowp = base + (size_t)row * 512 + colw;
#pragma unroll
                    for (int bj = 0; bj < 2; ++bj) {
                        const int head = (cb >> 6) + bj * 2 + (wc >> 1);
                        const float ds = (seg == 3) ? dpos[head * 256 + tl] : 0.125f * dneg[head * 256 + tl];
                        const f32x4 v0 = acc[ai][bj][m][0], v1 = acc[ai][bj][m][1];
                        u32x4 w;
                        w.x = cvt_pk_bf16((v0[0] * c01[0] - v0[1] * c01[1]) * ds, (v0[0] * c01[1] + v0[1] * c01[0]) * ds);
                        w.y = cvt_pk_bf16((v0[2] * c01[2] - v0[3] * c01[3]) * ds, (v0[2] * c01[3] + v0[3] * c01[2]) * ds);
                        w.z = cvt_pk_bf16((v1[0] * c23[0] - v1[1] * c23[1]) * ds, (v1[0] * c23[1] + v1[1] * c23[0]) * ds);
                        w.w = cvt_pk_bf16((v1[2] * c23[2] - v1[3] * c23[3]) * ds, (v1[2] * c23[3] + v1[3] * c23[2]) * ds);
                        *(u32x4*)(rowp + bj * HALF) = w;
                    }
                }
        } else {
            const float sc = (seg == 0) ? 0.18033688011112042f : 1.0f;
#pragma unroll
            for (int ai = 0; ai < 2; ++ai)
#pragma unroll
                for (int m = 0; m < 4; ++m) {
                    bf16_t* rowp = base + (size_t)(row0 + ai * HALF + m * 16) * 512 + colw;
#pragma unroll
                    for (int bj = 0; bj < 2; ++bj) {
                        const f32x4 v0 = acc[ai][bj][m][0] * sc, v1 = acc[ai][bj][m][1] * sc;
                        u32x4 w; w.x = cvt_pk_bf16(v0[0], v0[1]); w.y = cvt_pk_bf16(v0[2], v0[3]); w.z = cvt_pk_bf16(v1[0], v1[1]); w.w = cvt_pk_bf16(v1[2], v1[3]);
                        *(u32x4*)(rowp + bj * HALF) = w;
                    }
                }
            if (seg == 1) {
#pragma unroll
                for (int bj = 0; bj < 2; ++bj)
#pragma unroll
                    for (int n = 0; n < 2; ++n) {
                        f32x4 s = acc[0][bj][0][n];
#pragma unroll
                        for (int m = 1; m < 4; ++m) s += acc[0][bj][m][n];
#pragma unroll
                        for (int m = 0; m < 4; ++m) s += acc[1][bj][m][n];
#pragma unroll
                        for (int o = 1; o < 16; o <<= 1) { s[0] += __shfl_xor(s[0], o); s[1] += __shfl_xor(s[1], o); s[2] += __shfl_xor(s[2], o); s[3] += __shfl_xor(s[3], o); }
                        if (fr == 0) *(f32x4*)(kms + ((size_t)wr * NPANEL + u.pm) * 512 + colw + bj * HALF + 4 * n) = s;
                    }
            }
        }
    }
};
struct EpiY {
    static constexpr bool PERM = true, AFTER_DRAIN = false;
    bf16_t* Y; float* rowss;
    __device__ __forceinline__ void operator()(const f32x4 (&acc)[2][2][4][2], const Unit& u, int wr, int wc, int fr, int fq) const {
        const int row0 = u.pm * BM + wr * 64 + fr, colw = u.pn * BM + wc * 32 + 8 * fq;
#pragma unroll
        for (int ai = 0; ai < 2; ++ai)
#pragma unroll
            for (int m = 0; m < 4; ++m) {
                const int row = row0 + ai * HALF + m * 16;
                bf16_t* rowp = Y + (size_t)row * 1024 + colw; float ss = 0.f;
#pragma unroll
                for (int bj = 0; bj < 2; ++bj) {
                    const f32x4 v0 = acc[ai][bj][m][0], v1 = acc[ai][bj][m][1];
                    ss += (v0[0] * v0[0] + v0[1] * v0[1]) + (v0[2] * v0[2] + v0[3] * v0[3]) + (v1[0] * v1[0] + v1[1] * v1[1]) + (v1[2] * v1[2] + v1[3] * v1[3]);
                    u32x4 w; w.x = cvt_pk_bf16(v0[0], v0[1]); w.y = cvt_pk_bf16(v0[2], v0[3]); w.z = cvt_pk_bf16(v1[0], v1[1]); w.w = cvt_pk_bf16(v1[2], v1[3]);
                    *(u32x4*)(rowp + bj * HALF) = w;
                }
                ss += __shfl_xor(ss, 16); ss += __shfl_xor(ss, 32);
                if (fq == 0) rowss[(size_t)row * 16 + u.pn * 4 + wc] = ss;
            }
    }
};
}

constexpr int RING_OFF = 0, RING_BYTES = 131072;
constexpr int LDSCTL_OFF = RING_BYTES, MISC_OFF = LDSCTL_OFF + 320;
constexpr int LDS_BYTES = 147456;
constexpr int NWAVES = 8;

struct Frame {
    LAS unsigned char* lds; volatile LAS unsigned* MISC; gu32* ctl;
    int tid, lane, wave, vcu, G;
    const float *x, *g_mix_pre, *w_in, *rel_bias, *w_out, *g_mix_post, *g_ffn_pre, *w_up, *conv_w, *conv_b, *w_down, *g_ffn_post;
    float* out;
    bf16 *Win_t, *Wout_t, *Wup_t, *Wdn_t, *XN, *PROJ, *Y, *Y1, *U, *Fb;
    float *cs, *biasd, *dpos, *dneg, *gam, *g256, *kms, *rowss, *KV, *RP;
    unsigned* sel; unsigned short* RUNS; unsigned* CNTW; bf16 *PO01, *PO23; float* ML;
};

__device__ __forceinline__ float wave_sum(float v) {
#pragma unroll
    for (int o = 1; o < 64; o <<= 1) v += __shfl_xor(v, o);
    return v;
}

template <int MODE> __device__ __forceinline__ int src_col(int n) {
    if (MODE == 1) { const int seg = n >> 9; if (seg == 3 || seg == 4) { const int p = n & 63; return (n & ~63) + (p >> 1) + 32 * (p & 1); } }
    return n;
}
template <int MODE> __device__ __forceinline__ void p0_transpose_item(const float* W, const float* gain, int K, int N, bf16* WT, LAS float* scr, int item, int lane) {
    const int nblk = N / 32, kb = item / nblk, nb = item % nblk, k0 = 64 * kb, n0 = 32 * nb;
    const int sc = src_col<MODE>(n0 + (lane & 31));
#pragma unroll 8
    for (int i = 0; i < 32; ++i) { const int kk = 2 * i + (lane >> 5); const float g = gain ? gain[k0 + kk] : 1.0f; scr[kk * 33 + (lane & 31)] = W[(size_t)(k0 + kk) * N + sc] * g; }
    LDS_WAIT(); asm volatile("" ::: "memory");
    const int c = lane & 7;
#pragma unroll
    for (int j = 0; j < 4; ++j) { const int n = (lane >> 3) + 8 * j; const LAS float* s = scr + (8 * c) * 33 + n;
        v4u o; o.x = pk2(s[0 * 33], s[1 * 33]); o.y = pk2(s[2 * 33], s[3 * 33]); o.z = pk2(s[4 * 33], s[5 * 33]); o.w = pk2(s[6 * 33], s[7 * 33]);
        *(GAS v4u*)(WT + (size_t)(n0 + n) * K + k0 + 8 * c) = o; }
    LDS_WAIT(); asm volatile("" ::: "memory");
}
__device__ __forceinline__ int t5_bucket(int n) {
    if (n < 16) return n;
    int l = 16 + (int)(__logf((float)n * (1.0f / 16.0f)) / __logf(8.0f) * 16.0f);
    return l < 31 ? l : 31;
}
__device__ __forceinline__ void p0_prologue(Frame& F) {
    LAS float* scr = (LAS float*)(F.lds + RING_OFF + F.wave * 16384);
    const int gw = F.vcu * NWAVES + F.wave, NGW = F.G * NWAVES;
    constexpr int I_IN = (DM / 64) * (NPROJ / 32), I_OUT = (DM / 64) * (DM / 32), I_UP = (DM / 64) * (NUP / 32), I_DN = (DFF / 64) * (DM / 32);
    for (int it = gw; it < I_IN + I_OUT + I_UP + I_DN; it += NGW) {
        int r = it;
        if (r < I_IN) { p0_transpose_item<1>(F.w_in, F.g_mix_pre, DM, NPROJ, F.Win_t, scr, r, F.lane); continue; } r -= I_IN;
        if (r < I_OUT) { p0_transpose_item<0>(F.w_out, nullptr, DM, DM, F.Wout_t, scr, r, F.lane); continue; } r -= I_OUT;
        if (r < I_UP) { p0_transpose_item<0>(F.w_up, F.g_ffn_pre, DM, NUP, F.Wup_t, scr, r, F.lane); continue; } r -= I_UP;
        p0_transpose_item<0>(F.w_down, nullptr, DFF, DM, F.Wdn_t, scr, r, F.lane);
    }
    for (int m = gw; m < TT; m += NGW) {
        const GAS f32x4* xr = (const GAS f32x4*)(F.x + (size_t)m * DM) + F.lane;
        f32x4 v[4]; float s = 0.f;
#pragma unroll
        for (int j = 0; j < 4; ++j) { v[j] = xr[64 * j]; s += (v[j].x * v[j].x + v[j].y * v[j].y) + (v[j].z * v[j].z + v[j].w * v[j].w); }
        const float rstd = 1.0f / sqrtf(wave_sum(s) * (1.f / DM) + EPS);
        GAS unsigned long long* o8 = (GAS unsigned long long*)(F.XN + (size_t)m * DM) + F.lane;
#pragma unroll
        for (int j = 0; j < 4; ++j) o8[64 * j] = (unsigned long long)pk2(v[j].x * rstd, v[j].y * rstd) | ((unsigned long long)pk2(v[j].z * rstd, v[j].w * rstd) << 32);
    }
    const int gt = blockIdx.x * (NWAVES * 64) + F.tid, NT = F.G * NWAVES * 64;
    for (int i = gt; i < SEQ * 32; i += NT) {
        const int t = i >> 5, k = i & 31;
        double inv = 1.0; for (int q = 0; q < k; ++q) inv *= 0.74989420933245582730;
        const float ang = (float)t * (float)inv;
        const double rev = (double)ang * 0.15915494309189533577; const double fr = rev - __builtin_rint(rev);
        F.cs[2 * i] = __builtin_amdgcn_cosf((float)fr); F.cs[2 * i + 1] = __builtin_amdgcn_sinf((float)fr);
    }
    for (int i = gt; i < NH * 256; i += NT) {
        const int h = i >> 8, n = i & 255; const double g = 1.0 - 1.0 / (double)(32 << h);
        double p = 1.0; for (int q = 0; q < n; ++q) p *= g;
        F.dpos[i] = (float)p; F.dneg[i] = (float)(1.0 / p);
        if (n == 255) { F.gam[h] = (float)g; F.g256[h] = (float)(p * g); }
    }
    for (int i = gt; i < NH * 132; i += NT) { const int h = i / 132, d = i % 132; F.biasd[i] = F.rel_bias[t5_bucket(d < 128 ? d : 128) * NH + h]; }
}

__device__ __forceinline__ void p2_gate(Frame& F) {
    LAS float* km = (LAS float*)(F.lds + RING_OFF);
    LAS int* hist = (LAS int*)(F.lds + RING_OFF + 16384);
    const bf16* QA = F.PROJ;
    for (int it = blockIdx.x; it < 512; it += F.G) {
        const int cp = 31 - (it & 31), bh = it >> 5, b = bh >> 3, h = bh & 7, c0 = 2 * cp, nj = c0 + 1;
        __syncthreads();
        if (F.tid < 384) hist[F.tid] = 0;
        for (int i = F.tid; i < nj * 64; i += NWAVES * 64) { const int j = i >> 6, d = i & 63; const size_t o = (size_t)(b * 64 + j) * 512 + h * 64 + d;
            km[i] = (F.kms[o] + F.kms[(size_t)NPANEL * 512 + o]) * (1.0f / 256.0f); }
        __syncthreads();
        const int t = c0 * 256 + F.tid, c = t >> 8; const size_t row = (size_t)b * SEQ + t;
        float q[64];
        { const GAS u32x4v* qp = (const GAS u32x4v*)(QA + row * 512 + h * 64);
#pragma unroll
          for (int i = 0; i < 8; ++i) { const u32x4v w = qp[i]; q[8 * i] = bflo(w.x); q[8 * i + 1] = bfhi(w.x); q[8 * i + 2] = bflo(w.y); q[8 * i + 3] = bfhi(w.y); q[8 * i + 4] = bflo(w.z); q[8 * i + 5] = bfhi(w.z); q[8 * i + 6] = bflo(w.w); q[8 * i + 7] = bfhi(w.w); } }
        float v0 = -INFINITY, v1 = -INFINITY, v2 = -INFINITY; unsigned i0 = 255u, i1 = 255u, i2 = 255u;
        for (int j = 0; j < c; ++j) {
            const LAS f32x4* kp = (const LAS f32x4*)(km + j * 64); float g = 0.f;
#pragma unroll
            for (int i = 0; i < 16; ++i) { const f32x4 k4 = kp[i]; g += q[4 * i] * k4.x + q[4 * i + 1] * k4.y + q[4 * i + 2] * k4.z + q[4 * i + 3] * k4.w; }
            if (g > v0) { v2 = v1; i2 = i1; v1 = v0; i1 = i0; v0 = g; i0 = (unsigned)j; }
            else if (g > v1) { v2 = v1; i2 = i1; v1 = g; i1 = (unsigned)j; }
            else if (g > v2) { v2 = g; i2 = (unsigned)j; }
        }
        F.sel[row * 8 + h] = i0 | (i1 << 8) | (i2 << 16);
        const int half = F.tid >> 8, tl = F.tid & 255;
        if (i0 != 255u) atomicAdd((int*)&hist[half * 64 + i0], 1);
        if (i1 != 255u) atomicAdd((int*)&hist[half * 64 + i1], 1);
        if (i2 != 255u) atomicAdd((int*)&hist[half * 64 + i2], 1);
        __syncthreads();
        if (F.tid < 128) { const int v = hist[F.tid]; int xs = v;
#pragma unroll
            for (int o = 1; o < 64; o <<= 1) { const int y = __shfl_up(xs, o); if (F.lane >= o) xs += y; }
            hist[128 + F.tid] = xs - v; F.CNTW[(size_t)(bh * 64 + c0 + (F.tid >> 6)) * 64 + (F.tid & 63)] = ((unsigned)(xs - v) << 16) | (unsigned)v; }
        __syncthreads();
        unsigned short* runs = F.RUNS + (size_t)(bh * 64 + c) * 768;
        if (i0 != 255u) runs[hist[128 + half * 64 + i0] + atomicAdd((int*)&hist[256 + half * 64 + i0], 1)] = (unsigned short)(tl);
        if (i1 != 255u) runs[hist[128 + half * 64 + i1] + atomicAdd((int*)&hist[256 + half * 64 + i1], 1)] = (unsigned short)(tl | 256);
        if (i2 != 255u) runs[hist[128 + half * 64 + i2] + atomicAdd((int*)&hist[256 + half * 64 + i2], 1)] = (unsigned short)(tl | 512);
    }
}
__device__ __forceinline__ void p2_kv_simple(Frame& F) {
    const bf16* KR = F.PROJ + 4 * (size_t)TT * 512; const bf16* VR = F.PROJ + 5 * (size_t)TT * 512;
    for (int it = blockIdx.x; it < 1024; it += F.G) {
        const int b = it >> 9, h = (it >> 6) & 7, c = it & 63; const size_t row0 = (size_t)b * SEQ + c * 256;
        const int d = F.tid >> 3, e0 = (F.tid & 7) * 8; float a[8];
#pragma unroll
        for (int i = 0; i < 8; ++i) a[i] = 0.f;
        for (int m = 0; m < 256; ++m) {
            const float kk = bf1(KR[(row0 + m) * 512 + h * 64 + d]);
            const u32x4v w = *(const GAS u32x4v*)(VR + (row0 + m) * 512 + h * 64 + e0);
            a[0] += kk * bflo(w.x); a[1] += kk * bfhi(w.x); a[2] += kk * bflo(w.y); a[3] += kk * bfhi(w.y); a[4] += kk * bflo(w.z); a[5] += kk * bfhi(w.z); a[6] += kk * bflo(w.w); a[7] += kk * bfhi(w.w);
        }
        const float sc = F.dpos[h * 256 + 255];
#pragma unroll
        for (int i = 0; i < 8; ++i) F.KV[(size_t)it * 4096 + d * 64 + e0 + i] = a[i] * sc;
    }
}
__device__ __forceinline__ void p3_scan(Frame& F) {
    const int gt = blockIdx.x * (NWAVES * 64) + F.tid;
    if (gt < 16 * 4096) {
        const int bh = gt >> 12, idx = gt & 4095, h = bh & 7; const float g = F.g256[h]; float st = 0.f;
        for (int c = 0; c < 64; ++c) { const size_t o = ((size_t)(bh * 64 + c)) * 4096 + idx; F.RP[o] = st; st = st * g + F.KV[o]; }
    }
}
__device__ __forceinline__ void p3_moba_simple(Frame& F) {
    const bf16* QA = F.PROJ; const bf16* KA = F.PROJ + (size_t)TT * 512; const bf16* VA = F.PROJ + 2 * (size_t)TT * 512;
    const int gt = blockIdx.x * (NWAVES * 64) + F.tid, NT = F.G * NWAVES * 64;
    for (int idx = gt; idx < TT * NH; idx += NT) {
        const int h = idx >> 15, row = idx & (TT - 1), b = row >> 14, t = row & (SEQ - 1), c = t >> 8;
        float q[64], o[64];
        { const GAS u32x4v* qp = (const GAS u32x4v*)(QA + (size_t)row * 512 + h * 64);
#pragma unroll
          for (int i = 0; i < 8; ++i) { const u32x4v w = qp[i]; q[8 * i] = bflo(w.x); q[8 * i + 1] = bfhi(w.x); q[8 * i + 2] = bflo(w.y); q[8 * i + 3] = bfhi(w.y); q[8 * i + 4] = bflo(w.z); q[8 * i + 5] = bfhi(w.z); q[8 * i + 6] = bflo(w.w); q[8 * i + 7] = bfhi(w.w); } }
#pragma unroll
        for (int i = 0; i < 64; ++i) o[i] = 0.f;
        const unsigned sw = F.sel[(size_t)row * 8 + h]; const float* bd = F.biasd + h * 132;
        float mrun = -3.0e38f, l = 0.f;
        for (int slot = 0; slot < 4; ++slot) {
            const int j = slot < 3 ? (int)((sw >> (8 * slot)) & 255u) : c;
            if (slot < 3 && j >= c) continue;
            const size_t r0 = (size_t)b * SEQ + j * 256;
            for (int s = 0; s < 256; ++s) {
                const int pos = j * 256 + s; if (pos > t) break;
                const GAS u32x4v* kp = (const GAS u32x4v*)(KA + (r0 + s) * 512 + h * 64); float dot = 0.f;
#pragma unroll
                for (int i = 0; i < 8; ++i) { const u32x4v w = kp[i]; dot += q[8 * i] * bflo(w.x) + q[8 * i + 1] * bfhi(w.x) + q[8 * i + 2] * bflo(w.y) + q[8 * i + 3] * bfhi(w.y) + q[8 * i + 4] * bflo(w.z) + q[8 * i + 5] * bfhi(w.z) + q[8 * i + 6] * bflo(w.w) + q[8 * i + 7] * bfhi(w.w); }
                const int dist = t - pos; const float sc = dot + bd[dist < 128 ? dist : 128];
                if (sc > mrun) { const float a = __expf(mrun - sc); l *= a;
#pragma unroll
                    for (int i = 0; i < 64; ++i) o[i] *= a;
                    mrun = sc; }
                const float p = __expf(sc - mrun); l += p;
                const GAS u32x4v* vp = (const GAS u32x4v*)(VA + (r0 + s) * 512 + h * 64);
#pragma unroll
                for (int i = 0; i < 8; ++i) { const u32x4v w = vp[i]; o[8 * i] += p * bflo(w.x); o[8 * i + 1] += p * bfhi(w.x); o[8 * i + 2] += p * bflo(w.y); o[8 * i + 3] += p * bfhi(w.y); o[8 * i + 4] += p * bflo(w.z); o[8 * i + 5] += p * bfhi(w.z); o[8 * i + 6] += p * bflo(w.w); o[8 * i + 7] += p * bfhi(w.w); }
            }
        }
        const float il = 1.0f / l;
        GAS u32x4v* yp = (GAS u32x4v*)(F.Y + (size_t)row * 1024 + h * 64);
#pragma unroll
        for (int i = 0; i < 8; ++i) { u32x4v w; w.x = pk2(o[8 * i] * il, o[8 * i + 1] * il); w.y = pk2(o[8 * i + 2] * il, o[8 * i + 3] * il); w.z = pk2(o[8 * i + 4] * il, o[8 * i + 5] * il); w.w = pk2(o[8 * i + 6] * il, o[8 * i + 7] * il); yp[i] = w; }
    }
}
__device__ __forceinline__ void p4_ret_simple(Frame& F) {
    const bf16* QR = F.PROJ + 3 * (size_t)TT * 512; const bf16* KR = F.PROJ + 4 * (size_t)TT * 512; const bf16* VR = F.PROJ + 5 * (size_t)TT * 512; const bf16* GR = F.PROJ + 6 * (size_t)TT * 512;
    const int gt = blockIdx.x * (NWAVES * 64) + F.tid, NT = F.G * NWAVES * 64;
    for (int idx = gt; idx < TT * NH; idx += NT) {
        const int h = idx >> 15, row = idx & (TT - 1), b = row >> 14, t = row & (SEQ - 1), c = t >> 8, n = t & 255;
        float q[64], y[64];
        { const GAS u32x4v* qp = (const GAS u32x4v*)(QR + (size_t)row * 512 + h * 64);
#pragma unroll
          for (int i = 0; i < 8; ++i) { const u32x4v w = qp[i]; q[8 * i] = bflo(w.x); q[8 * i + 1] = bfhi(w.x); q[8 * i + 2] = bflo(w.y); q[8 * i + 3] = bfhi(w.y); q[8 * i + 4] = bflo(w.z); q[8 * i + 5] = bfhi(w.z); q[8 * i + 6] = bflo(w.w); q[8 * i + 7] = bfhi(w.w); } }
#pragma unroll
        for (int i = 0; i < 64; ++i) y[i] = 0.f;
        const size_t r0 = (size_t)row - n;
        for (int m = 0; m <= n; ++m) {
            const GAS u32x4v* kp = (const GAS u32x4v*)(KR + (r0 + m) * 512 + h * 64); float dot = 0.f;
#pragma unroll
            for (int i = 0; i < 8; ++i) { const u32x4v w = kp[i]; dot += q[8 * i] * bflo(w.x) + q[8 * i + 1] * bfhi(w.x) + q[8 * i + 2] * bflo(w.y) + q[8 * i + 3] * bfhi(w.y) + q[8 * i + 4] * bflo(w.z) + q[8 * i + 5] * bfhi(w.z) + q[8 * i + 6] * bflo(w.w) + q[8 * i + 7] * bfhi(w.w); }
            const GAS u32x4v* vp = (const GAS u32x4v*)(VR + (r0 + m) * 512 + h * 64);
#pragma unroll
            for (int i = 0; i < 8; ++i) { const u32x4v w = vp[i]; y[8 * i] += dot * bflo(w.x); y[8 * i + 1] += dot * bfhi(w.x); y[8 * i + 2] += dot * bflo(w.y); y[8 * i + 3] += dot * bfhi(w.y); y[8 * i + 4] += dot * bflo(w.z); y[8 * i + 5] += dot * bfhi(w.z); y[8 * i + 6] += dot * bflo(w.w); y[8 * i + 7] += dot * bfhi(w.w); }
        }
        const float* R = F.RP + ((size_t)((b * 8 + h) * 64 + c)) * 4096; const float gam = F.gam[h];
        const bf16* qrow = QR + (size_t)row * 512 + h * 64;
        for (int d = 0; d < 64; ++d) {
            const float qd = bf1(qrow[d]) * gam; const GAS f32x4* rp = (const GAS f32x4*)(R + d * 64);
#pragma unroll
            for (int i = 0; i < 16; ++i) { const f32x4 r4 = rp[i]; y[4 * i] += qd * r4.x; y[4 * i + 1] += qd * r4.y; y[4 * i + 2] += qd * r4.z; y[4 * i + 3] += qd * r4.w; }
        }
        float mu = 0.f;
#pragma unroll
        for (int i = 0; i < 64; ++i) mu += y[i];
        mu *= (1.f / 64.f); float var = 0.f;
#pragma unroll
        for (int i = 0; i < 64; ++i) { y[i] -= mu; var += y[i] * y[i]; }
        const float rs = 1.0f / sqrtf(var * (1.f / 64.f) + EPS);
        const GAS u32x4v* gp = (const GAS u32x4v*)(GR + (size_t)row * 512 + h * 64);
        GAS u32x4v* yp = (GAS u32x4v*)(F.Y + (size_t)row * 1024 + 512 + h * 64);
#pragma unroll
        for (int i = 0; i < 8; ++i) { const u32x4v w = gp[i]; float g[8] = {bflo(w.x), bfhi(w.x), bflo(w.y), bfhi(w.y), bflo(w.z), bfhi(w.z), bflo(w.w), bfhi(w.w)}; float r[8];
#pragma unroll
            for (int k = 0; k < 8; ++k) r[k] = g[k] / (1.0f + __expf(-g[k])) * (y[8 * i + k] * rs);
            u32x4v ow; ow.x = pk2(r[0], r[1]); ow.y = pk2(r[2], r[3]); ow.z = pk2(r[4], r[5]); ow.w = pk2(r[6], r[7]); yp[i] = ow; }
    }
}

namespace mx {
typedef __attribute__((ext_vector_type(8))) short bf16x8;
typedef __attribute__((ext_vector_type(4))) short s16x4;
typedef __attribute__((ext_vector_type(16))) float f32x16;
typedef __attribute__((ext_vector_type(4))) unsigned u32x4;
typedef short v4i16_t __attribute__((ext_vector_type(4)));
typedef __attribute__((address_space(3))) const char* lds_cptr;
typedef float f32x2_t __attribute__((ext_vector_type(2))); typedef __bf16 bf16x2_t __attribute__((ext_vector_type(2)));
__device__ __forceinline__ int crow(int r, int hi) { return (r & 3) + 8 * (r >> 2) + 4 * hi; }
__device__ __forceinline__ unsigned cvtpk(float lo, float hi) { f32x2_t v = {lo, hi}; bf16x2_t b = __builtin_convertvector(v, bf16x2_t); return __builtin_bit_cast(unsigned, b); }
__device__ __forceinline__ void glds16(const void* gsrc, unsigned lds_dst) { unsigned keep;
    asm volatile("s_mov_b32 %0, m0\n\ts_mov_b32 m0, %2\n\ts_nop 0\n\tglobal_load_lds_dwordx4 %1, off\n\ts_mov_b32 m0, %0" : "=&s"(keep) : "v"(gsrc), "s"(lds_dst) : "memory"); }
__device__ __forceinline__ s16x4 vtr(lds_cptr p) { return __builtin_bit_cast(s16x4, __builtin_amdgcn_ds_read_tr16_b64_v4i16((__attribute__((address_space(3))) v4i16_t*)p)); }
#define MX_WAIT_BAR() asm volatile("s_waitcnt vmcnt(0) lgkmcnt(0)\n\ts_barrier" ::: "memory")
#define MX_LBAR() asm volatile("s_waitcnt lgkmcnt(0)\n\ts_barrier" ::: "memory")
__device__ __forceinline__ void dma_kimg(const bf16* tile, unsigned lds_img, int wid, int lane) { glds16(tile + (size_t)lane * 512 + wid * 8, (unsigned)__builtin_amdgcn_readfirstlane(lds_img + wid * 1024)); }
__device__ __forceinline__ void dma_timg(const bf16* tile, unsigned lds_img, int wid, int lane) { glds16(tile + (size_t)(16 * (wid & 3) + (lane >> 2)) * 512 + (wid >> 2) * 32 + (lane & 3) * 8, (unsigned)__builtin_amdgcn_readfirstlane(lds_img + wid * 1024)); }
__device__ __forceinline__ void qkt(f32x16& p0, f32x16& p1, lds_cptr kimg, const bf16x8* qr, int r32, int hi) {
    const lds_cptr kb = kimg + hi * 1024 + r32 * 16; const f32x16 z = {};
#pragma unroll
    for (int d0 = 0; d0 < 4; ++d0) {
        const bf16x8 b0 = *(const __attribute__((address_space(3))) bf16x8*)(kb + d0 * 2048), b1 = *(const __attribute__((address_space(3))) bf16x8*)(kb + d0 * 2048 + 512);
        p0 = __builtin_amdgcn_mfma_f32_32x32x16_bf16(b0, qr[d0], d0 == 0 ? z : p0, 0, 0, 0); p1 = __builtin_amdgcn_mfma_f32_32x32x16_bf16(b1, qr[d0], d0 == 0 ? z : p1, 0, 0, 0); }
}
__device__ __forceinline__ bf16x8 tfrag_perm(lds_cptr timg, int ks, int d0, int lane, int hi) {
    const lds_cptr p = timg + ((lane >> 4) & 1) * 32 + (lane & 3) * 8 + (4 * hi + ((lane & 15) >> 2)) * 64 + d0 * 4096 + ks * 1024;
    const s16x4 lo = vtr(p), hh = vtr(p + 512); return (bf16x8){lo[0], lo[1], lo[2], lo[3], hh[0], hh[1], hh[2], hh[3]};
}
__device__ __forceinline__ bf16x8 tfrag_nat(lds_cptr timg, int ks, int d0, int lane, int hi) {
    const lds_cptr p = timg + ((lane >> 4) & 1) * 32 + (lane & 3) * 8 + (8 * hi + ((lane & 15) >> 2)) * 64 + d0 * 4096 + ks * 1024;
    const s16x4 lo = vtr(p), hh = vtr(p + 256); return (bf16x8){lo[0], lo[1], lo[2], lo[3], hh[0], hh[1], hh[2], hh[3]};
}
__device__ __forceinline__ void pv64(f32x16* o, const f32x16& p0, const f32x16& p1, lds_cptr vimg, int lane, int hi) {
    u32x4 w0 = {cvtpk(p0[0], p0[1]), cvtpk(p0[2], p0[3]), cvtpk(p0[4], p0[5]), cvtpk(p0[6], p0[7])}, w1 = {cvtpk(p0[8], p0[9]), cvtpk(p0[10], p0[11]), cvtpk(p0[12], p0[13]), cvtpk(p0[14], p0[15])};
    u32x4 w2 = {cvtpk(p1[0], p1[1]), cvtpk(p1[2], p1[3]), cvtpk(p1[4], p1[5]), cvtpk(p1[6], p1[7])}, w3 = {cvtpk(p1[8], p1[9]), cvtpk(p1[10], p1[11]), cvtpk(p1[12], p1[13]), cvtpk(p1[14], p1[15])};
#pragma unroll
    for (int d0 = 0; d0 < 2; ++d0) {
        o[d0] = __builtin_amdgcn_mfma_f32_32x32x16_bf16(__builtin_bit_cast(bf16x8, w0), tfrag_perm(vimg, 0, d0, lane, hi), o[d0], 0, 0, 0);
        o[d0] = __builtin_amdgcn_mfma_f32_32x32x16_bf16(__builtin_bit_cast(bf16x8, w1), tfrag_perm(vimg, 1, d0, lane, hi), o[d0], 0, 0, 0);
        o[d0] = __builtin_amdgcn_mfma_f32_32x32x16_bf16(__builtin_bit_cast(bf16x8, w2), tfrag_perm(vimg, 2, d0, lane, hi), o[d0], 0, 0, 0);
        o[d0] = __builtin_amdgcn_mfma_f32_32x32x16_bf16(__builtin_bit_cast(bf16x8, w3), tfrag_perm(vimg, 3, d0, lane, hi), o[d0], 0, 0, 0);
    }
}
constexpr int L_K = 0, L_V = 32768, L_R = 65536, L_LIST = 65536, L_STG = 98304;
}

__device__ __forceinline__ void p2_kv_mfma(Frame& F) {
    using namespace mx;
    const bf16* KR = F.PROJ + 4 * (size_t)TT * 512; const bf16* VR = F.PROJ + 5 * (size_t)TT * 512;
    const int wid = F.wave, lane = F.lane, r32 = lane & 31, hi = lane >> 5;
    const unsigned lds0 = (unsigned)(size_t)F.lds; const lds_cptr L = (lds_cptr)F.lds;
    for (int it = blockIdx.x; it < 1024; it += F.G) {
        const int b = it >> 9, h = (it >> 6) & 7, c = it & 63; const size_t row0 = (size_t)b * SEQ + c * 256;
        MX_LBAR();
#pragma unroll
        for (int kt = 0; kt < 4; ++kt) { dma_timg(KR + (row0 + 64 * kt) * 512 + h * 64, lds0 + L_K + kt * 8192, wid, lane); dma_timg(VR + (row0 + 64 * kt) * 512 + h * 64, lds0 + L_V + kt * 8192, wid, lane); }
        MX_WAIT_BAR();
        const int dt = wid & 1, et = (wid >> 1) & 1, kh = wid >> 2; f32x16 acc = {};
#pragma unroll
        for (int k = 0; k < 8; ++k) { const int kt = 2 * kh + (k >> 2), ks = k & 3;
            acc = __builtin_amdgcn_mfma_f32_32x32x16_bf16(tfrag_perm(L + L_K + kt * 8192, ks, dt, lane, hi), tfrag_perm(L + L_V + kt * 8192, ks, et, lane, hi), acc, 0, 0, 0); }
        LAS float* red = (LAS float*)(F.lds + L_STG) + (wid & 3) * 1024;
        if (kh == 1) {
#pragma unroll
            for (int r = 0; r < 16; ++r) red[r * 64 + lane] = acc[r];
        }
        MX_LBAR();
        if (kh == 0) { const float sc = F.dpos[h * 256 + 255]; float* dst = F.KV + (size_t)it * 4096 + (32 * dt + 4 * hi) * 64 + 32 * et + r32;
#pragma unroll
            for (int r = 0; r < 16; ++r) dst[((r & 3) + 8 * (r >> 2)) * 64] = (acc[r] + red[r * 64 + lane]) * sc; }
    }
    MX_LBAR();
}
__device__ __forceinline__ void p4_ret_mfma(Frame& F) {
    using namespace mx;
    const bf16* QR = F.PROJ + 3 * (size_t)TT * 512; const bf16* KR = F.PROJ + 4 * (size_t)TT * 512; const bf16* VR = F.PROJ + 5 * (size_t)TT * 512; const bf16* GR = F.PROJ + 6 * (size_t)TT * 512;
    const int wid = F.wave, lane = F.lane, r32 = lane & 31, hi = lane >> 5;
    const unsigned lds0 = (unsigned)(size_t)F.lds; const lds_cptr L = (lds_cptr)F.lds;
    for (int it = blockIdx.x; it < 1024; it += F.G) {
        const int b = it >> 9, h = (it >> 6) & 7, c = it & 63; const size_t row0 = (size_t)b * SEQ + c * 256;
        MX_LBAR();
#pragma unroll
        for (int kt = 0; kt < 4; ++kt) { dma_kimg(KR + (row0 + 64 * kt) * 512 + h * 64, lds0 + L_K + kt * 8192, wid, lane); dma_timg(VR + (row0 + 64 * kt) * 512 + h * 64, lds0 + L_V + kt * 8192, wid, lane); }
        {
            const int d = F.tid >> 3, e0 = (F.tid & 7) * 8; const float g = F.gam[h];
            const GAS f32x4* rp = (const GAS f32x4*)(F.RP + (size_t)it * 4096 + d * 64 + e0); const f32x4 a = rp[0], bq = rp[1];
            u32x4 w = {cvtpk(a.x * g, a.y * g), cvtpk(a.z * g, a.w * g), cvtpk(bq.x * g, bq.y * g), cvtpk(bq.z * g, bq.w * g)};
            *(LAS u32x4*)(F.lds + L_R + ((e0 >> 5) * 4 + (d >> 4)) * 1024 + (d & 15) * 64 + (e0 & 31) * 2) = w; }
        bf16x8 qr[4];
        { const bf16* qp = QR + (row0 + 32 * wid + r32) * 512 + h * 64 + hi * 8;
#pragma unroll
          for (int d0 = 0; d0 < 4; ++d0) qr[d0] = *(const bf16x8*)(qp + d0 * 16); }
        MX_WAIT_BAR();
        f32x16 o[2]; o[0] = f32x16{}; o[1] = f32x16{};
        const int ktd = wid >> 1;
        for (int kt = 0; kt <= ktd; ++kt) {
            f32x16 p0, p1; qkt(p0, p1, L + L_K + kt * 8192, qr, r32, hi);
            if (kt == ktd) { const int qrel = 32 * (wid & 1) + r32;
#pragma unroll
                for (int r = 0; r < 16; ++r) { const int kv = crow(r, hi); if (kv > qrel) p0[r] = 0.f; if (kv + 32 > qrel) p1[r] = 0.f; } }
            pv64(o, p0, p1, L + L_V + kt * 8192, lane, hi);
        }
#pragma unroll
        for (int d0 = 0; d0 < 2; ++d0)
#pragma unroll
            for (int ks = 0; ks < 4; ++ks) o[d0] = __builtin_amdgcn_mfma_f32_32x32x16_bf16(qr[ks], tfrag_nat(L + L_R, ks, d0, lane, hi), o[d0], 0, 0, 0);
        LAS bf16* stg = (LAS bf16*)(F.lds + L_STG) + wid * 2048;
#pragma unroll
        for (int r = 0; r < 16; ++r) {
            float s1 = o[0][r] + o[1][r], s2 = o[0][r] * o[0][r] + o[1][r] * o[1][r];
#pragma unroll
            for (int x = 1; x < 32; x <<= 1) { s1 += __shfl_xor(s1, x); s2 += __shfl_xor(s2, x); }
            const float mu = s1 * (1.f / 64.f), var = s2 * (1.f / 64.f) - mu * mu, rs = 1.0f / sqrtf(fmaxf(var, 0.f) + EPS);
            const int orow = crow(r, hi);
            stg[orow * 64 + r32] = (bf16)(cvtpk((o[0][r] - mu) * rs, 0.f) & 0xffffu); stg[orow * 64 + 32 + r32] = (bf16)(cvtpk((o[1][r] - mu) * rs, 0.f) & 0xffffu);
        }
        LDS_WAIT();
#pragma unroll
        for (int i = 0; i < 4; ++i) { const int row = i * 8 + (lane >> 3), ch = lane & 7; const size_t grow = row0 + 32 * wid + row;
            const u32x4 yv = *(const LAS u32x4*)(stg + row * 64 + ch * 8); const u32x4 gv = *(const GAS u32x4*)(GR + grow * 512 + h * 64 + ch * 8);
            u32x4 ov;
#define P4_G(yw, gw) cvtpk(bflo(gw) / (1.0f + __expf(-bflo(gw))) * bflo(yw), bfhi(gw) / (1.0f + __expf(-bfhi(gw))) * bfhi(yw))
            ov.x = P4_G(yv.x, gv.x); ov.y = P4_G(yv.y, gv.y); ov.z = P4_G(yv.z, gv.z); ov.w = P4_G(yv.w, gv.w);
#undef P4_G
            *(GAS u32x4*)(F.Y + grow * 1024 + 512 + h * 64 + ch * 8) = ov; }
    }
    MX_LBAR();
}


constexpr int NSEL_ITEMS = 63 * 16, NOWN_ITEMS = 64 * 16, NMOBA_ITEMS = NSEL_ITEMS + NOWN_ITEMS;
constexpr int LX_ITEM = 131072 + 512, LX_BD2 = 131072 + 1024, LX_WSF = 131072 + 2048, LX_OFF = 131072 + 4096;
__device__ __forceinline__ void moba_tile(Frame& F, bool own, int b, int h, int j, int tile, int n) {
    using namespace mx;
    const int wid = F.wave, lane = F.lane, r32 = lane & 31, hi = lane >> 5;
    const lds_cptr L = (lds_cptr)F.lds;
    const LAS unsigned short* LIST = (const LAS unsigned short*)(F.lds + L_LIST);
    LAS float* wsf = (LAS float*)(F.lds + LX_WSF) + wid * 64;
    const LAS float* bd2 = (const LAS float*)(F.lds + LX_BD2);
    const bf16* QA = F.PROJ;
    int ri = tile * 32 + r32; const bool rvalid = ri < n; if (!rvalid) ri = n - 1;
    const unsigned e = own ? (((unsigned)j << 10) | (3u << 8) | (unsigned)ri) : (unsigned)LIST[ri];
    const int tq = (int)(e >> 10) * 256 + (int)(e & 255u), slot = (int)((e >> 8) & 3u);
    const size_t row = (size_t)b * SEQ + tq;
    bf16x8 qr[4];
    { const bf16* qp = QA + row * 512 + h * 64 + hi * 8;
#pragma unroll
      for (int d0 = 0; d0 < 4; ++d0) qr[d0] = *(const bf16x8*)(qp + d0 * 16); }
    float m = -1.0e30f, l = 0.f; f32x16 o[2]; o[0] = f32x16{}; o[1] = f32x16{};
    const int ktmax = own ? ((tile * 32 + 31) >> 6) : 3;
    const bool far = !own && __all(tq >= 256 * j + 383);
    for (int kt = 0; kt <= ktmax; ++kt) {
        f32x16 p0, p1; qkt(p0, p1, L + L_K + kt * 8192, qr, r32, hi);
        if (!far) { const int kb = 256 * j + 64 * kt + 4 * hi;
#pragma unroll
            for (int r = 0; r < 16; ++r) { const int d0 = tq - (kb + (r & 3) + 8 * (r >> 2)), d1 = d0 - 32;
                const float b0 = bd2[d0 < 0 ? 0 : (d0 < 128 ? d0 : 128)], b1 = bd2[d1 < 0 ? 0 : (d1 < 128 ? d1 : 128)];
                p0[r] = d0 < 0 ? -1.0e30f : p0[r] + b0; p1[r] = d1 < 0 ? -1.0e30f : p1[r] + b1; } }
        float rm = fmaxf(p0[0], p1[0]);
#pragma unroll
        for (int r = 1; r < 16; ++r) rm = fmaxf(rm, fmaxf(p0[r], p1[r]));
        { auto rr = __builtin_amdgcn_permlane32_swap(__float_as_uint(rm), __float_as_uint(rm), false, false); rm = fmaxf(__uint_as_float(rr[0]), __uint_as_float(rr[1])); }
        const float mn = fmaxf(m, rm), alpha = __builtin_amdgcn_exp2f(m - mn); m = mn;
        float ls = 0.f;
#pragma unroll
        for (int r = 0; r < 16; ++r) { p0[r] = __builtin_amdgcn_exp2f(p0[r] - mn); p1[r] = __builtin_amdgcn_exp2f(p1[r] - mn); ls += p0[r] + p1[r]; }
        l = l * alpha + ls;
        if (hi == 0) wsf[r32] = alpha;
        LDS_WAIT();
#pragma unroll
        for (int g = 0; g < 4; ++g) { const f32x4 a4 = *(const LAS f32x4*)(wsf + 8 * g + 4 * hi);
#pragma unroll
            for (int k = 0; k < 4; ++k) { o[0][4 * g + k] *= a4[k]; o[1][4 * g + k] *= a4[k]; } }
        pv64(o, p0, p1, L + L_V + kt * 8192, lane, hi);
    }
    { auto rr = __builtin_amdgcn_permlane32_swap(__float_as_uint(l), __float_as_uint(l), false, false); l = __uint_as_float(rr[0]) + __uint_as_float(rr[1]); }
    if (hi == 0) { wsf[32 + r32] = 1.0f / l;
        if (rvalid) { float* mlp = F.ML + (((size_t)slot * TT + row) * 8 + h) * 2; mlp[0] = far ? m + bd2[128] : m; mlp[1] = l; } }
    LDS_WAIT();
    LAS bf16* stg = (LAS bf16*)(F.lds + L_STG) + wid * 2048;
#pragma unroll
    for (int g = 0; g < 4; ++g) { const f32x4 i4 = *(const LAS f32x4*)(wsf + 32 + 8 * g + 4 * hi);
#pragma unroll
        for (int k = 0; k < 4; ++k) { const int r = 4 * g + k, orow = crow(r, hi);
            stg[orow * 64 + r32] = (bf16)(cvtpk(o[0][r] * i4[k], 0.f) & 0xffffu); stg[orow * 64 + 32 + r32] = (bf16)(cvtpk(o[1][r] * i4[k], 0.f) & 0xffffu); } }
    LDS_WAIT();
#pragma unroll
    for (int i = 0; i < 4; ++i) { const int rw = i * 8 + (lane >> 3), ch = lane & 7, ri2 = tile * 32 + rw;
        if (ri2 < n) { const unsigned e2 = own ? (((unsigned)j << 10) | (3u << 8) | (unsigned)ri2) : (unsigned)LIST[ri2];
            const int tq2 = (int)(e2 >> 10) * 256 + (int)(e2 & 255u), s2 = (int)((e2 >> 8) & 3u);
            bf16* dst = (s2 < 2 ? F.PO01 + (size_t)s2 * TT * 512 : F.PO23 + (size_t)(s2 - 2) * TT * 512) + (((size_t)b * SEQ + tq2) * 8 + h) * 64 + ch * 8;
            *(GAS u32x4*)dst = *(const LAS u32x4*)(stg + rw * 64 + ch * 8); } }
    LDS_WAIT();
}
__device__ __forceinline__ void p3_moba(Frame& F) {
    using namespace mx;
    const bf16* KA = F.PROJ + (size_t)TT * 512; const bf16* VA = F.PROJ + 2 * (size_t)TT * 512;
    const int wid = F.wave, lane = F.lane;
    const unsigned lds0 = (unsigned)(size_t)F.lds;
    volatile LAS int* itemw = (volatile LAS int*)(F.lds + LX_ITEM);
    LAS int* offs = (LAS int*)(F.lds + LX_OFF);
    LAS unsigned short* LIST = (LAS unsigned short*)(F.lds + L_LIST);
    LAS float* bd2 = (LAS float*)(F.lds + LX_BD2);
    int nxt = 0;
    if (F.tid == 0) nxt = (int)__hip_atomic_fetch_add(F.ctl + CW_Q, 1u, RLX_AGENT);
    for (;;) {
        if (F.tid == 0) itemw[0] = nxt;
        MX_LBAR();
        const int idx = itemw[0];
        if (idx >= NMOBA_ITEMS) break;
        if (F.tid == 0) nxt = (int)__hip_atomic_fetch_add(F.ctl + CW_Q, 1u, RLX_AGENT);
        const bool own = idx >= NSEL_ITEMS; const int o_ = own ? idx - NSEL_ITEMS : idx, j = o_ >> 4, bh = o_ & 15, b = bh >> 3, h = bh & 7;
        const size_t row0 = (size_t)b * SEQ + j * 256;
#pragma unroll
        for (int kt = 0; kt < 4; ++kt) { dma_kimg(KA + (row0 + 64 * kt) * 512 + h * 64, lds0 + L_K + kt * 8192, wid, lane); dma_timg(VA + (row0 + 64 * kt) * 512 + h * 64, lds0 + L_V + kt * 8192, wid, lane); }
        if (F.tid < 132) bd2[F.tid] = F.biasd[h * 132 + F.tid] * 1.4426950408889634f;
        int n = 256;
        if (!own) {
            if (wid == 0) { const unsigned v = (lane > j) ? F.CNTW[(size_t)(bh * 64 + lane) * 64 + j] : 0u; const int cnt = (int)(v & 0xffffu); int xs = cnt;
#pragma unroll
                for (int o = 1; o < 64; o <<= 1) { const int y = __shfl_up(xs, o); if (lane >= o) xs += y; }
                offs[lane] = xs - cnt; offs[64 + lane] = (int)(v >> 16); offs[128 + lane] = cnt; if (lane == 63) offs[192] = xs; }
            MX_LBAR();
            n = offs[192];
            for (int c = j + 1 + wid; c < 64; c += 8) { const int cnt = offs[128 + c], st = offs[64 + c], off = offs[c]; const unsigned short* runs = F.RUNS + (size_t)(bh * 64 + c) * 768 + st;
                for (int i = lane; i < cnt; i += 64) LIST[off + i] = (unsigned short)((c << 10) | runs[i]); }
        }
        MX_WAIT_BAR();
        const int ntile = (n + 31) >> 5;
        for (int tile = wid; tile < ntile; tile += 8) moba_tile(F, own, b, h, j, tile, n);
    }
}
__device__ __forceinline__ void p4_combine(Frame& F) {
    const int gt = blockIdx.x * (NWAVES * 64) + F.tid, NT = F.G * NWAVES * 64;
    for (int gid = gt; gid < TT * 64; gid += NT) {
        const int ch = gid & 7, h = (gid >> 3) & 7, row = gid >> 6, c = (row & (SEQ - 1)) >> 8, nv = c < 3 ? c : 3;
        float ms[4], ls[4];
#pragma unroll
        for (int s = 0; s < 4; ++s) { const bool v = (s == 3) || (s < nv); const float* mlp = F.ML + (((size_t)s * TT + row) * 8 + h) * 2; ms[s] = v ? mlp[0] : -3.0e38f; ls[s] = v ? mlp[1] : 0.f; }
        const float M = fmaxf(fmaxf(ms[0], ms[1]), fmaxf(ms[2], ms[3]));
        float acc[8], wsum = 0.f;
#pragma unroll
        for (int k = 0; k < 8; ++k) acc[k] = 0.f;
#pragma unroll
        for (int s = 0; s < 4; ++s) { const bool v = (s == 3) || (s < nv);
            if (v) { const float w = __builtin_amdgcn_exp2f(ms[s] - M) * ls[s]; wsum += w;
                const bf16* src = (s < 2 ? F.PO01 + (size_t)s * TT * 512 : F.PO23 + (size_t)(s - 2) * TT * 512) + ((size_t)row * 8 + h) * 64 + ch * 8;
                const u32x4v pw = *(const GAS u32x4v*)src;
                acc[0] += w * bflo(pw.x); acc[1] += w * bfhi(pw.x); acc[2] += w * bflo(pw.y); acc[3] += w * bfhi(pw.y); acc[4] += w * bflo(pw.z); acc[5] += w * bfhi(pw.z); acc[6] += w * bflo(pw.w); acc[7] += w * bfhi(pw.w); } }
        const float iw = 1.0f / wsum; u32x4v ow; ow.x = pk2(acc[0] * iw, acc[1] * iw); ow.y = pk2(acc[2] * iw, acc[3] * iw); ow.z = pk2(acc[4] * iw, acc[5] * iw); ow.w = pk2(acc[6] * iw, acc[7] * iw);
        *(GAS u32x4v*)(F.Y + (size_t)row * 1024 + h * 64 + ch * 8) = ow;
    }
}

__device__ __forceinline__ void rows_residual(Frame& F, const float* xin, const bf16* Yb, const float* gpost, float* xout, bf16* XNo) {
    const int gw = F.vcu * NWAVES + F.wave, NGW = F.G * NWAVES;
    for (int m = gw; m < TT; m += NGW) {
        float ss = 0.f;
        { const GAS f32x4* rp = (const GAS f32x4*)(F.rowss + (size_t)m * 16);
#pragma unroll
          for (int i = 0; i < 4; ++i) { const f32x4 r = rp[i]; ss += (r.x + r.y) + (r.z + r.w); } }
        const float rstd = 1.0f / sqrtf(ss * (1.f / DM) + EPS);
        const GAS f32x4* xr = (const GAS f32x4*)(xin + (size_t)m * DM) + F.lane;
        const GAS u32x2v* yr = (const GAS u32x2v*)(Yb + (size_t)m * DM) + F.lane;
        const GAS f32x4* gr = (const GAS f32x4*)gpost + F.lane;
        GAS f32x4* orow = (GAS f32x4*)(xout + (size_t)m * DM) + F.lane;
        f32x4 v[4]; float s2 = 0.f;
#pragma unroll
        for (int j = 0; j < 4; ++j) { const f32x4 xv = xr[64 * j]; const u32x2v yw = yr[64 * j]; const f32x4 g = gr[64 * j];
            v[j].x = xv.x + bflo(yw.x) * rstd * g.x; v[j].y = xv.y + bfhi(yw.x) * rstd * g.y; v[j].z = xv.z + bflo(yw.y) * rstd * g.z; v[j].w = xv.w + bfhi(yw.y) * rstd * g.w;
            orow[64 * j] = v[j]; s2 += (v[j].x * v[j].x + v[j].y * v[j].y) + (v[j].z * v[j].z + v[j].w * v[j].w); }
        if (XNo) {
            const float r2 = 1.0f / sqrtf(wave_sum(s2) * (1.f / DM) + EPS);
            GAS unsigned long long* o8 = (GAS unsigned long long*)(XNo + (size_t)m * DM) + F.lane;
#pragma unroll
            for (int j = 0; j < 4; ++j) o8[64 * j] = (unsigned long long)pk2(v[j].x * r2, v[j].y * r2) | ((unsigned long long)pk2(v[j].z * r2, v[j].w * r2) << 32);
        }
    }
}
__device__ __forceinline__ float gelu_tanh(float a) { const float z = 0.7978845608028654f * (a + 0.044715f * a * a * a); return a * (1.0f - 1.0f / (__expf(2.0f * z) + 1.0f)); }
__device__ __forceinline__ void p8_conv(Frame& F, int hb) {
    const int gw = F.vcu * NWAVES + F.wave, NGW = F.G * NWAVES;
    constexpr int RSEG = 32, NSEG = SEQ / RSEG;
    for (int it = gw; it < 11 * NSEG; it += NGW) {
        const int strip = it % 11, seg = it / 11, c = strip * 256 + F.lane * 4, r0 = seg * RSEG;
        f32x4 wa[3], wb[3];
#pragma unroll
        for (int j = 0; j < 3; ++j) { wa[j] = *(const GAS f32x4*)(F.conv_w + (size_t)j * NUP + c); wb[j] = *(const GAS f32x4*)(F.conv_w + (size_t)j * NUP + DFF + c); }
        const f32x4 ba = *(const GAS f32x4*)(F.conv_b + c), bb = *(const GAS f32x4*)(F.conv_b + DFF + c);
        f32x4 a2 = {0.f, 0.f, 0.f, 0.f}, a1 = a2, b2 = a2, b1 = a2;
#define P8_LD(r, ua, ub) do { const u32x2v wa_ = *(const GAS u32x2v*)(Ub + (size_t)(r) * NUP + c), wb_ = *(const GAS u32x2v*)(Ub + (size_t)(r) * NUP + DFF + c); \
            ua = (f32x4){bflo(wa_.x), bfhi(wa_.x), bflo(wa_.y), bfhi(wa_.y)}; ub = (f32x4){bflo(wb_.x), bfhi(wb_.x), bflo(wb_.y), bfhi(wb_.y)}; } while (0)
        const bf16* Ub = F.U;
        if (r0 >= 2) { P8_LD(r0 - 2, a2, b2); P8_LD(r0 - 1, a1, b1); }
        for (int r = r0; r < r0 + RSEG; ++r) {
            f32x4 ua, ub; P8_LD(r, ua, ub);
            const f32x4 av = ba + wa[0] * a2 + wa[1] * a1 + wa[2] * ua, bv = bb + wb[0] * b2 + wb[1] * b1 + wb[2] * ub;
            u32x2v o; o.x = pk2(gelu_tanh(av.x) * bv.x, gelu_tanh(av.y) * bv.y); o.y = pk2(gelu_tanh(av.z) * bv.z, gelu_tanh(av.w) * bv.w);
            *(GAS u32x2v*)(F.Fb + ((size_t)hb * SEQ + r) * DFF + c) = o;
            a2 = a1; a1 = ua; b2 = b1; b1 = ub;
        }
    }
}

constexpr int NPHASE = 13;
struct Args { const float* in[12]; float* out; unsigned char* ws; int ph_lo, ph_hi; };
__global__ void __launch_bounds__(NWAVES * 64, 2) fwd_kernel(Args args) {
    extern __shared__ __attribute__((aligned(16))) unsigned char lds[];
    Frame F;
    F.lds = (LAS unsigned char*)lds; F.MISC = (volatile LAS unsigned*)(F.lds + MISC_OFF);
    F.tid = threadIdx.x; F.lane = F.tid & 63; F.wave = __builtin_amdgcn_readfirstlane(F.tid >> 6);
    F.G = gridDim.x; { const int bx = blockIdx.x; F.vcu = (F.G % 8 == 0) ? (bx % 8) * (F.G / 8) + bx / 8 : bx; }
    unsigned char* ws = args.ws;
    F.ctl = (gu32*)(ws + WS_CTL);
    F.x = args.in[0]; F.g_mix_pre = args.in[1]; F.w_in = args.in[2]; F.rel_bias = args.in[3]; F.w_out = args.in[4]; F.g_mix_post = args.in[5];
    F.g_ffn_pre = args.in[6]; F.w_up = args.in[7]; F.conv_w = args.in[8]; F.conv_b = args.in[9]; F.w_down = args.in[10]; F.g_ffn_post = args.in[11]; F.out = args.out;
    F.Win_t = (bf16*)(ws + WS_WIN); F.Wout_t = (bf16*)(ws + WS_WOUT); F.Wup_t = (bf16*)(ws + WS_WUP); F.Wdn_t = (bf16*)(ws + WS_WDN);
    F.XN = (bf16*)(ws + WS_XN); F.PROJ = (bf16*)(ws + WS_PROJ); F.Y = (bf16*)(ws + WS_Y); F.Y1 = (bf16*)(ws + WS_Y1); F.U = (bf16*)(ws + WS_U); F.Fb = (bf16*)(ws + WS_F);
    F.cs = (float*)(ws + WS_CS); F.biasd = (float*)(ws + WS_SMALL + SM_BIASD); F.dpos = (float*)(ws + WS_SMALL + SM_DPOS); F.dneg = (float*)(ws + WS_SMALL + SM_DNEG);
    F.gam = (float*)(ws + WS_SMALL + SM_GAM); F.g256 = (float*)(ws + WS_SMALL + SM_G256);
    F.kms = (float*)(ws + WS_KMS); F.rowss = (float*)(ws + WS_ROWSS); F.KV = (float*)(ws + WS_KV); F.RP = (float*)(ws + WS_RP); F.sel = (unsigned*)(ws + WS_SEL);
    F.RUNS = (unsigned short*)(ws + WS_RUNS); F.CNTW = (unsigned*)(ws + WS_CNTW); F.PO01 = (bf16*)(ws + WS_PO01); F.PO23 = (bf16*)(ws + WS_PO23); F.ML = (float*)(ws + WS_ML);
    for (int u = F.tid; u < (LDS_BYTES - LDSCTL_OFF) / 4; u += NWAVES * 64) ((LAS unsigned*)(F.lds + LDSCTL_OFF))[u] = 0u;
    __syncthreads();
    XcdBarrier bar; bar.bar = (unsigned*)(F.ctl + CW_BAR); bar.x = 0; bar.st = nullptr;
    if (MK_ONE_LAUNCH) bar = xcd_barrier_post((unsigned*)(F.ctl + CW_BAR), F.MISC + 8);
    const int lo = args.ph_lo, hi = args.ph_hi;
#define IN(k) (lo <= (k) && (k) < hi)
#define SEAM(k) do { if (IN(k) && IN((k) + 1)) xcd_barrier(bar); } while (0)

    if (IN(0)) { p0_prologue(F); }
#if MK_ONE_LAUNCH
    if (IN(0) && IN(1)) { cooperative_groups::this_grid().sync(); }
#endif
    if (IN(1)) {
        pg8::Gemm g{F.XN, F.Win_t, TT, NPROJ, DM}; pg8::StaticOrder S; S.init(TT, NPROJ, F.G, (int)blockIdx.x);
        pg8::EpiProj E{F.PROJ, F.cs, F.dpos, F.dneg, F.kms};
        pg8::gemm_phase<pg8::EpiProj, pg8::StaticOrder, PG8_ALIGN, PG8_SP2>(F.lds + RING_OFF, g, S, E);
    } SEAM(1);
    if (IN(2)) { p2_gate(F); __syncthreads(); p2_kv_mfma(F); } SEAM(2);
    if (IN(3)) { p3_scan(F); p3_moba(F); } SEAM(3);
    if (IN(4)) { p4_ret_mfma(F); p4_combine(F); } SEAM(4);
    if (IN(5)) {
        pg8::Gemm g{F.Y, F.Wout_t, TT, DM, DM}; pg8::StaticOrder S; S.init(TT, DM, F.G, (int)blockIdx.x);
        pg8::EpiY E{F.Y1, F.rowss};
        pg8::gemm_phase<pg8::EpiY, pg8::StaticOrder, PG8_ALIGN, PG8_SP2>(F.lds + RING_OFF, g, S, E);
    } SEAM(5);
    if (IN(6)) { rows_residual(F, F.x, F.Y1, F.g_mix_post, F.out, F.XN); } SEAM(6);
#pragma unroll 1
    for (int hb = 0; hb < 2; ++hb) {
        if (IN(7 + 2 * hb)) {
            pg8::Gemm g{F.XN + (size_t)hb * SEQ * DM, F.Wup_t, SEQ, NUP, DM}; pg8::StaticOrder S; S.init(SEQ, NUP, F.G, (int)blockIdx.x);
            pg8::EpiBf16<0> E{F.U, NUP, nullptr, 0, 0, 1.f};
            pg8::gemm_phase<pg8::EpiBf16<0>, pg8::StaticOrder, PG8_ALIGN, PG8_SP2>(F.lds + RING_OFF, g, S, E);
        } SEAM(7 + 2 * hb);
        if (IN(8 + 2 * hb)) { p8_conv(F, hb); } SEAM(8 + 2 * hb);
    }
    if (IN(11)) {
        pg8::Gemm g{F.Fb, F.Wdn_t, TT, DM, DFF}; pg8::StaticOrder S; S.init(TT, DM, F.G, (int)blockIdx.x);
        pg8::EpiY E{F.Y1, F.rowss};
        pg8::gemm_phase<pg8::EpiY, pg8::StaticOrder, PG8_ALIGN, PG8_SP2>(F.lds + RING_OFF, g, S, E);
    } SEAM(11);
    if (IN(12)) { rows_residual(F, F.out, F.Y1, F.g_ffn_post, F.out, nullptr); }
#undef IN
#undef SEAM
}

extern "C" void kernel_launch(void* const* d_in, const int* in_sizes, int n_in, void* d_out, int out_size, void* d_ws, size_t ws_size, hipStream_t stream) {
    static int grid = 0;
    if (grid == 0) {
        if (n_in != 12 || in_sizes[0] != TT * DM || out_size != TT * DM || ws_size < WS_END) { fprintf(stderr, "kernel_launch: unexpected shapes (n_in %d in0 %d out %d ws %zu)\n", n_in, n_in > 0 ? in_sizes[0] : -1, out_size, ws_size); grid = -1; return; }
        int dev = 0, cus = 0, per_cu = 0;
        if (hipGetDevice(&dev) != hipSuccess || hipDeviceGetAttribute(&cus, hipDeviceAttributeMultiprocessorCount, dev) != hipSuccess) { grid = -1; return; }
        if (hipFuncSetAttribute((const void*)fwd_kernel, hipFuncAttributeMaxDynamicSharedMemorySize, LDS_BYTES) != hipSuccess) { fprintf(stderr, "kernel_launch: hipFuncSetAttribute failed\n"); grid = -1; return; }
        if (hipOccupancyMaxActiveBlocksPerMultiprocessor(&per_cu, (const void*)fwd_kernel, NWAVES * 64, LDS_BYTES) != hipSuccess || per_cu < 1) { fprintf(stderr, "kernel_launch: occupancy query says %d\n", per_cu); per_cu = 1; }
        (void)hipGetLastError();
        grid = cus * (per_cu < 1 ? 1 : 1);
    }
    if (grid < 0) return;
    if (hipMemsetAsync((char*)d_ws + WS_CTL, 0, CTL_ZERO_BYTES, stream) != hipSuccess) { fprintf(stderr, "kernel_launch: memset failed\n"); return; }
    Args a{};
    for (int i = 0; i < 12; ++i) a.in[i] = (const float*)d_in[i];
    a.out = (float*)d_out; a.ws = (unsigned char*)d_ws;
#if MK_ONE_LAUNCH
    a.ph_lo = 0; a.ph_hi = NPHASE;
    void* kargs[] = {&a};
    hipError_t e = hipLaunchCooperativeKernel((const void*)fwd_kernel, dim3(grid), dim3(NWAVES * 64), kargs, LDS_BYTES, stream);
    if (e != hipSuccess) fprintf(stderr, "kernel_launch: cooperative launch failed: %s\n", hipGetErrorString(e));
#else
    for (int p = 0; p < NPHASE; ++p) { a.ph_lo = p; a.ph_hi = p + 1; hipLaunchKernelGGL(fwd_kernel, dim3(grid), dim3(NWAVES * 64), LDS_BYTES, stream, a); }
#endif
}
```

```cpp
#include <hip/hip_runtime.h>
#include <hip/hip_cooperative_groups.h>
#include <cstdio>
#include <cstdint>
#define MK_ONE_LAUNCH 1
namespace pg8 {
#define PG8_LAS __attribute__((address_space(3)))
typedef unsigned short bf16_t;
typedef short bf16x8 __attribute__((ext_vector_type(8)));
typedef float f32x4 __attribute__((ext_vector_type(4)));
typedef unsigned u32x4 __attribute__((ext_vector_type(4)));
constexpr int BM = 256, BK = 64, HALF = 128, HTB = HALF * BK * 2  , STAGE_BYTES = 8 * HTB, NXCD = 8, WGM = 8;

__host__ __device__ __forceinline__ int lds_byte(int r, int c) { const int st = (r >> 4) * 2 + (c >> 5), rr = r & 15, cc = c & 31, ob = rr * 64 + cc * 2; return st * 1024 + (ob ^ (((ob >> 9) & 1) << 5)); }
__host__ __device__ __forceinline__ void stage_rc(int b, int& R, int& C) { const int st = b / 1024, sb = b % 1024, swz = sb ^ (((sb >> 9) & 1) << 5); R = (st >> 1) * 16 + swz / 64; C = (st & 1) * 32 + (swz % 64) / 2; }
__host__ __device__ __forceinline__ int perm32(int rho) { const int n = rho >> 4, i = rho & 15; return 8 * (i >> 2) + 4 * n + (i & 3); }

struct Unit { int pm, pn; };
struct Gemm { const bf16_t* A; const bf16_t* Bt; int M, N, K; int amode;
    __device__ __forceinline__ const char* abase(int pm) const { if (amode == 0) return (const char*)A + (size_t)pm * ((size_t)BM * K * 2);
        const int b = pm / 65, i = pm - 65 * b; return (const char*)A + ((long)b * 16384 + 254 * i - 2) * ((long)K * 2); } };

struct StaticOrder {
    int nM, nN, nwg, G, c;
    __host__ __device__ void init(int M, int N, int G_, int c_) { nM = M / BM; nN = N / BM; nwg = nM * nN; G = G_; c = c_; }
    __host__ __device__ bool next(int i, Unit& u) const {
        const long L = (long)i * G + c; if (L >= nwg) return false;
        int wgid = (int)L; { const int q = nwg / NXCD, r = nwg % NXCD, xcd = wgid % NXCD, off = wgid / NXCD; wgid = (xcd < r ? xcd * (q + 1) : r * (q + 1) + (xcd - r) * q) + off; }
        const int nig = WGM * nN, gid = wgid / nig, fm = gid * WGM, gsz = (nM - fm) < WGM ? (nM - fm) : WGM;
        u.pm = fm + ((wgid % nig) % gsz); u.pn = (wgid % nig) / gsz; return true;
    }
    __device__ __forceinline__ void a_ready(const Unit&) const {}
    __device__ __forceinline__ void done(const Unit&) const {}
};

__device__ __forceinline__ unsigned cvt_pk_bf16(float lo, float hi) { unsigned r; asm volatile("v_cvt_pk_bf16_f32 %0, %1, %2" : "=v"(r) : "v"(lo), "v"(hi)); return r; }
typedef float f32x2 __attribute__((ext_vector_type(2)));
__device__ __forceinline__ f32x2 gelu_pk(f32x2 v) {
    const f32x2 av = __builtin_elementwise_abs(v), d = av * 0.2316418882f + 1.0f;
    f32x2 t; t.x = __builtin_amdgcn_rcpf(d.x); t.y = __builtin_amdgcn_rcpf(d.y);
    f32x2 q = t * 0.5307027145f + (-0.7265760135f); q = q * t + 0.7107068705f; q = q * t + (-0.142248368f); q = q * t + 0.127414796f; q = q * t;
    const f32x2 s = (v * v) * (-0.72134752044f);
    f32x2 e; e.x = __builtin_amdgcn_exp2f(s.x); e.y = __builtin_amdgcn_exp2f(s.y);
    const f32x2 m = v * (q * e), r = v - m;
    f32x2 o; o.x = v.x < 0.f ? m.x : r.x; o.y = v.y < 0.f ? m.y : r.y; return o;
}

template <int ACT  > struct EpiBf16 {
    static constexpr bool PERM = true, AFTER_DRAIN = false; static_assert(ACT == 0 || ACT == 1, "EpiBf16: ACT is 0 (none) or 1 (gelu_pk)");
    bf16_t* O; int ldc; const float* bias; int split_cols; size_t split_stride; float scale0;
    __device__ __forceinline__ void operator()(const f32x4 (&acc)[2][2][4][2], const Unit& u, int wr, int wc, int fr, int fq) const {
        const int row0 = u.pm * BM + wr * 64 + fr; int colt = u.pn * BM; bf16_t* base = O;
        float sc = 1.f; if (split_cols) { const int t = colt / split_cols; base += (size_t)t * split_stride; colt -= t * split_cols; if (t == 0) sc = scale0; }
        const int col0 = colt + wc * 32 + 8 * fq, bcol0 = u.pn * BM + wc * 32 + 8 * fq;
        f32x4 bv[2][2];
#pragma unroll
        for (int bj = 0; bj < 2; ++bj)
#pragma unroll
            for (int n = 0; n < 2; ++n) bv[bj][n] = bias ? *(const f32x4*)(bias + bcol0 + bj * HALF + 4 * n) : (f32x4){0.f, 0.f, 0.f, 0.f};
#pragma unroll
        for (int ai = 0; ai < 2; ++ai)
#pragma unroll
            for (int m = 0; m < 4; ++m) { bf16_t* rowp = base + (size_t)(row0 + ai * HALF + m * 16) * ldc + col0;
#pragma unroll
                for (int bj = 0; bj < 2; ++bj) { f32x4 v0 = acc[ai][bj][m][0] + bv[bj][0], v1 = acc[ai][bj][m][1] + bv[bj][1];
                    if (ACT == 1) { f32x2 a = gelu_pk((f32x2){v0[0], v0[1]}), b = gelu_pk((f32x2){v0[2], v0[3]}), c = gelu_pk((f32x2){v1[0], v1[1]}), d = gelu_pk((f32x2){v1[2], v1[3]});
                        v0 = (f32x4){a.x, a.y, b.x, b.y}; v1 = (f32x4){c.x, c.y, d.x, d.y}; }
                    v0 = v0 * sc; v1 = v1 * sc; u32x4 w; w.x = cvt_pk_bf16(v0[0], v0[1]); w.y = cvt_pk_bf16(v0[2], v0[3]); w.z = cvt_pk_bf16(v1[0], v1[1]); w.w = cvt_pk_bf16(v1[2], v1[3]);
                    *(u32x4*)(rowp + bj * HALF) = w; } }
    }
};
template <class Epi, class Sched, bool ALIGN_EPI = false, bool SP2 = false>
__device__ __forceinline__ void gemm_phase(PG8_LAS unsigned char* lds, const Gemm g, const Sched& S, const Epi& E) {
    const int tid = threadIdx.x, wid = __builtin_amdgcn_readfirstlane(tid >> 6), lane = tid & 63, wr = wid >> 2, wc = wid & 3, fr = lane & 15, fq = lane >> 4;
    const int K = g.K, nt = K / BK;
    unsigned voffA[2], voffB[2];
#pragma unroll
    for (int i = 0; i < 2; ++i) { int R, C; stage_rc(tid * 16 + i * 8192, R, C); const int Rb = Epi::PERM ? ((R & ~31) + perm32(R & 31)) : R;
        voffA[i] = (unsigned)(R * K + C) * 2u; voffB[i] = (unsigned)(Rb * K + C) * 2u; }
    const size_t kstep = (size_t)(BK * 2);
    const size_t hstep = (size_t)HALF * K * 2;
    const size_t tstep = 2 * hstep;
    const unsigned ldsw = (unsigned)wid * 1024u;
    const int aoff = lds_byte(wr * 64 + fr, fq * 8), boff = lds_byte(wc * 32 + fr, fq * 8);
#define PG8_SA(b, h) (((b) * 2 + (h)) * HTB)
#define PG8_SB(b, h) ((4 + (b) * 2 + (h)) * HTB)
#define PG8_STAGE(bufoff, gbase, voff) do { _Pragma("unroll") for (int _i = 0; _i < 2; ++_i) \
        __builtin_amdgcn_global_load_lds((const unsigned*)((const char*)(gbase) + (voff)[_i]), (PG8_LAS unsigned*)(lds + (bufoff) + ldsw + _i * 8192), 16, 0, 0); } while (0)
#define PG8_LDA(dst, b, h) do { _Pragma("unroll") for (int m = 0; m < 4; ++m) _Pragma("unroll") for (int k = 0; k < 2; ++k) dst[m][k] = *(const PG8_LAS bf16x8*)(lds + PG8_SA(b, h) + aoff + m * 2048 + k * 1024); } while (0)
#define PG8_LDB(dst, b, h) do { _Pragma("unroll") for (int n = 0; n < 2; ++n) _Pragma("unroll") for (int k = 0; k < 2; ++k) dst[n][k] = *(const PG8_LAS bf16x8*)(lds + PG8_SB(b, h) + boff + n * 2048 + k * 1024); } while (0)
#define PG8_MMA(ai, bj, At, Bt) do { __builtin_amdgcn_s_setprio(1); _Pragma("unroll") for (int m = 0; m < 4; ++m) _Pragma("unroll") for (int n = 0; n < 2; ++n) _Pragma("unroll") for (int k = 0; k < 2; ++k) \
        acc[ai][bj][m][n] = __builtin_amdgcn_mfma_f32_16x16x32_bf16(Bt[n][k], At[m][k], acc[ai][bj][m][n], 0, 0, 0); __builtin_amdgcn_s_setprio(0); } while (0)
#define PG8_WAIT_V(n) asm volatile("s_waitcnt vmcnt(" #n ")" ::: "memory")
#define PG8_WAIT_L(n) asm volatile("s_waitcnt lgkmcnt(" #n ")" ::: "memory")
#define PG8_BAR __builtin_amdgcn_s_barrier()
#define PG8_SCHED __builtin_amdgcn_sched_barrier(0)
    Unit cur, nxt; int ui = 0;
    if (!S.next(0, cur)) return;
    f32x4 acc[2][2][4][2];
#pragma unroll
    for (int a = 0; a < 2; ++a)
#pragma unroll
        for (int b = 0; b < 2; ++b)
#pragma unroll
            for (int m = 0; m < 4; ++m)
#pragma unroll
                for (int n = 0; n < 2; ++n) acc[a][b][m][n] = (f32x4){0.f, 0.f, 0.f, 0.f};
    bf16x8 At[4][2], B0[2][2], B1[2][2];
    const char* cA = g.abase(cur.pm); const char* cB = (const char*)g.Bt + (size_t)cur.pn * tstep;
    S.a_ready(cur);
    if constexpr (SP2) {
        PG8_STAGE(PG8_SB(0, 0), cB, voffB); PG8_STAGE(PG8_SB(0, 1), cB + hstep, voffB); PG8_STAGE(PG8_SA(0, 0), cA, voffA); PG8_STAGE(PG8_SA(0, 1), cA + hstep, voffA);
        if (wr == 1) PG8_BAR;
        PG8_WAIT_V(2); PG8_BAR;
        PG8_STAGE(PG8_SB(1, 0), cB + kstep, voffB); PG8_STAGE(PG8_SA(1, 0), cA + kstep, voffA); PG8_STAGE(PG8_SB(1, 1), cB + hstep + kstep, voffB);
        PG8_WAIT_V(6); PG8_BAR;
    } else {
        PG8_STAGE(PG8_SB(0, 0), cB, voffB); PG8_STAGE(PG8_SA(0, 0), cA, voffA); PG8_STAGE(PG8_SB(0, 1), cB + hstep, voffB); PG8_STAGE(PG8_SA(0, 1), cA + hstep, voffA);
        if (wr == 1) PG8_BAR;
        PG8_WAIT_V(4); PG8_BAR;
        PG8_STAGE(PG8_SB(1, 0), cB + kstep, voffB); PG8_STAGE(PG8_SA(1, 0), cA + kstep, voffA); PG8_STAGE(PG8_SB(1, 1), cB + hstep + kstep, voffB);
        PG8_WAIT_V(6); PG8_BAR;
    }
    for (;;) {
        const bool has_next = S.next(ui + 1, nxt);
        const char* nA = has_next ? g.abase(nxt.pm) : cA; const char* nB = has_next ? (const char*)g.Bt + (size_t)nxt.pn * tstep : cB;
        for (int t = 0; t < nt; t += 2) {
            const bool last = (t == nt - 2);
            const char* a1 = cA + (size_t)(t + 1) * kstep;
            const char* a2 = last ? nA : cA + (size_t)(t + 2) * kstep; const char* b2 = last ? nB : cB + (size_t)(t + 2) * kstep;
            const char* a3 = a2 + kstep; const char* b3 = b2 + kstep;
            if (last && has_next) S.a_ready(nxt);
            if constexpr (SP2) {
            PG8_LDB(B0, 0, 0); PG8_LDB(B1, 0, 1); PG8_SCHED; PG8_LDA(At, 0, 0); PG8_STAGE(PG8_SA(1, 1), a1 + hstep, voffA);
            PG8_WAIT_V(8); PG8_WAIT_L(0); PG8_BAR; PG8_MMA(0, 0, At, B0); PG8_MMA(0, 1, At, B1); PG8_BAR; PG8_SCHED;
            PG8_LDA(At, 0, 1); PG8_STAGE(PG8_SB(0, 0), b2, voffB); PG8_STAGE(PG8_SB(0, 1), b2 + hstep, voffB); PG8_STAGE(PG8_SA(0, 0), a2, voffA);
            PG8_WAIT_V(8); PG8_WAIT_L(0); PG8_BAR; PG8_MMA(1, 0, At, B0); PG8_MMA(1, 1, At, B1); PG8_BAR; PG8_SCHED;
            PG8_LDB(B0, 1, 0); PG8_LDB(B1, 1, 1); PG8_SCHED; PG8_LDA(At, 1, 0); PG8_STAGE(PG8_SA(0, 1), a2 + hstep, voffA);
            PG8_WAIT_V(8); PG8_WAIT_L(0); PG8_BAR; PG8_MMA(0, 0, At, B0); PG8_MMA(0, 1, At, B1); PG8_BAR; PG8_SCHED;
            PG8_LDA(At, 1, 1); PG8_STAGE(PG8_SB(1, 0), b3, voffB); PG8_STAGE(PG8_SB(1, 1), b3 + hstep, voffB); PG8_STAGE(PG8_SA(1, 0), a3, voffA);
            PG8_WAIT_V(8); PG8_WAIT_L(0); PG8_BAR; PG8_MMA(1, 0, At, B0); PG8_MMA(1, 1, At, B1); PG8_BAR; PG8_SCHED;
            } else {
            PG8_LDB(B0, 0, 0); PG8_SCHED; PG8_LDA(At, 0, 0); PG8_STAGE(PG8_SA(1, 1), a1 + hstep, voffA);
            PG8_WAIT_L(8); PG8_BAR; PG8_WAIT_L(0); PG8_MMA(0, 0, At, B0); PG8_BAR; PG8_SCHED;
            PG8_LDB(B1, 0, 1); PG8_STAGE(PG8_SB(0, 0), b2, voffB);
            PG8_BAR; PG8_WAIT_L(0); PG8_MMA(0, 1, At, B1); PG8_BAR;
            PG8_LDA(At, 0, 1); PG8_STAGE(PG8_SA(0, 0), a2, voffA);
            PG8_BAR; PG8_WAIT_L(0); PG8_MMA(1, 0, At, B0); PG8_BAR; PG8_SCHED;
            PG8_STAGE(PG8_SB(0, 1), b2 + hstep, voffB);
            PG8_WAIT_V(6); PG8_BAR; PG8_MMA(1, 1, At, B1); PG8_BAR;
            PG8_LDB(B0, 1, 0); PG8_SCHED; PG8_LDA(At, 1, 0); PG8_STAGE(PG8_SA(0, 1), a2 + hstep, voffA);
            PG8_WAIT_L(8); PG8_BAR; PG8_WAIT_L(0); PG8_MMA(0, 0, At, B0); PG8_BAR; PG8_SCHED;
            PG8_LDB(B1, 1, 1); PG8_STAGE(PG8_SB(1, 0), b3, voffB);
            PG8_BAR; PG8_WAIT_L(0); PG8_MMA(0, 1, At, B1); PG8_BAR;
            PG8_LDA(At, 1, 1); PG8_STAGE(PG8_SA(1, 0), a3, voffA);
            PG8_BAR; PG8_WAIT_L(0); PG8_MMA(1, 0, At, B0); PG8_BAR; PG8_SCHED;
            PG8_STAGE(PG8_SB(1, 1), b3 + hstep, voffB);
            PG8_WAIT_V(6); PG8_BAR; PG8_MMA(1, 1, At, B1); PG8_BAR;
            }
        }
        if constexpr (ALIGN_EPI) { if (wr == 0) PG8_BAR; }
        if constexpr (!Epi::AFTER_DRAIN) { E(acc, cur, wr, wc, fr, fq); S.done(cur); }
        if (!has_next) break;
#pragma unroll
        for (int a = 0; a < 2; ++a)
#pragma unroll
            for (int b = 0; b < 2; ++b)
#pragma unroll
                for (int m = 0; m < 4; ++m)
#pragma unroll
                    for (int n = 0; n < 2; ++n) acc[a][b][m][n] = (f32x4){0.f, 0.f, 0.f, 0.f};
        cur = nxt; cA = nA; cB = nB; ++ui;
        if constexpr (ALIGN_EPI) { if (wr == 1) PG8_BAR; }
    }
    PG8_WAIT_V(0);
    if constexpr (!ALIGN_EPI) { if (wr == 0) PG8_BAR; }
    PG8_BAR;
    if constexpr (Epi::AFTER_DRAIN) { E.fused(acc, cur, wr, wc, fr, fq, lds, wid, lane); S.done(cur); }
#undef PG8_SA
#undef PG8_SB
#undef PG8_STAGE
#undef PG8_LDA
#undef PG8_LDB
#undef PG8_MMA
#undef PG8_WAIT_V
#undef PG8_WAIT_L
#undef PG8_BAR
#undef PG8_SCHED
}
}

#ifndef PG8_SP2
#define PG8_SP2 true
#endif
#ifndef PG8_ALIGN
#define PG8_ALIGN true
#endif
#define GAS __attribute__((address_space(1)))
#define LAS __attribute__((address_space(3)))
typedef unsigned short bf16;
typedef unsigned v4u __attribute__((ext_vector_type(4)));
typedef float f32x4 __attribute__((ext_vector_type(4)));
typedef short bf16x8 __attribute__((ext_vector_type(8)));
typedef GAS unsigned gu32;
typedef GAS unsigned long long gu64;
#define RLX_AGENT __ATOMIC_RELAXED, __HIP_MEMORY_SCOPE_AGENT
#define LDS_WAIT() asm volatile("s_waitcnt lgkmcnt(0)" ::: "memory")
#define VM_WAIT() asm volatile("s_waitcnt vmcnt(0)" ::: "memory")
__device__ __forceinline__ unsigned long long rt() { return __builtin_amdgcn_s_memrealtime(); }
__device__ __forceinline__ unsigned f2bf(float f) { unsigned u = __builtin_bit_cast(unsigned, f); return (u + 0x7fffu + ((u >> 16) & 1u)) >> 16; }
__device__ __forceinline__ unsigned pk2(float lo, float hi) { return f2bf(lo) | (f2bf(hi) << 16); }

#define XB_TMO      128
#define XB_XCNT(j)  (256  + 64 * (j))
#define XB_XSUB(j)  (1280 + 64 * (j))
#define XB_XGEN(j)  (2304 + 64 * (j))
#define XB_TOP      3328
#define XB_TOPGEN   3392
#define XCD_BAR_WORDS 3456
#define XB_SPIN_CAP (1u << 18)

__device__ __forceinline__ unsigned xb_ld(unsigned* p)              { return __hip_atomic_load(p, __ATOMIC_RELAXED, __HIP_MEMORY_SCOPE_AGENT); }
__device__ __forceinline__ unsigned xb_add(unsigned* p, unsigned v) { return __hip_atomic_fetch_add(p, v, __ATOMIC_RELAXED, __HIP_MEMORY_SCOPE_AGENT); }
__device__ __forceinline__ unsigned xb_xcc_id() { return (unsigned)__builtin_amdgcn_s_getreg((3 << 11) | 20) & 0xFu; }
#define XB_SPIN(cond, bar) do { unsigned _sp = 0; while (cond) { __builtin_amdgcn_s_sleep(1); \
    if ((++_sp & 255u) == 0u) { if (xb_ld(&(bar)[XB_TMO])) break; if (_sp > XB_SPIN_CAP) { atomicAdd(&(bar)[XB_TMO], 1u); break; } } } } while (0)

struct XcdBarrier {
    unsigned* bar; unsigned x;
    volatile LAS unsigned* st;
};

__device__ __forceinline__ XcdBarrier xcd_barrier_post(unsigned* bar, volatile LAS unsigned* st) {
    XcdBarrier b; b.bar = bar; b.x = xb_xcc_id(); b.st = st;
    if (threadIdx.x == 0) (void)xb_add(&bar[XB_XCNT(b.x)], 1u);
    return b;
}
__device__ __forceinline__ void xcd_barrier_complete(unsigned* bar, unsigned x, unsigned& nloc, unsigned& nx) {
    const unsigned G = gridDim.x * gridDim.y * gridDim.z;
    unsigned sum, cnt, mine, sp = 0u;
    for (;;) {
        sum = 0u; cnt = 0u; mine = 0u;
#pragma unroll
        for (unsigned j = 0; j < 16; ++j) { const unsigned c = xb_ld(&bar[XB_XCNT(j)]); sum += c; cnt += (c > 0u) ? 1u : 0u; mine = (j == x) ? c : mine; }
        if (sum == G) break;
        __builtin_amdgcn_s_sleep(1);
        if ((++sp & 255u) == 0u) { if (xb_ld(&bar[XB_TMO])) break; if (sp > XB_SPIN_CAP) { atomicAdd(&bar[XB_TMO], 1u); break; } }
    }
    nloc = mine > 0u ? mine : 1u; nx = cnt > 0u ? cnt : 1u;
}

__device__ __forceinline__ void xcd_barrier(const XcdBarrier& b) {
    asm volatile("s_waitcnt vmcnt(0)" ::: "memory");
    __syncthreads();
    if (threadIdx.x == 0) {
        unsigned* bar = b.bar;
        __builtin_amdgcn_s_waitcnt(0);
        unsigned nloc = b.st[0], nx = b.st[1];
        if (nloc == 0u) { xcd_barrier_complete(bar, b.x, nloc, nx); b.st[0] = nloc; b.st[1] = nx; }
        const unsigned old = xb_add(&bar[XB_XSUB(b.x)], 1u);
        const unsigned gen = old / nloc;
        if (old + 1u == (gen + 1u) * nloc) {
            __builtin_amdgcn_fence(__ATOMIC_RELEASE, "agent");
            asm volatile("s_waitcnt vmcnt(0)" ::: "memory");
            const unsigned og = xb_add(&bar[XB_TOP], 1u);
            const unsigned tg = og / nx;
            if (og + 1u == (tg + 1u) * nx) xb_add(&bar[XB_TOPGEN], 1u);
            else XB_SPIN(xb_ld(&bar[XB_TOPGEN]) == tg, bar);
            __builtin_amdgcn_fence(__ATOMIC_ACQUIRE, "agent");
            xb_add(&bar[XB_XGEN(b.x)], 1u);
            asm volatile("s_waitcnt vmcnt(0)" ::: "memory");
        } else {
            XB_SPIN(xb_ld(&bar[XB_XGEN(b.x)]) == gen, bar);
            __builtin_amdgcn_fence(__ATOMIC_ACQUIRE, "agent");
            asm volatile("s_waitcnt vmcnt(0)" ::: "memory");
        }
    }
    __syncthreads();
}

constexpr int BATCH = 2, SEQ = 16384, DM = 1024, TT = BATCH * SEQ, NPROJ = 3584, DFF = 2816, NUP = 2 * DFF, NPANEL = TT / 256;
constexpr int NH = 8, HD = 64, HW = 512;
constexpr float EPS = 1e-6f;
#ifndef MK_DUP
#define MK_DUP 0
#endif
#ifndef MK_ONE_LAUNCH
#define MK_ONE_LAUNCH 0
#endif

constexpr size_t MiB = 1u << 20;
constexpr size_t WS_CTL = 0, CTL_ZERO_BYTES = 1 * MiB;
constexpr size_t WS_WIN = 1 * MiB, WS_WOUT = 8 * MiB, WS_WUP = 10 * MiB, WS_WDN = 21 * MiB;
constexpr size_t WS_CS = 27 * MiB;
constexpr size_t WS_SMALL = 31 * MiB;
constexpr size_t SM_BIASD = 0, SM_DPOS = 8192, SM_DNEG = 16384, SM_GAM = 24576, SM_G256 = 24576 + 64;
constexpr size_t WS_KMS = 32 * MiB;
constexpr size_t WS_ROWSS = 33 * MiB;
constexpr size_t WS_SEL = 35 * MiB;
constexpr size_t WS_RUNS = 36 * MiB, WS_CNTW = 38 * MiB;
constexpr size_t WS_KV = 40 * MiB, WS_RP = 56 * MiB;
constexpr size_t WS_XN = 72 * MiB;
constexpr size_t WS_PROJ = 136 * MiB;
constexpr size_t PROJ_SEG = (size_t)TT * 512 * 2;
constexpr size_t WS_Y = 360 * MiB;
constexpr size_t WS_Y1 = 136 * MiB;
constexpr size_t WS_U = 136 * MiB;
constexpr size_t WS_F = 312 * MiB;
constexpr size_t WS_PO01 = 72 * MiB, WS_PO23 = 424 * MiB, PO_SLOT = (size_t)TT * 512 * 2;
constexpr size_t WS_ML = 488 * MiB;
constexpr size_t WS_END = 496 * MiB;
constexpr int CW_Q = 8192;
constexpr int CW_BAR = 4096;

typedef unsigned u32x4v __attribute__((ext_vector_type(4)));
typedef unsigned u32x2v __attribute__((ext_vector_type(2)));

__device__ __forceinline__ float bflo(unsigned w) { return __uint_as_float(w << 16); }
__device__ __forceinline__ float bfhi(unsigned w) { return __uint_as_float(w & 0xffff0000u); }
__device__ __forceinline__ float bf1(bf16 b) { return __uint_as_float((unsigned)b << 16); }

namespace pg8 {
struct EpiProj {
    static constexpr bool PERM = true, AFTER_DRAIN = false;
    bf16_t* proj; const float* cs; const float* dpos; const float* dneg; float* kms;
    __device__ __forceinline__ void operator()(const f32x4 (&acc)[2][2][4][2], const Unit& u, int wr, int wc, int fr, int fq) const {
        const int seg = u.pn >> 1, cb = (u.pn & 1) * 256;
        bf16_t* base = proj + (size_t)seg * ((size_t)TT * 512);
        const int row0 = u.pm * BM + wr * 64 + fr, colw = cb + wc * 32 + 8 * fq;
        if (seg == 3 || seg == 4) {
            const int i0 = 16 * (wc & 1) + 4 * fq;
#pragma unroll
            for (int ai = 0; ai < 2; ++ai)
#pragma unroll
                for (int m = 0; m < 4; ++m) {
                    const int row = row0 + ai * HALF + m * 16, t = row & (SEQ - 1), tl = t & 255;
                    const f32x4 c01 = *(const f32x4*)(cs + ((size_t)t * 32 + i0) * 2), c23 = *(const f32x4*)(cs + ((size_t)t * 32 + i0) * 2 + 4);
                    bf16_t* rowp = base + (size_t)row * 512 + colw;
#pragma unroll
                    for (int bj = 0; bj < 2; ++bj) {
                        const int head = (cb >> 6) + bj * 2 + (wc >> 1);
                        const float ds = (seg == 3) ? dpos[head * 256 + tl] : 0.125f * dneg[head * 256 + tl];
                        const f32x4 v0 = acc[ai][bj][m][0], v1 = acc[ai][bj][m][1];
                        u32x4 w;
                        w.x = cvt_pk_bf16((v0[0] * c01[0] - v0[1] * c01[1]) * ds, (v0[0] * c01[1] + v0[1] * c01[0]) * ds);
                        w.y = cvt_pk_bf16((v0[2] * c01[2] - v0[3] * c01[3]) * ds, (v0[2] * c01[3] + v0[3] * c01[2]) * ds);
                        w.z = cvt_pk_bf16((v1[0] * c23[0] - v1[1] * c23[1]) * ds, (v1[0] * c23[1] + v1[1] * c23[0]) * ds);
                        w.w = cvt_pk_bf16((v1[2] * c23[2] - v1[3] * c23[3]) * ds, (v1[2] * c23[3] + v1[3] * c23[2]) * ds);
                        *(u32x4*)(rowp + bj * HALF) = w;
                    }
                }
        } else {
            const float sc = (seg == 0) ? 0.18033688011112042f : 1.0f;
#pragma unroll
            for (int ai = 0; ai < 2; ++ai)
#pragma unroll
                for (int m = 0; m < 4; ++m) {
                    bf16_t* rowp = base + (size_t)(row0 + ai * HALF + m * 16) * 512 + colw;
#pragma unroll
                    for (int bj = 0; bj < 2; ++bj) {
                        const f32x4 v0 = acc[ai][bj][m][0] * sc, v1 = acc[ai][bj][m][1] * sc;
                        u32x4 w; w.x = cvt_pk_bf16(v0[0], v0[1]); w.y = cvt_pk_bf16(v0[2], v0[3]); w.z = cvt_pk_bf16(v1[0], v1[1]); w.w = cvt_pk_bf16(v1[2], v1[3]);
                        *(u32x4*)(rowp + bj * HALF) = w;
                    }
                }
            if (seg == 1) {
#pragma unroll
                for (int bj = 0; bj < 2; ++bj)
#pragma unroll
                    for (int n = 0; n < 2; ++n) {
                        f32x4 s = acc[0][bj][0][n];
#pragma unroll
                        for (int m = 1; m < 4; ++m) s += acc[0][bj][m][n];
#pragma unroll
                        for (int m = 0; m < 4; ++m) s += acc[1][bj][m][n];
#pragma unroll
                        for (int o = 1; o < 16; o <<= 1) { s[0] += __shfl_xor(s[0], o); s[1] += __shfl_xor(s[1], o); s[2] += __shfl_xor(s[2], o); s[3] += __shfl_xor(s[3], o); }
                        if (fr == 0) *(f32x4*)(kms + ((size_t)wr * NPANEL + u.pm) * 512 + colw + bj * HALF + 4 * n) = s;
                    }
            }
        }
    }
};
struct EpiY {
    static constexpr bool PERM = true, AFTER_DRAIN = false;
    bf16_t* Y; float* rowss;
    __device__ __forceinline__ void operator()(const f32x4 (&acc)[2][2][4][2], const Unit& u, int wr, int wc, int fr, int fq) const {
        const int row0 = u.pm * BM + wr * 64 + fr, colw = u.pn * BM + wc * 32 + 8 * fq;
#pragma unroll
        for (int ai = 0; ai < 2; ++ai)
#pragma unroll
            for (int m = 0; m < 4; ++m) {
                const int row = row0 + ai * HALF + m * 16;
                bf16_t* rowp = Y + (size_t)row * 1024 + colw; float ss = 0.f;
#pragma unroll
                for (int bj = 0; bj < 2; ++bj) {
                    const f32x4 v0 = acc[ai][bj][m][0], v1 = acc[ai][bj][m][1];
                    ss += (v0[0] * v0[0] + v0[1] * v0[1]) + (v0[2] * v0[2] + v0[3] * v0[3]) + (v1[0] * v1[0] + v1[1] * v1[1]) + (v1[2] * v1[2] + v1[3] * v1[3]);
                    u32x4 w; w.x = cvt_pk_bf16(v0[0], v0[1]); w.y = cvt_pk_bf16(v0[2], v0[3]); w.z = cvt_pk_bf16(v1[0], v1[1]); w.w = cvt_pk_bf16(v1[2], v1[3]);
                    *(u32x4*)(rowp + bj * HALF) = w;
                }
                ss += __shfl_xor(ss, 16); ss += __shfl_xor(ss, 32);
                if (fq == 0) rowss[(size_t)row * 16 + u.pn * 4 + wc] = ss;
            }
    }
};
struct EpiFfn {
    static constexpr bool PERM = true, AFTER_DRAIN = false;
    bf16_t* Fo; const float* cw; const float* cb; PG8_LAS float* xch;
    __device__ __forceinline__ void operator()(const f32x4 (&acc)[2][2][4][2], const Unit& u, int wr, int wc, int fr, int fq) const {
        const int b = u.pm / 65, i = u.pm - 65 * b, t0 = 254 * i - 2, lane = fr + 16 * fq;
        if (fr >= 14) {
#pragma unroll
            for (int ai = 0; ai < 2; ++ai) { PG8_LAS f32x4* d = (PG8_LAS f32x4*)(xch + ((((wr * 4 + wc) * 2 + ai) * 2 + (fr - 14)) * 4 + fq) * 16);
                d[0] = acc[ai][0][3][0]; d[1] = acc[ai][0][3][1]; d[2] = acc[ai][1][3][0]; d[3] = acc[ai][1][3][1]; }
        }
        asm volatile("s_waitcnt lgkmcnt(0)\n\ts_barrier" ::: "memory");
        const int c0 = u.pn * 128 + wc * 32 + 8 * fq;
        const int a1 = ((lane & 48) | ((fr + 15) & 15)) * 4, a2 = ((lane & 48) | ((fr + 14) & 15)) * 4;
        const f32x4 z4 = {0.f, 0.f, 0.f, 0.f};
#pragma unroll
        for (int n = 0; n < 2; ++n) {
            f32x4 w[3][2], bs[2];
#pragma unroll
            for (int bj = 0; bj < 2; ++bj) { bs[bj] = *(const f32x4*)(cb + bj * DFF + c0 + 4 * n);
#pragma unroll
                for (int j = 0; j < 3; ++j) w[j][bj] = *(const f32x4*)(cw + (size_t)j * NUP + bj * DFF + c0 + 4 * n); }
#pragma unroll
            for (int ai = 0; ai < 2; ++ai) {
                f32x4 r1[2], r2[2];
                { const bool has = (wr == 1) || (ai == 1); const int sw = (wr == 1) ? wc : 4 + wc, sa = (wr == 1) ? ai : 0;
                  const PG8_LAS f32x4* s15 = (const PG8_LAS f32x4*)(xch + (((sw * 2 + sa) * 2 + 1) * 4 + fq) * 16); const PG8_LAS f32x4* s14 = (const PG8_LAS f32x4*)(xch + (((sw * 2 + sa) * 2 + 0) * 4 + fq) * 16);
#pragma unroll
                  for (int bj = 0; bj < 2; ++bj) { r1[bj] = has ? s15[bj * 2 + n] : z4; r2[bj] = has ? s14[bj * 2 + n] : z4; } }
#pragma unroll
                for (int m = 0; m < 4; ++m) {
                    f32x4 x[2];
#pragma unroll
                    for (int bj = 0; bj < 2; ++bj) {
                        f32x4 cur = acc[ai][bj][m][n];
                        if (m == 0 && ai == 0) { if (i == 0 && wr == 0 && fr < 2) cur = z4; }
                        f32x4 s1, s2;
#pragma unroll
                        for (int k = 0; k < 4; ++k) { s1[k] = __int_as_float(__builtin_amdgcn_ds_bpermute(a1, __float_as_int(cur[k]))); s2[k] = __int_as_float(__builtin_amdgcn_ds_bpermute(a2, __float_as_int(cur[k]))); }
                        f32x4 p1, p2;
                        if (m == 0) { p1 = fr == 0 ? r1[bj] : s1; p2 = fr == 0 ? r2[bj] : (fr == 1 ? r1[bj] : s2); }
                        else { p1 = fr == 0 ? r1[bj] : s1; p2 = fr < 2 ? r2[bj] : s2; }
                        r1[bj] = s1; r2[bj] = s2;
                        x[bj] = bs[bj] + w[0][bj] * p2 + w[1][bj] * p1 + w[2][bj] * cur;
                    }
                    const int r = ai * HALF + wr * 64 + m * 16 + fr, t = t0 + r;
                    if (r >= 2 && t < 16384) {
                        unsigned o0, o1;
#define FFN_G(a, bv) ({ const float z_ = 0.7978845608028654f * ((a) + 0.044715f * (a) * (a) * (a)); (a) * (1.0f - 1.0f / (__expf(2.0f * z_) + 1.0f)) * (bv); })
                        o0 = cvt_pk_bf16(FFN_G(x[0][0], x[1][0]), FFN_G(x[0][1], x[1][1])); o1 = cvt_pk_bf16(FFN_G(x[0][2], x[1][2]), FFN_G(x[0][3], x[1][3]));
#undef FFN_G
                        typedef unsigned u32x2e __attribute__((ext_vector_type(2)));
                        *(u32x2e*)(Fo + ((size_t)b * 16384 + t) * DFF + c0 + 4 * n) = (u32x2e){o0, o1};
                    }
                }
            }
        }
    }
};
}

constexpr int RING_OFF = 0, RING_BYTES = 131072;
constexpr int LDSCTL_OFF = RING_BYTES, MISC_OFF = LDSCTL_OFF + 320;
constexpr int LDS_BYTES = 163840;
constexpr int XCH_OFF = 139264;
constexpr int NWAVES = 8;

struct Frame {
    LAS unsigned char* lds; volatile LAS unsigned* MISC; gu32* ctl;
    int tid, lane, wave, vcu, G;
    const float *x, *g_mix_pre, *w_in, *rel_bias, *w_out, *g_mix_post, *g_ffn_pre, *w_up, *conv_w, *conv_b, *w_down, *g_ffn_post;
    float* out;
    bf16 *Win_t, *Wout_t, *Wup_t, *Wdn_t, *XN, *PROJ, *Y, *Y1, *U, *Fb;
    float *cs, *biasd, *dpos, *dneg, *gam, *g256, *kms, *rowss, *KV, *RP;
    unsigned* sel; unsigned short* RUNS; unsigned* CNTW; bf16 *PO01, *PO23; float* ML;
};

__device__ __forceinline__ float wave_sum(float v) {
#pragma unroll
    for (int o = 1; o < 64; o <<= 1) v += __shfl_xor(v, o);
    return v;
}

template <int MODE> __device__ __forceinline__ int src_col(int n) {
    if (MODE == 2) return ((n >> 7) & 1) * DFF + (n >> 8) * 128 + (n & 127);
    if (MODE == 1) { const int seg = n >> 9; if (seg == 3 || seg == 4) { const int p = n & 63; return (n & ~63) + (p >> 1) + 32 * (p & 1); } }
    return n;
}
template <int MODE> __device__ __forceinline__ void p0_transpose_item(const float* W, const float* gain, int K, int N, bf16* WT, LAS float* scr, int item, int lane) {
    const int nblk = N / 32, kb = item / nblk, nb = item % nblk, k0 = 64 * kb, n0 = 32 * nb;
    const int sc = src_col<MODE>(n0 + (lane & 31));
#pragma unroll 8
    for (int i = 0; i < 32; ++i) { const int kk = 2 * i + (lane >> 5); const float g = gain ? gain[k0 + kk] : 1.0f; scr[kk * 33 + (lane & 31)] = W[(size_t)(k0 + kk) * N + sc] * g; }
    LDS_WAIT(); asm volatile("" ::: "memory");
    const int c = lane & 7;
#pragma unroll
    for (int j = 0; j < 4; ++j) { const int n = (lane >> 3) + 8 * j; const LAS float* s = scr + (8 * c) * 33 + n;
        v4u o; o.x = pk2(s[0 * 33], s[1 * 33]); o.y = pk2(s[2 * 33], s[3 * 33]); o.z = pk2(s[4 * 33], s[5 * 33]); o.w = pk2(s[6 * 33], s[7 * 33]);
        *(GAS v4u*)(WT + (size_t)(n0 + n) * K + k0 + 8 * c) = o; }
    LDS_WAIT(); asm volatile("" ::: "memory");
}
__device__ __forceinline__ int t5_bucket(int n) {
    if (n < 16) return n;
    int l = 16 + (int)(__logf((float)n * (1.0f / 16.0f)) / __logf(8.0f) * 16.0f);
    return l < 31 ? l : 31;
}
__device__ __forceinline__ void p0_prologue(Frame& F) {
    LAS float* scr = (LAS float*)(F.lds + RING_OFF + F.wave * 16384);
    const int gw = F.vcu * NWAVES + F.wave, NGW = F.G * NWAVES;
    constexpr int I_IN = (DM / 64) * (NPROJ / 32), I_OUT = (DM / 64) * (DM / 32), I_UP = (DM / 64) * (NUP / 32), I_DN = (DFF / 64) * (DM / 32);
    for (int it = gw; it < I_IN + I_OUT + I_UP + I_DN; it += NGW) {
        int r = it;
        if (r < I_IN) { p0_transpose_item<1>(F.w_in, F.g_mix_pre, DM, NPROJ, F.Win_t, scr, r, F.lane); continue; } r -= I_IN;
        if (r < I_OUT) { p0_transpose_item<0>(F.w_out, nullptr, DM, DM, F.Wout_t, scr, r, F.lane); continue; } r -= I_OUT;
        if (r < I_UP) { p0_transpose_item<2>(F.w_up, F.g_ffn_pre, DM, NUP, F.Wup_t, scr, r, F.lane); continue; } r -= I_UP;
        p0_transpose_item<0>(F.w_down, nullptr, DFF, DM, F.Wdn_t, scr, r, F.lane);
    }
    for (int m = gw; m < TT; m += NGW) {
        const GAS f32x4* xr = (const GAS f32x4*)(F.x + (size_t)m * DM) + F.lane;
        f32x4 v[4]; float s = 0.f;
#pragma unroll
        for (int j = 0; j < 4; ++j) { v[j] = xr[64 * j]; s += (v[j].x * v[j].x + v[j].y * v[j].y) + (v[j].z * v[j].z + v[j].w * v[j].w); }
        const float rstd = 1.0f / sqrtf(wave_sum(s) * (1.f / DM) + EPS);
        GAS unsigned long long* o8 = (GAS unsigned long long*)(F.XN + (size_t)m * DM) + F.lane;
#pragma unroll
        for (int j = 0; j < 4; ++j) o8[64 * j] = (unsigned long long)pk2(v[j].x * rstd, v[j].y * rstd) | ((unsigned long long)pk2(v[j].z * rstd, v[j].w * rstd) << 32);
    }
    const int gt = blockIdx.x * (NWAVES * 64) + F.tid, NT = F.G * NWAVES * 64;
    for (int i = gt; i < SEQ * 32; i += NT) {
        const int t = i >> 5, k = i & 31;
        double inv = 1.0; for (int q = 0; q < k; ++q) inv *= 0.74989420933245582730;
        const float ang = (float)t * (float)inv;
        const double rev = (double)ang * 0.15915494309189533577; const double fr = rev - __builtin_rint(rev);
        F.cs[2 * i] = __builtin_amdgcn_cosf((float)fr); F.cs[2 * i + 1] = __builtin_amdgcn_sinf((float)fr);
    }
    for (int i = gt; i < NH * 256; i += NT) {
        const int h = i >> 8, n = i & 255; const double g = 1.0 - 1.0 / (double)(32 << h);
        double p = 1.0; for (int q = 0; q < n; ++q) p *= g;
        F.dpos[i] = (float)p; F.dneg[i] = (float)(1.0 / p);
        if (n == 255) { F.gam[h] = (float)g; F.g256[h] = (float)(p * g); }
    }
    for (int i = gt; i < NH * 132; i += NT) { const int h = i / 132, d = i % 132; F.biasd[i] = F.rel_bias[t5_bucket(d < 128 ? d : 128) * NH + h]; }
}

__device__ __forceinline__ void p2_gate(Frame& F) {
    LAS float* km = (LAS float*)(F.lds + RING_OFF);
    LAS int* hist = (LAS int*)(F.lds + RING_OFF + 16384);
    const bf16* QA = F.PROJ;
    for (int it = blockIdx.x; it < 512; it += F.G) {
        const int cp = 31 - (it & 31), bh = it >> 5, b = bh >> 3, h = bh & 7, c0 = 2 * cp, nj = c0 + 1;
        __syncthreads();
        if (F.tid < 384) hist[F.tid] = 0;
        for (int i = F.tid; i < nj * 64; i += NWAVES * 64) { const int j = i >> 6, d = i & 63; const size_t o = (size_t)(b * 64 + j) * 512 + h * 64 + d;
            km[i] = (F.kms[o] + F.kms[(size_t)NPANEL * 512 + o]) * (1.0f / 256.0f); }
        __syncthreads();
        const int t = c0 * 256 + F.tid, c = t >> 8; const size_t row = (size_t)b * SEQ + t;
        float q[64];
        { const GAS u32x4v* qp = (const GAS u32x4v*)(QA + row * 512 + h * 64);
#pragma unroll
          for (int i = 0; i < 8; ++i) { const u32x4v w = qp[i]; q[8 * i] = bflo(w.x); q[8 * i + 1] = bfhi(w.x); q[8 * i + 2] = bflo(w.y); q[8 * i + 3] = bfhi(w.y); q[8 * i + 4] = bflo(w.z); q[8 * i + 5] = bfhi(w.z); q[8 * i + 6] = bflo(w.w); q[8 * i + 7] = bfhi(w.w); } }
        float v0 = -INFINITY, v1 = -INFINITY, v2 = -INFINITY; unsigned i0 = 255u, i1 = 255u, i2 = 255u;
        for (int j = 0; j < c; ++j) {
            const LAS f32x4* kp = (const LAS f32x4*)(km + j * 64); float g = 0.f;
#pragma unroll
            for (int i = 0; i < 16; ++i) { const f32x4 k4 = kp[i]; g += q[4 * i] * k4.x + q[4 * i + 1] * k4.y + q[4 * i + 2] * k4.z + q[4 * i + 3] * k4.w; }
            if (g > v0) { v2 = v1; i2 = i1; v1 = v0; i1 = i0; v0 = g; i0 = (unsigned)j; }
            else if (g > v1) { v2 = v1; i2 = i1; v1 = g; i1 = (unsigned)j; }
            else if (g > v2) { v2 = g; i2 = (unsigned)j; }
        }
        F.sel[row * 8 + h] = i0 | (i1 << 8) | (i2 << 16);
        const int half = F.tid >> 8, tl = F.tid & 255;
        if (i0 != 255u) atomicAdd((int*)&hist[half * 64 + i0], 1);
        if (i1 != 255u) atomicAdd((int*)&hist[half * 64 + i1], 1);
        if (i2 != 255u) atomicAdd((int*)&hist[half * 64 + i2], 1);
        __syncthreads();
        if (F.tid < 128) { const int v = hist[F.tid]; int xs = v;
#pragma unroll
            for (int o = 1; o < 64; o <<= 1) { const int y = __shfl_up(xs, o); if (F.lane >= o) xs += y; }
            hist[128 + F.tid] = xs - v; F.CNTW[(size_t)(bh * 64 + c0 + (F.tid >> 6)) * 64 + (F.tid & 63)] = ((unsigned)(xs - v) << 16) | (unsigned)v; }
        __syncthreads();
        unsigned short* runs = F.RUNS + (size_t)(bh * 64 + c) * 768;
        if (i0 != 255u) runs[hist[128 + half * 64 + i0] + atomicAdd((int*)&hist[256 + half * 64 + i0], 1)] = (unsigned short)(tl);
        if (i1 != 255u) runs[hist[128 + half * 64 + i1] + atomicAdd((int*)&hist[256 + half * 64 + i1], 1)] = (unsigned short)(tl | 256);
        if (i2 != 255u) runs[hist[128 + half * 64 + i2] + atomicAdd((int*)&hist[256 + half * 64 + i2], 1)] = (unsigned short)(tl | 512);
    }
}
__device__ __forceinline__ void p2_kv_simple(Frame& F) {
    const bf16* KR = F.PROJ + 4 * (size_t)TT * 512; const bf16* VR = F.PROJ + 5 * (size_t)TT * 512;
    for (int it = blockIdx.x; it < 1024; it += F.G) {
        const int b = it >> 9, h = (it >> 6) & 7, c = it & 63; const size_t row0 = (size_t)b * SEQ + c * 256;
        const int d = F.tid >> 3, e0 = (F.tid & 7) * 8; float a[8];
#pragma unroll
        for (int i = 0; i < 8; ++i) a[i] = 0.f;
        for (int m = 0; m < 256; ++m) {
            const float kk = bf1(KR[(row0 + m) * 512 + h * 64 + d]);
            const u32x4v w = *(const GAS u32x4v*)(VR + (row0 + m) * 512 + h * 64 + e0);
            a[0] += kk * bflo(w.x); a[1] += kk * bfhi(w.x); a[2] += kk * bflo(w.y); a[3] += kk * bfhi(w.y); a[4] += kk * bflo(w.z); a[5] += kk * bfhi(w.z); a[6] += kk * bflo(w.w); a[7] += kk * bfhi(w.w);
        }
        const float sc = F.dpos[h * 256 + 255];
#pragma unroll
        for (int i = 0; i < 8; ++i) F.KV[(size_t)it * 4096 + d * 64 + e0 + i] = a[i] * sc;
    }
}
__device__ __forceinline__ void p3_scan(Frame& F) {
    const int gt = blockIdx.x * (NWAVES * 64) + F.tid;
    if (gt < 16 * 4096) {
        const int bh = gt >> 12, idx = gt & 4095, h = bh & 7; const float g = F.g256[h]; float st = 0.f;
        for (int c = 0; c < 64; ++c) { const size_t o = ((size_t)(bh * 64 + c)) * 4096 + idx; F.RP[o] = st; st = st * g + F.KV[o]; }
    }
}
__device__ __forceinline__ void p3_moba_simple(Frame& F) {
    const bf16* QA = F.PROJ; const bf16* KA = F.PROJ + (size_t)TT * 512; const bf16* VA = F.PROJ + 2 * (size_t)TT * 512;
    const int gt = blockIdx.x * (NWAVES * 64) + F.tid, NT = F.G * NWAVES * 64;
    for (int idx = gt; idx < TT * NH; idx += NT) {
        const int h = idx >> 15, row = idx & (TT - 1), b = row >> 14, t = row & (SEQ - 1), c = t >> 8;
        float q[64], o[64];
        { const GAS u32x4v* qp = (const GAS u32x4v*)(QA + (size_t)row * 512 + h * 64);
#pragma unroll
          for (int i = 0; i < 8; ++i) { const u32x4v w = qp[i]; q[8 * i] = bflo(w.x); q[8 * i + 1] = bfhi(w.x); q[8 * i + 2] = bflo(w.y); q[8 * i + 3] = bfhi(w.y); q[8 * i + 4] = bflo(w.z); q[8 * i + 5] = bfhi(w.z); q[8 * i + 6] = bflo(w.w); q[8 * i + 7] = bfhi(w.w); } }
#pragma unroll
        for (int i = 0; i < 64; ++i) o[i] = 0.f;
        const unsigned sw = F.sel[(size_t)row * 8 + h]; const float* bd = F.biasd + h * 132;
        float mrun = -3.0e38f, l = 0.f;
        for (int slot = 0; slot < 4; ++slot) {
            const int j = slot < 3 ? (int)((sw >> (8 * slot)) & 255u) : c;
            if (slot < 3 && j >= c) continue;
            const size_t r0 = (size_t)b * SEQ + j * 256;
            for (int s = 0; s < 256; ++s) {
                const int pos = j * 256 + s; if (pos > t) break;
                const GAS u32x4v* kp = (const GAS u32x4v*)(KA + (r0 + s) * 512 + h * 64); float dot = 0.f;
#pragma unroll
                for (int i = 0; i < 8; ++i) { const u32x4v w = kp[i]; dot += q[8 * i] * bflo(w.x) + q[8 * i + 1] * bfhi(w.x) + q[8 * i + 2] * bflo(w.y) + q[8 * i + 3] * bfhi(w.y) + q[8 * i + 4] * bflo(w.z) + q[8 * i + 5] * bfhi(w.z) + q[8 * i + 6] * bflo(w.w) + q[8 * i + 7] * bfhi(w.w); }
                const int dist = t - pos; const float sc = dot + bd[dist < 128 ? dist : 128];
                if (sc > mrun) { const float a = __expf(mrun - sc); l *= a;
#pragma unroll
                    for (int i = 0; i < 64; ++i) o[i] *= a;
                    mrun = sc; }
                const float p = __expf(sc - mrun); l += p;
                const GAS u32x4v* vp = (const GAS u32x4v*)(VA + (r0 + s) * 512 + h * 64);
#pragma unroll
                for (int i = 0; i < 8; ++i) { const u32x4v w = vp[i]; o[8 * i] += p * bflo(w.x); o[8 * i + 1] += p * bfhi(w.x); o[8 * i + 2] += p * bflo(w.y); o[8 * i + 3] += p * bfhi(w.y); o[8 * i + 4] += p * bflo(w.z); o[8 * i + 5] += p * bfhi(w.z); o[8 * i + 6] += p * bflo(w.w); o[8 * i + 7] += p * bfhi(w.w); }
            }
        }
        const float il = 1.0f / l;
        GAS u32x4v* yp = (GAS u32x4v*)(F.Y + (size_t)row * 1024 + h * 64);
#pragma unroll
        for (int i = 0; i < 8; ++i) { u32x4v w; w.x = pk2(o[8 * i] * il, o[8 * i + 1] * il); w.y = pk2(o[8 * i + 2] * il, o[8 * i + 3] * il); w.z = pk2(o[8 * i + 4] * il, o[8 * i + 5] * il); w.w = pk2(o[8 * i + 6] * il, o[8 * i + 7] * il); yp[i] = w; }
    }
}
__device__ __forceinline__ void p4_ret_simple(Frame& F) {
    const bf16* QR = F.PROJ + 3 * (size_t)TT * 512; const bf16* KR = F.PROJ + 4 * (size_t)TT * 512; const bf16* VR = F.PROJ + 5 * (size_t)TT * 512; const bf16* GR = F.PROJ + 6 * (size_t)TT * 512;
    const int gt = blockIdx.x * (NWAVES * 64) + F.tid, NT = F.G * NWAVES * 64;
    for (int idx = gt; idx < TT * NH; idx += NT) {
        const int h = idx >> 15, row = idx & (TT - 1), b = row >> 14, t = row & (SEQ - 1), c = t >> 8, n = t & 255;
        float q[64], y[64];
        { const GAS u32x4v* qp = (const GAS u32x4v*)(QR + (size_t)row * 512 + h * 64);
#pragma unroll
          for (int i = 0; i < 8; ++i) { const u32x4v w = qp[i]; q[8 * i] = bflo(w.x); q[8 * i + 1] = bfhi(w.x); q[8 * i + 2] = bflo(w.y); q[8 * i + 3] = bfhi(w.y); q[8 * i + 4] = bflo(w.z); q[8 * i + 5] = bfhi(w.z); q[8 * i + 6] = bflo(w.w); q[8 * i + 7] = bfhi(w.w); } }
#pragma unroll
        for (int i = 0; i < 64; ++i) y[i] = 0.f;
        const size_t r0 = (size_t)row - n;
        for (int m = 0; m <= n; ++m) {
            const GAS u32x4v* kp = (const GAS u32x4v*)(KR + (r0 + m) * 512 + h * 64); float dot = 0.f;
#pragma unroll
            for (int i = 0; i < 8; ++i) { const u32x4v w = kp[i]; dot += q[8 * i] * bflo(w.x) + q[8 * i + 1] * bfhi(w.x) + q[8 * i + 2] * bflo(w.y) + q[8 * i + 3] * bfhi(w.y) + q[8 * i + 4] * bflo(w.z) + q[8 * i + 5] * bfhi(w.z) + q[8 * i + 6] * bflo(w.w) + q[8 * i + 7] * bfhi(w.w); }
            const GAS u32x4v* vp = (const GAS u32x4v*)(VR + (r0 + m) * 512 + h * 64);
#pragma unroll
            for (int i = 0; i < 8; ++i) { const u32x4v w = vp[i]; y[8 * i] += dot * bflo(w.x); y[8 * i + 1] += dot * bfhi(w.x); y[8 * i + 2] += dot * bflo(w.y); y[8 * i + 3] += dot * bfhi(w.y); y[8 * i + 4] += dot * bflo(w.z); y[8 * i + 5] += dot * bfhi(w.z); y[8 * i + 6] += dot * bflo(w.w); y[8 * i + 7] += dot * bfhi(w.w); }
        }
        const float* R = F.RP + ((size_t)((b * 8 + h) * 64 + c)) * 4096; const float gam = F.gam[h];
        const bf16* qrow = QR + (size_t)row * 512 + h * 64;
        for (int d = 0; d < 64; ++d) {
            const float qd = bf1(qrow[d]) * gam; const GAS f32x4* rp = (const GAS f32x4*)(R + d * 64);
#pragma unroll
            for (int i = 0; i < 16; ++i) { const f32x4 r4 = rp[i]; y[4 * i] += qd * r4.x; y[4 * i + 1] += qd * r4.y; y[4 * i + 2] += qd * r4.z; y[4 * i + 3] += qd * r4.w; }
        }
        float mu = 0.f;
#pragma unroll
        for (int i = 0; i < 64; ++i) mu += y[i];
        mu *= (1.f / 64.f); float var = 0.f;
#pragma unroll
        for (int i = 0; i < 64; ++i) { y[i] -= mu; var += y[i] * y[i]; }
        const float rs = 1.0f / sqrtf(var * (1.f / 64.f) + EPS);
        const GAS u32x4v* gp = (const GAS u32x4v*)(GR + (size_t)row * 512 + h * 64);
        GAS u32x4v* yp = (GAS u32x4v*)(F.Y + (size_t)row * 1024 + 512 + h * 64);
#pragma unroll
        for (int i = 0; i < 8; ++i) { const u32x4v w = gp[i]; float g[8] = {bflo(w.x), bfhi(w.x), bflo(w.y), bfhi(w.y), bflo(w.z), bfhi(w.z), bflo(w.w), bfhi(w.w)}; float r[8];
#pragma unroll
            for (int k = 0; k < 8; ++k) r[k] = g[k] / (1.0f + __expf(-g[k])) * (y[8 * i + k] * rs);
            u32x4v ow; ow.x = pk2(r[0], r[1]); ow.y = pk2(r[2], r[3]); ow.z = pk2(r[4], r[5]); ow.w = pk2(r[6], r[7]); yp[i] = ow; }
    }
}

namespace mx {
typedef __attribute__((ext_vector_type(8))) short bf16x8;
typedef __attribute__((ext_vector_type(4))) short s16x4;
typedef __attribute__((ext_vector_type(16))) float f32x16;
typedef __attribute__((ext_vector_type(4))) unsigned u32x4;
typedef short v4i16_t __attribute__((ext_vector_type(4)));
typedef __attribute__((address_space(3))) const char* lds_cptr;
typedef float f32x2_t __attribute__((ext_vector_type(2))); typedef __bf16 bf16x2_t __attribute__((ext_vector_type(2)));
__device__ __forceinline__ int crow(int r, int hi) { return (r & 3) + 8 * (r >> 2) + 4 * hi; }
__device__ __forceinline__ unsigned cvtpk(float lo, float hi) { f32x2_t v = {lo, hi}; bf16x2_t b = __builtin_convertvector(v, bf16x2_t); return __builtin_bit_cast(unsigned, b); }
__device__ __forceinline__ void glds16(const void* gsrc, unsigned lds_dst) { unsigned keep;
    asm volatile("s_mov_b32 %0, m0\n\ts_mov_b32 m0, %2\n\ts_nop 0\n\tglobal_load_lds_dwordx4 %1, off\n\ts_mov_b32 m0, %0" : "=&s"(keep) : "v"(gsrc), "s"(lds_dst) : "memory"); }
__device__ __forceinline__ s16x4 vtr(lds_cptr p) { return __builtin_bit_cast(s16x4, __builtin_amdgcn_ds_read_tr16_b64_v4i16((__attribute__((address_space(3))) v4i16_t*)p)); }
#define MX_WAIT_BAR() asm volatile("s_waitcnt vmcnt(0) lgkmcnt(0)\n\ts_barrier" ::: "memory")
#define MX_LBAR() asm volatile("s_waitcnt lgkmcnt(0)\n\ts_barrier" ::: "memory")
__device__ __forceinline__ void dma_kimg(const bf16* tile, unsigned lds_img, int wid, int lane) { glds16(tile + (size_t)lane * 512 + wid * 8, (unsigned)__builtin_amdgcn_readfirstlane(lds_img + wid * 1024)); }
__device__ __forceinline__ void dma_timg(const bf16* tile, unsigned lds_img, int wid, int lane) { glds16(tile + (size_t)(16 * (wid & 3) + (lane >> 2)) * 512 + (wid >> 2) * 32 + (lane & 3) * 8, (unsigned)__builtin_amdgcn_readfirstlane(lds_img + wid * 1024)); }
__device__ __forceinline__ void qkt(f32x16& p0, f32x16& p1, lds_cptr kimg, const bf16x8* qr, int r32, int hi) {
    const lds_cptr kb = kimg + hi * 1024 + r32 * 16; const f32x16 z = {};
#pragma unroll
    for (int d0 = 0; d0 < 4; ++d0) {
        const bf16x8 b0 = *(const __attribute__((address_space(3))) bf16x8*)(kb + d0 * 2048), b1 = *(const __attribute__((address_space(3))) bf16x8*)(kb + d0 * 2048 + 512);
        p0 = __builtin_amdgcn_mfma_f32_32x32x16_bf16(b0, qr[d0], d0 == 0 ? z : p0, 0, 0, 0); p1 = __builtin_amdgcn_mfma_f32_32x32x16_bf16(b1, qr[d0], d0 == 0 ? z : p1, 0, 0, 0); }
}
__device__ __forceinline__ bf16x8 tfrag_perm(lds_cptr timg, int ks, int d0, int lane, int hi) {
    const lds_cptr p = timg + ((lane >> 4) & 1) * 32 + (lane & 3) * 8 + (4 * hi + ((lane & 15) >> 2)) * 64 + d0 * 4096 + ks * 1024;
    const s16x4 lo = vtr(p), hh = vtr(p + 512); return (bf16x8){lo[0], lo[1], lo[2], lo[3], hh[0], hh[1], hh[2], hh[3]};
}
__device__ __forceinline__ bf16x8 tfrag_nat(lds_cptr timg, int ks, int d0, int lane, int hi) {
    const lds_cptr p = timg + ((lane >> 4) & 1) * 32 + (lane & 3) * 8 + (8 * hi + ((lane & 15) >> 2)) * 64 + d0 * 4096 + ks * 1024;
    const s16x4 lo = vtr(p), hh = vtr(p + 256); return (bf16x8){lo[0], lo[1], lo[2], lo[3], hh[0], hh[1], hh[2], hh[3]};
}
__device__ __forceinline__ void pv64(f32x16* o, const f32x16& p0, const f32x16& p1, lds_cptr vimg, int lane, int hi) {
    u32x4 w0 = {cvtpk(p0[0], p0[1]), cvtpk(p0[2], p0[3]), cvtpk(p0[4], p0[5]), cvtpk(p0[6], p0[7])}, w1 = {cvtpk(p0[8], p0[9]), cvtpk(p0[10], p0[11]), cvtpk(p0[12], p0[13]), cvtpk(p0[14], p0[15])};
    u32x4 w2 = {cvtpk(p1[0], p1[1]), cvtpk(p1[2], p1[3]), cvtpk(p1[4], p1[5]), cvtpk(p1[6], p1[7])}, w3 = {cvtpk(p1[8], p1[9]), cvtpk(p1[10], p1[11]), cvtpk(p1[12], p1[13]), cvtpk(p1[14], p1[15])};
#pragma unroll
    for (int d0 = 0; d0 < 2; ++d0) {
        o[d0] = __builtin_amdgcn_mfma_f32_32x32x16_bf16(__builtin_bit_cast(bf16x8, w0), tfrag_perm(vimg, 0, d0, lane, hi), o[d0], 0, 0, 0);
        o[d0] = __builtin_amdgcn_mfma_f32_32x32x16_bf16(__builtin_bit_cast(bf16x8, w1), tfrag_perm(vimg, 1, d0, lane, hi), o[d0], 0, 0, 0);
        o[d0] = __builtin_amdgcn_mfma_f32_32x32x16_bf16(__builtin_bit_cast(bf16x8, w2), tfrag_perm(vimg, 2, d0, lane, hi), o[d0], 0, 0, 0);
        o[d0] = __builtin_amdgcn_mfma_f32_32x32x16_bf16(__builtin_bit_cast(bf16x8, w3), tfrag_perm(vimg, 3, d0, lane, hi), o[d0], 0, 0, 0);
    }
}
constexpr int L_K = 0, L_V = 32768, L_R = 65536, L_LIST = 65536, L_STG = 98304;
}

__device__ __forceinline__ void p2_kv_mfma(Frame& F) {
    using namespace mx;
    const bf16* KR = F.PROJ + 4 * (size_t)TT * 512; const bf16* VR = F.PROJ + 5 * (size_t)TT * 512;
    const int wid = F.wave, lane = F.lane, r32 = lane & 31, hi = lane >> 5;
    const unsigned lds0 = (unsigned)(size_t)F.lds; const lds_cptr L = (lds_cptr)F.lds;
    for (int it = blockIdx.x; it < 1024; it += F.G) {
        const int b = it >> 9, h = (it >> 6) & 7, c = it & 63; const size_t row0 = (size_t)b * SEQ + c * 256;
        MX_LBAR();
#pragma unroll
        for (int kt = 0; kt < 4; ++kt) { dma_timg(KR + (row0 + 64 * kt) * 512 + h * 64, lds0 + L_K + kt * 8192, wid, lane); dma_timg(VR + (row0 + 64 * kt) * 512 + h * 64, lds0 + L_V + kt * 8192, wid, lane); }
        MX_WAIT_BAR();
        const int dt = wid & 1, et = (wid >> 1) & 1, kh = wid >> 2; f32x16 acc = {};
#pragma unroll
        for (int k = 0; k < 8; ++k) { const int kt = 2 * kh + (k >> 2), ks = k & 3;
            acc = __builtin_amdgcn_mfma_f32_32x32x16_bf16(tfrag_perm(L + L_K + kt * 8192, ks, dt, lane, hi), tfrag_perm(L + L_V + kt * 8192, ks, et, lane, hi), acc, 0, 0, 0); }
        LAS float* red = (LAS float*)(F.lds + L_STG) + (wid & 3) * 1024;
        if (kh == 1) {
#pragma unroll
            for (int r = 0; r < 16; ++r) red[r * 64 + lane] = acc[r];
        }
        MX_LBAR();
        if (kh == 0) { const float sc = F.dpos[h * 256 + 255]; float* dst = F.KV + (size_t)it * 4096 + (32 * dt + 4 * hi) * 64 + 32 * et + r32;
#pragma unroll
            for (int r = 0; r < 16; ++r) dst[((r & 3) + 8 * (r >> 2)) * 64] = (acc[r] + red[r * 64 + lane]) * sc; }
    }
    MX_LBAR();
}
__device__ __forceinline__ void p4_ret_mfma(Frame& F) {
    using namespace mx;
    const bf16* QR = F.PROJ + 3 * (size_t)TT * 512; const bf16* KR = F.PROJ + 4 * (size_t)TT * 512; const bf16* VR = F.PROJ + 5 * (size_t)TT * 512; const bf16* GR = F.PROJ + 6 * (size_t)TT * 512;
    const int wid = F.wave, lane = F.lane, r32 = lane & 31, hi = lane >> 5;
    const unsigned lds0 = (unsigned)(size_t)F.lds; const lds_cptr L = (lds_cptr)F.lds;
    for (int it = blockIdx.x; it < 1024; it += F.G) {
        const int b = it >> 9, h = (it >> 6) & 7, c = it & 63; const size_t row0 = (size_t)b * SEQ + c * 256;
        MX_LBAR();
#pragma unroll
        for (int kt = 0; kt < 4; ++kt) { dma_kimg(KR + (row0 + 64 * kt) * 512 + h * 64, lds0 + L_K + kt * 8192, wid, lane); dma_timg(VR + (row0 + 64 * kt) * 512 + h * 64, lds0 + L_V + kt * 8192, wid, lane); }
        {
            const int d = F.tid >> 3, e0 = (F.tid & 7) * 8; const float g = F.gam[h];
            const GAS f32x4* rp = (const GAS f32x4*)(F.RP + (size_t)it * 4096 + d * 64 + e0); const f32x4 a = rp[0], bq = rp[1];
            u32x4 w = {cvtpk(a.x * g, a.y * g), cvtpk(a.z * g, a.w * g), cvtpk(bq.x * g, bq.y * g), cvtpk(bq.z * g, bq.w * g)};
            *(LAS u32x4*)(F.lds + L_R + ((e0 >> 5) * 4 + (d >> 4)) * 1024 + (d & 15) * 64 + (e0 & 31) * 2) = w; }
        bf16x8 qr[4];
        { const bf16* qp = QR + (row0 + 32 * wid + r32) * 512 + h * 64 + hi * 8;
#pragma unroll
          for (int d0 = 0; d0 < 4; ++d0) qr[d0] = *(const bf16x8*)(qp + d0 * 16); }
        MX_WAIT_BAR();
        f32x16 o[2]; o[0] = f32x16{}; o[1] = f32x16{};
        const int ktd = wid >> 1;
        for (int kt = 0; kt <= ktd; ++kt) {
            f32x16 p0, p1; qkt(p0, p1, L + L_K + kt * 8192, qr, r32, hi);
            if (kt == ktd) { const int qrel = 32 * (wid & 1) + r32;
#pragma unroll
                for (int r = 0; r < 16; ++r) { const int kv = crow(r, hi); if (kv > qrel) p0[r] = 0.f; if (kv + 32 > qrel) p1[r] = 0.f; } }
            pv64(o, p0, p1, L + L_V + kt * 8192, lane, hi);
        }
#pragma unroll
        for (int d0 = 0; d0 < 2; ++d0)
#pragma unroll
            for (int ks = 0; ks < 4; ++ks) o[d0] = __builtin_amdgcn_mfma_f32_32x32x16_bf16(qr[ks], tfrag_nat(L + L_R, ks, d0, lane, hi), o[d0], 0, 0, 0);
        LAS bf16* stg = (LAS bf16*)(F.lds + L_STG) + wid * 2048;
#pragma unroll
        for (int r = 0; r < 16; ++r) {
            float s1 = o[0][r] + o[1][r], s2 = o[0][r] * o[0][r] + o[1][r] * o[1][r];
#pragma unroll
            for (int x = 1; x < 32; x <<= 1) { s1 += __shfl_xor(s1, x); s2 += __shfl_xor(s2, x); }
            const float mu = s1 * (1.f / 64.f), var = s2 * (1.f / 64.f) - mu * mu, rs = 1.0f / sqrtf(fmaxf(var, 0.f) + EPS);
            const int orow = crow(r, hi);
            stg[orow * 64 + r32] = (bf16)(cvtpk((o[0][r] - mu) * rs, 0.f) & 0xffffu); stg[orow * 64 + 32 + r32] = (bf16)(cvtpk((o[1][r] - mu) * rs, 0.f) & 0xffffu);
        }
        LDS_WAIT();
#pragma unroll
        for (int i = 0; i < 4; ++i) { const int row = i * 8 + (lane >> 3), ch = lane & 7; const size_t grow = row0 + 32 * wid + row;
            const u32x4 yv = *(const LAS u32x4*)(stg + row * 64 + ch * 8); const u32x4 gv = *(const GAS u32x4*)(GR + grow * 512 + h * 64 + ch * 8);
            u32x4 ov;
#define P4_G(yw, gw) cvtpk(bflo(gw) / (1.0f + __expf(-bflo(gw))) * bflo(yw), bfhi(gw) / (1.0f + __expf(-bfhi(gw))) * bfhi(yw))
            ov.x = P4_G(yv.x, gv.x); ov.y = P4_G(yv.y, gv.y); ov.z = P4_G(yv.z, gv.z); ov.w = P4_G(yv.w, gv.w);
#undef P4_G
            *(GAS u32x4*)(F.Y + grow * 1024 + 512 + h * 64 + ch * 8) = ov; }
    }
    MX_LBAR();
}


constexpr int NSEL_ITEMS = 63 * 16, NOWN_ITEMS = 64 * 16, NMOBA_ITEMS = NSEL_ITEMS + NOWN_ITEMS;
constexpr int LX_ITEM = 131072 + 512, LX_BD2 = 131072 + 1024, LX_WSF = 131072 + 2048, LX_OFF = 131072 + 4096;
__device__ __forceinline__ void moba_tile(Frame& F, bool own, int b, int h, int j, int tile, int n) {
    using namespace mx;
    const int wid = F.wave, lane = F.lane, r32 = lane & 31, hi = lane >> 5;
    const lds_cptr L = (lds_cptr)F.lds;
    const LAS unsigned short* LIST = (const LAS unsigned short*)(F.lds + L_LIST);
    LAS float* wsf = (LAS float*)(F.lds + LX_WSF) + wid * 64;
    const LAS float* bd2 = (const LAS float*)(F.lds + LX_BD2);
    const bf16* QA = F.PROJ;
    int ri = tile * 32 + r32; const bool rvalid = ri < n; if (!rvalid) ri = n - 1;
    const unsigned e = own ? (((unsigned)j << 10) | (3u << 8) | (unsigned)ri) : (unsigned)LIST[ri];
    const int tq = (int)(e >> 10) * 256 + (int)(e & 255u), slot = (int)((e >> 8) & 3u);
    const size_t row = (size_t)b * SEQ + tq;
    bf16x8 qr[4];
    { const bf16* qp = QA + row * 512 + h * 64 + hi * 8;
#pragma unroll
      for (int d0 = 0; d0 < 4; ++d0) qr[d0] = *(const bf16x8*)(qp + d0 * 16); }
    float m = -1.0e30f, l = 0.f; f32x16 o[2]; o[0] = f32x16{}; o[1] = f32x16{};
    const int ktmax = own ? ((tile * 32 + 31) >> 6) : 3;
    const bool far = !own && __all(tq >= 256 * j + 383);
    for (int kt = 0; kt <= ktmax; ++kt) {
        f32x16 p0, p1; qkt(p0, p1, L + L_K + kt * 8192, qr, r32, hi);
        if (!far) { const int kb = 256 * j + 64 * kt + 4 * hi;
#pragma unroll
            for (int r = 0; r < 16; ++r) { const int d0 = tq - (kb + (r & 3) + 8 * (r >> 2)), d1 = d0 - 32;
                const float b0 = bd2[d0 < 0 ? 0 : (d0 < 128 ? d0 : 128)], b1 = bd2[d1 < 0 ? 0 : (d1 < 128 ? d1 : 128)];
                p0[r] = d0 < 0 ? -1.0e30f : p0[r] + b0; p1[r] = d1 < 0 ? -1.0e30f : p1[r] + b1; } }
        float rm = fmaxf(p0[0], p1[0]);
#pragma unroll
        for (int r = 1; r < 16; ++r) rm = fmaxf(rm, fmaxf(p0[r], p1[r]));
        { auto rr = __builtin_amdgcn_permlane32_swap(__float_as_uint(rm), __float_as_uint(rm), false, false); rm = fmaxf(__uint_as_float(rr[0]), __uint_as_float(rr[1])); }
        const float mn = fmaxf(m, rm), alpha = __builtin_amdgcn_exp2f(m - mn); m = mn;
        float ls = 0.f;
#pragma unroll
        for (int r = 0; r < 16; ++r) { p0[r] = __builtin_amdgcn_exp2f(p0[r] - mn); p1[r] = __builtin_amdgcn_exp2f(p1[r] - mn); ls += p0[r] + p1[r]; }
        l = l * alpha + ls;
        if (hi == 0) wsf[r32] = alpha;
        LDS_WAIT();
#pragma unroll
        for (int g = 0; g < 4; ++g) { const f32x4 a4 = *(const LAS f32x4*)(wsf + 8 * g + 4 * hi);
#pragma unroll
            for (int k = 0; k < 4; ++k) { o[0][4 * g + k] *= a4[k]; o[1][4 * g + k] *= a4[k]; } }
        pv64(o, p0, p1, L + L_V + kt * 8192, lane, hi);
    }
    { auto rr = __builtin_amdgcn_permlane32_swap(__float_as_uint(l), __float_as_uint(l), false, false); l = __uint_as_float(rr[0]) + __uint_as_float(rr[1]); }
    if (hi == 0) { wsf[32 + r32] = 1.0f / l;
        if (rvalid) { float* mlp = F.ML + (((size_t)slot * TT + row) * 8 + h) * 2; mlp[0] = far ? m + bd2[128] : m; mlp[1] = l; } }
    LDS_WAIT();
    LAS bf16* stg = (LAS bf16*)(F.lds + L_STG) + wid * 2048;
#pragma unroll
    for (int g = 0; g < 4; ++g) { const f32x4 i4 = *(const LAS f32x4*)(wsf + 32 + 8 * g + 4 * hi);
#pragma unroll
        for (int k = 0; k < 4; ++k) { const int r = 4 * g + k, orow = crow(r, hi);
            stg[orow * 64 + r32] = (bf16)(cvtpk(o[0][r] * i4[k], 0.f) & 0xffffu); stg[orow * 64 + 32 + r32] = (bf16)(cvtpk(o[1][r] * i4[k], 0.f) & 0xffffu); } }
    LDS_WAIT();
#pragma unroll
    for (int i = 0; i < 4; ++i) { const int rw = i * 8 + (lane >> 3), ch = lane & 7, ri2 = tile * 32 + rw;
        if (ri2 < n) { const unsigned e2 = own ? (((unsigned)j << 10) | (3u << 8) | (unsigned)ri2) : (unsigned)LIST[ri2];
            const int tq2 = (int)(e2 >> 10) * 256 + (int)(e2 & 255u), s2 = (int)((e2 >> 8) & 3u);
            bf16* dst = (s2 < 2 ? F.PO01 + (size_t)s2 * TT * 512 : F.PO23 + (size_t)(s2 - 2) * TT * 512) + (((size_t)b * SEQ + tq2) * 8 + h) * 64 + ch * 8;
            *(GAS u32x4*)dst = *(const LAS u32x4*)(stg + rw * 64 + ch * 8); } }
    LDS_WAIT();
}
__device__ __forceinline__ void p3_moba(Frame& F, int qw) {
    using namespace mx;
    const bf16* KA = F.PROJ + (size_t)TT * 512; const bf16* VA = F.PROJ + 2 * (size_t)TT * 512;
    const int wid = F.wave, lane = F.lane;
    const unsigned lds0 = (unsigned)(size_t)F.lds;
    volatile LAS int* itemw = (volatile LAS int*)(F.lds + LX_ITEM);
    LAS int* offs = (LAS int*)(F.lds + LX_OFF);
    LAS unsigned short* LIST = (LAS unsigned short*)(F.lds + L_LIST);
    LAS float* bd2 = (LAS float*)(F.lds + LX_BD2);
    int nxt = 0;
    if (F.tid == 0) nxt = (int)__hip_atomic_fetch_add(F.ctl + qw, 1u, RLX_AGENT);
    for (;;) {
        if (F.tid == 0) itemw[0] = nxt;
        MX_LBAR();
        const int idx = itemw[0];
        if (idx >= NMOBA_ITEMS) break;
        if (F.tid == 0) nxt = (int)__hip_atomic_fetch_add(F.ctl + qw, 1u, RLX_AGENT);
        const bool own = idx >= NSEL_ITEMS; const int o_ = own ? idx - NSEL_ITEMS : idx, j = o_ >> 4, bh = o_ & 15, b = bh >> 3, h = bh & 7;
        const size_t row0 = (size_t)b * SEQ + j * 256;
#pragma unroll
        for (int kt = 0; kt < 4; ++kt) { dma_kimg(KA + (row0 + 64 * kt) * 512 + h * 64, lds0 + L_K + kt * 8192, wid, lane); dma_timg(VA + (row0 + 64 * kt) * 512 + h * 64, lds0 + L_V + kt * 8192, wid, lane); }
        if (F.tid < 132) bd2[F.tid] = F.biasd[h * 132 + F.tid] * 1.4426950408889634f;
        int n = 256;
        if (!own) {
            if (wid == 0) { const unsigned v = (lane > j) ? F.CNTW[(size_t)(bh * 64 + lane) * 64 + j] : 0u; const int cnt = (int)(v & 0xffffu); int xs = cnt;
#pragma unroll
                for (int o = 1; o < 64; o <<= 1) { const int y = __shfl_up(xs, o); if (lane >= o) xs += y; }
                offs[lane] = xs - cnt; offs[64 + lane] = (int)(v >> 16); offs[128 + lane] = cnt; if (lane == 63) offs[192] = xs; }
            MX_LBAR();
            n = offs[192];
            for (int c = j + 1 + wid; c < 64; c += 8) { const int cnt = offs[128 + c], st = offs[64 + c], off = offs[c]; const unsigned short* runs = F.RUNS + (size_t)(bh * 64 + c) * 768 + st;
                for (int i = lane; i < cnt; i += 64) LIST[off + i] = (unsigned short)((c << 10) | runs[i]); }
        }
        MX_WAIT_BAR();
        const int ntile = (n + 31) >> 5;
        for (int tile = wid; tile < ntile; tile += 8) moba_tile(F, own, b, h, j, tile, n);
    }
}
__device__ __forceinline__ void p4_combine(Frame& F) {
    const int gt = blockIdx.x * (NWAVES * 64) + F.tid, NT = F.G * NWAVES * 64;
    for (int gid = gt; gid < TT * 64; gid += NT) {
        const int ch = gid & 7, h = (gid >> 3) & 7, row = gid >> 6, c = (row & (SEQ - 1)) >> 8, nv = c < 3 ? c : 3;
        float ms[4], ls[4];
#pragma unroll
        for (int s = 0; s < 4; ++s) { const bool v = (s == 3) || (s < nv); const float* mlp = F.ML + (((size_t)s * TT + row) * 8 + h) * 2; ms[s] = v ? mlp[0] : -3.0e38f; ls[s] = v ? mlp[1] : 0.f; }
        const float M = fmaxf(fmaxf(ms[0], ms[1]), fmaxf(ms[2], ms[3]));
        float acc[8], wsum = 0.f;
#pragma unroll
        for (int k = 0; k < 8; ++k) acc[k] = 0.f;
#pragma unroll
        for (int s = 0; s < 4; ++s) { const bool v = (s == 3) || (s < nv);
            if (v) { const float w = __builtin_amdgcn_exp2f(ms[s] - M) * ls[s]; wsum += w;
                const bf16* src = (s < 2 ? F.PO01 + (size_t)s * TT * 512 : F.PO23 + (size_t)(s - 2) * TT * 512) + ((size_t)row * 8 + h) * 64 + ch * 8;
                const u32x4v pw = *(const GAS u32x4v*)src;
                acc[0] += w * bflo(pw.x); acc[1] += w * bfhi(pw.x); acc[2] += w * bflo(pw.y); acc[3] += w * bfhi(pw.y); acc[4] += w * bflo(pw.z); acc[5] += w * bfhi(pw.z); acc[6] += w * bflo(pw.w); acc[7] += w * bfhi(pw.w); } }
        const float iw = 1.0f / wsum; u32x4v ow; ow.x = pk2(acc[0] * iw, acc[1] * iw); ow.y = pk2(acc[2] * iw, acc[3] * iw); ow.z = pk2(acc[4] * iw, acc[5] * iw); ow.w = pk2(acc[6] * iw, acc[7] * iw);
        *(GAS u32x4v*)(F.Y + (size_t)row * 1024 + h * 64 + ch * 8) = ow;
    }
}

__device__ __forceinline__ void rows_residual(Frame& F, const float* xin, const bf16* Yb, const float* gpost, float* xout, bf16* XNo) {
    const int gw = F.vcu * NWAVES + F.wave, NGW = F.G * NWAVES;
    for (int m = gw; m < TT; m += NGW) {
        float ss = 0.f;
        { const GAS f32x4* rp = (const GAS f32x4*)(F.rowss + (size_t)m * 16);
#pragma unroll
          for (int i = 0; i < 4; ++i) { const f32x4 r = rp[i]; ss += (r.x + r.y) + (r.z + r.w); } }
        const float rstd = 1.0f / sqrtf(ss * (1.f / DM) + EPS);
        const GAS f32x4* xr = (const GAS f32x4*)(xin + (size_t)m * DM) + F.lane;
        const GAS u32x2v* yr = (const GAS u32x2v*)(Yb + (size_t)m * DM) + F.lane;
        const GAS f32x4* gr = (const GAS f32x4*)gpost + F.lane;
        GAS f32x4* orow = (GAS f32x4*)(xout + (size_t)m * DM) + F.lane;
        f32x4 v[4]; float s2 = 0.f;
#pragma unroll
        for (int j = 0; j < 4; ++j) { const f32x4 xv = xr[64 * j]; const u32x2v yw = yr[64 * j]; const f32x4 g = gr[64 * j];
            v[j].x = xv.x + bflo(yw.x) * rstd * g.x; v[j].y = xv.y + bfhi(yw.x) * rstd * g.y; v[j].z = xv.z + bflo(yw.y) * rstd * g.z; v[j].w = xv.w + bfhi(yw.y) * rstd * g.w;
            orow[64 * j] = v[j]; s2 += (v[j].x * v[j].x + v[j].y * v[j].y) + (v[j].z * v[j].z + v[j].w * v[j].w); }
        if (XNo) {
            const float r2 = 1.0f / sqrtf(wave_sum(s2) * (1.f / DM) + EPS);
            GAS unsigned long long* o8 = (GAS unsigned long long*)(XNo + (size_t)m * DM) + F.lane;
#pragma unroll
            for (int j = 0; j < 4; ++j) o8[64 * j] = (unsigned long long)pk2(v[j].x * r2, v[j].y * r2) | ((unsigned long long)pk2(v[j].z * r2, v[j].w * r2) << 32);
        }
    }
}
__device__ __forceinline__ float gelu_tanh(float a) { const float z = 0.7978845608028654f * (a + 0.044715f * a * a * a); return a * (1.0f - 1.0f / (__expf(2.0f * z) + 1.0f)); }
__device__ __forceinline__ void p8_conv(Frame& F, int hb) {
    const int gw = F.vcu * NWAVES + F.wave, NGW = F.G * NWAVES;
    constexpr int RSEG = 32, NSEG = SEQ / RSEG;
    for (int it = gw; it < 11 * NSEG; it += NGW) {
        const int strip = it % 11, seg = it / 11, c = strip * 256 + F.lane * 4, r0 = seg * RSEG;
        f32x4 wa[3], wb[3];
#pragma unroll
        for (int j = 0; j < 3; ++j) { wa[j] = *(const GAS f32x4*)(F.conv_w + (size_t)j * NUP + c); wb[j] = *(const GAS f32x4*)(F.conv_w + (size_t)j * NUP + DFF + c); }
        const f32x4 ba = *(const GAS f32x4*)(F.conv_b + c), bb = *(const GAS f32x4*)(F.conv_b + DFF + c);
        f32x4 a2 = {0.f, 0.f, 0.f, 0.f}, a1 = a2, b2 = a2, b1 = a2;
#define P8_LD(r, ua, ub) do { const u32x2v wa_ = *(const GAS u32x2v*)(Ub + (size_t)(r) * NUP + c), wb_ = *(const GAS u32x2v*)(Ub + (size_t)(r) * NUP + DFF + c); \
            ua = (f32x4){bflo(wa_.x), bfhi(wa_.x), bflo(wa_.y), bfhi(wa_.y)}; ub = (f32x4){bflo(wb_.x), bfhi(wb_.x), bflo(wb_.y), bfhi(wb_.y)}; } while (0)
        const bf16* Ub = F.U;
        if (r0 >= 2) { P8_LD(r0 - 2, a2, b2); P8_LD(r0 - 1, a1, b1); }
        for (int r = r0; r < r0 + RSEG; ++r) {
            f32x4 ua, ub; P8_LD(r, ua, ub);
            const f32x4 av = ba + wa[0] * a2 + wa[1] * a1 + wa[2] * ua, bv = bb + wb[0] * b2 + wb[1] * b1 + wb[2] * ub;
            u32x2v o; o.x = pk2(gelu_tanh(av.x) * bv.x, gelu_tanh(av.y) * bv.y); o.y = pk2(gelu_tanh(av.z) * bv.z, gelu_tanh(av.w) * bv.w);
            *(GAS u32x2v*)(F.Fb + ((size_t)hb * SEQ + r) * DFF + c) = o;
            a2 = a1; a1 = ua; b2 = b1; b1 = ub;
        }
    }
}

constexpr int NPHASE = 10;
struct Args { const float* in[12]; float* out; unsigned char* ws; int ph_lo, ph_hi; };
__global__ void __launch_bounds__(NWAVES * 64, 2) fwd_kernel(Args args) {
    extern __shared__ __attribute__((aligned(16))) unsigned char lds[];
    Frame F;
    F.lds = (LAS unsigned char*)lds; F.MISC = (volatile LAS unsigned*)(F.lds + MISC_OFF);
    F.tid = threadIdx.x; F.lane = F.tid & 63; F.wave = __builtin_amdgcn_readfirstlane(F.tid >> 6);
    F.G = gridDim.x; { const int bx = blockIdx.x; F.vcu = (F.G % 8 == 0) ? (bx % 8) * (F.G / 8) + bx / 8 : bx; }
    unsigned char* ws = args.ws;
    F.ctl = (gu32*)(ws + WS_CTL);
    F.x = args.in[0]; F.g_mix_pre = args.in[1]; F.w_in = args.in[2]; F.rel_bias = args.in[3]; F.w_out = args.in[4]; F.g_mix_post = args.in[5];
    F.g_ffn_pre = args.in[6]; F.w_up = args.in[7]; F.conv_w = args.in[8]; F.conv_b = args.in[9]; F.w_down = args.in[10]; F.g_ffn_post = args.in[11]; F.out = args.out;
    F.Win_t = (bf16*)(ws + WS_WIN); F.Wout_t = (bf16*)(ws + WS_WOUT); F.Wup_t = (bf16*)(ws + WS_WUP); F.Wdn_t = (bf16*)(ws + WS_WDN);
    F.XN = (bf16*)(ws + WS_XN); F.PROJ = (bf16*)(ws + WS_PROJ); F.Y = (bf16*)(ws + WS_Y); F.Y1 = (bf16*)(ws + WS_Y1); F.U = (bf16*)(ws + WS_U); F.Fb = (bf16*)(ws + WS_F);
    F.cs = (float*)(ws + WS_CS); F.biasd = (float*)(ws + WS_SMALL + SM_BIASD); F.dpos = (float*)(ws + WS_SMALL + SM_DPOS); F.dneg = (float*)(ws + WS_SMALL + SM_DNEG);
    F.gam = (float*)(ws + WS_SMALL + SM_GAM); F.g256 = (float*)(ws + WS_SMALL + SM_G256);
    F.kms = (float*)(ws + WS_KMS); F.rowss = (float*)(ws + WS_ROWSS); F.KV = (float*)(ws + WS_KV); F.RP = (float*)(ws + WS_RP); F.sel = (unsigned*)(ws + WS_SEL);
    F.RUNS = (unsigned short*)(ws + WS_RUNS); F.CNTW = (unsigned*)(ws + WS_CNTW); F.PO01 = (bf16*)(ws + WS_PO01); F.PO23 = (bf16*)(ws + WS_PO23); F.ML = (float*)(ws + WS_ML);
    for (int u = F.tid; u < (LDS_BYTES - LDSCTL_OFF) / 4; u += NWAVES * 64) ((LAS unsigned*)(F.lds + LDSCTL_OFF))[u] = 0u;
    __syncthreads();
    XcdBarrier bar; bar.bar = (unsigned*)(F.ctl + CW_BAR); bar.x = 0; bar.st = nullptr;
    if (MK_ONE_LAUNCH) bar = xcd_barrier_post((unsigned*)(F.ctl + CW_BAR), F.MISC + 8);
    const int lo = args.ph_lo, hi = args.ph_hi;
#define IN(k) (lo <= (k) && (k) < hi)
#define DUP(k) ((MK_DUP >> (k)) & 1)
#define SEAM(k) do { if (IN(k) && IN((k) + 1)) xcd_barrier(bar); } while (0)

    if (IN(0)) { p0_prologue(F); if (DUP(0)) { __syncthreads(); p0_prologue(F); } }
#if MK_ONE_LAUNCH
    if (IN(0) && IN(1)) { cooperative_groups::this_grid().sync(); }
#endif
    if (IN(1)) {
        pg8::Gemm g{F.XN, F.Win_t, TT, NPROJ, DM}; pg8::StaticOrder S; S.init(TT, NPROJ, F.G, (int)blockIdx.x);
        pg8::EpiProj E{F.PROJ, F.cs, F.dpos, F.dneg, F.kms};
        pg8::gemm_phase<pg8::EpiProj, pg8::StaticOrder, PG8_ALIGN, PG8_SP2>(F.lds + RING_OFF, g, S, E);
        if (DUP(1)) { __syncthreads(); pg8::gemm_phase<pg8::EpiProj, pg8::StaticOrder, PG8_ALIGN, PG8_SP2>(F.lds + RING_OFF, g, S, E); }
    } SEAM(1);
    if (IN(2)) { p2_gate(F); __syncthreads(); p2_kv_mfma(F); if (DUP(2)) { __syncthreads(); p2_gate(F); __syncthreads(); p2_kv_mfma(F); } } SEAM(2);
    if (IN(3)) { p3_scan(F); p3_moba(F, CW_Q); if (DUP(3)) { __syncthreads(); p3_scan(F); p3_moba(F, CW_Q + 64); } } SEAM(3);
    if (IN(4)) { p4_ret_mfma(F); p4_combine(F); if (DUP(4)) { __syncthreads(); p4_ret_mfma(F); p4_combine(F); } } SEAM(4);
    if (IN(5)) {
        pg8::Gemm g{F.Y, F.Wout_t, TT, DM, DM}; pg8::StaticOrder S; S.init(TT, DM, F.G, (int)blockIdx.x);
        pg8::EpiY E{F.Y1, F.rowss};
        pg8::gemm_phase<pg8::EpiY, pg8::StaticOrder, PG8_ALIGN, PG8_SP2>(F.lds + RING_OFF, g, S, E);
    } SEAM(5);
    if (IN(6)) { rows_residual(F, F.x, F.Y1, F.g_mix_post, F.out, F.XN); if (DUP(6)) rows_residual(F, F.x, F.Y1, F.g_mix_post, F.out, F.XN); } SEAM(6);
    if (IN(7)) {
        pg8::Gemm g{F.XN, F.Wup_t, 130 * 256, NUP, DM, 1}; pg8::StaticOrder S; S.init(130 * 256, NUP, F.G, (int)blockIdx.x);
        pg8::EpiFfn E{F.Fb, F.conv_w, F.conv_b, (LAS float*)(F.lds + XCH_OFF)};
        pg8::gemm_phase<pg8::EpiFfn, pg8::StaticOrder, true, PG8_SP2>(F.lds + RING_OFF, g, S, E);
    } SEAM(7);
    if (IN(8)) {
        pg8::Gemm g{F.Fb, F.Wdn_t, TT, DM, DFF}; pg8::StaticOrder S; S.init(TT, DM, F.G, (int)blockIdx.x);
        pg8::EpiY E{F.Y1, F.rowss};
        pg8::gemm_phase<pg8::EpiY, pg8::StaticOrder, PG8_ALIGN, PG8_SP2>(F.lds + RING_OFF, g, S, E);
    } SEAM(8);
    if (IN(9)) { rows_residual(F, F.out, F.Y1, F.g_ffn_post, F.out, nullptr); }
#undef IN
#undef SEAM
}

extern "C" void kernel_launch(void* const* d_in, const int* in_sizes, int n_in, void* d_out, int out_size, void* d_ws, size_t ws_size, hipStream_t stream) {
    static int grid = 0;
    if (grid == 0) {
        if (n_in != 12 || in_sizes[0] != TT * DM || out_size != TT * DM || ws_size < WS_END) { fprintf(stderr, "kernel_launch: unexpected shapes (n_in %d in0 %d out %d ws %zu)\n", n_in, n_in > 0 ? in_sizes[0] : -1, out_size, ws_size); grid = -1; return; }
        int dev = 0, cus = 0, per_cu = 0;
        if (hipGetDevice(&dev) != hipSuccess || hipDeviceGetAttribute(&cus, hipDeviceAttributeMultiprocessorCount, dev) != hipSuccess) { grid = -1; return; }
        if (hipFuncSetAttribute((const void*)fwd_kernel, hipFuncAttributeMaxDynamicSharedMemorySize, LDS_BYTES) != hipSuccess) { fprintf(stderr, "kernel_launch: hipFuncSetAttribute failed\n"); grid = -1; return; }
        if (hipOccupancyMaxActiveBlocksPerMultiprocessor(&per_cu, (const void*)fwd_kernel, NWAVES * 64, LDS_BYTES) != hipSuccess || per_cu < 1) { fprintf(stderr, "kernel_launch: occupancy query says %d\n", per_cu); per_cu = 1; }
        (void)hipGetLastError();
        grid = cus * (per_cu < 1 ? 1 : 1);
    }
    if (grid < 0) return;
    if (hipMemsetAsync((char*)d_ws + WS_CTL, 0, CTL_ZERO_BYTES, stream) != hipSuccess) { fprintf(stderr, "kernel_launch: memset failed\n"); return; }
    Args a{};
    for (int i = 0; i < 12; ++i) a.in[i] = (const float*)d_in[i];
    a.out = (float*)d_out; a.ws = (unsigned char*)d_ws;
#if MK_ONE_LAUNCH
    a.ph_lo = 0; a.ph_hi = NPHASE;
    void* kargs[] = {&a};
    hipError_t e = hipLaunchCooperativeKernel((const void*)fwd_kernel, dim3(grid), dim3(NWAVES * 64), kargs, LDS_BYTES, stream);
    if (e != hipSuccess) fprintf(stderr, "kernel_launch: cooperative launch failed: %s\n", hipGetErrorString(e));
#else
    for (int p = 0; p < NPHASE; ++p) { a.ph_lo = p; a.ph_hi = p + 1; hipLaunchKernelGGL(fwd_kernel, dim3(grid), dim3(NWAVES * 64), LDS_BYTES, stream, a); }
#endif
}
```

```cpp
#include <hip/hip_runtime.h>
#include <hip/hip_cooperative_groups.h>
#include <cstdio>
#include <cstdint>
#define MK_ONE_LAUNCH 1
namespace pg8 {
#define PG8_LAS __attribute__((address_space(3)))
typedef unsigned short bf16_t;
typedef short bf16x8 __attribute__((ext_vector_type(8)));
typedef float f32x4 __attribute__((ext_vector_type(4)));
typedef unsigned u32x4 __attribute__((ext_vector_type(4)));
constexpr int BM = 256, BK = 64, HALF = 128, HTB = HALF * BK * 2  , STAGE_BYTES = 8 * HTB, NXCD = 8, WGM = 8;

__host__ __device__ __forceinline__ int lds_byte(int r, int c) { const int st = (r >> 4) * 2 + (c >> 5), rr = r & 15, cc = c & 31, ob = rr * 64 + cc * 2; return st * 1024 + (ob ^ (((ob >> 9) & 1) << 5)); }
__host__ __device__ __forceinline__ void stage_rc(int b, int& R, int& C) { const int st = b / 1024, sb = b % 1024, swz = sb ^ (((sb >> 9) & 1) << 5); R = (st >> 1) * 16 + swz / 64; C = (st & 1) * 32 + (swz % 64) / 2; }
__host__ __device__ __forceinline__ int perm32(int rho) { const int n = rho >> 4, i = rho & 15; return 8 * (i >> 2) + 4 * n + (i & 3); }

struct Unit { int pm, pn; };
struct Gemm { const bf16_t* A; const bf16_t* Bt; int M, N, K; int amode;
    __device__ __forceinline__ const char* abase(int pm) const { if (amode == 0) return (const char*)A + (size_t)pm * ((size_t)BM * K * 2);
        const int b = pm / 65, i = pm - 65 * b; return (const char*)A + ((long)b * 16384 + 254 * i - 2) * ((long)K * 2); } };

struct StaticOrder {
    int nM, nN, nwg, G, c;
    __host__ __device__ void init(int M, int N, int G_, int c_) { nM = M / BM; nN = N / BM; nwg = nM * nN; G = G_; c = c_; }
    __host__ __device__ bool next(int i, Unit& u) const {
        const long L = (long)i * G + c; if (L >= nwg) return false;
        int wgid = (int)L; { const int q = nwg / NXCD, r = nwg % NXCD, xcd = wgid % NXCD, off = wgid / NXCD; wgid = (xcd < r ? xcd * (q + 1) : r * (q + 1) + (xcd - r) * q) + off; }
        const int nig = WGM * nN, gid = wgid / nig, fm = gid * WGM, gsz = (nM - fm) < WGM ? (nM - fm) : WGM;
        u.pm = fm + ((wgid % nig) % gsz); u.pn = (wgid % nig) / gsz; return true;
    }
    __device__ __forceinline__ void a_ready(const Unit&) const {}
    __device__ __forceinline__ void done(const Unit&) const {}
};

__device__ __forceinline__ unsigned cvt_pk_bf16(float lo, float hi) { unsigned r; asm volatile("v_cvt_pk_bf16_f32 %0, %1, %2" : "=v"(r) : "v"(lo), "v"(hi)); return r; }
typedef float f32x2 __attribute__((ext_vector_type(2)));
__device__ __forceinline__ f32x2 gelu_pk(f32x2 v) {
    const f32x2 av = __builtin_elementwise_abs(v), d = av * 0.2316418882f + 1.0f;
    f32x2 t; t.x = __builtin_amdgcn_rcpf(d.x); t.y = __builtin_amdgcn_rcpf(d.y);
    f32x2 q = t * 0.5307027145f + (-0.7265760135f); q = q * t + 0.7107068705f; q = q * t + (-0.142248368f); q = q * t + 0.127414796f; q = q * t;
    const f32x2 s = (v * v) * (-0.72134752044f);
    f32x2 e; e.x = __builtin_amdgcn_exp2f(s.x); e.y = __builtin_amdgcn_exp2f(s.y);
    const f32x2 m = v * (q * e), r = v - m;
    f32x2 o; o.x = v.x < 0.f ? m.x : r.x; o.y = v.y < 0.f ? m.y : r.y; return o;
}

template <int ACT  > struct EpiBf16 {
    static constexpr bool PERM = true, AFTER_DRAIN = false; static_assert(ACT == 0 || ACT == 1, "EpiBf16: ACT is 0 (none) or 1 (gelu_pk)");
    bf16_t* O; int ldc; const float* bias; int split_cols; size_t split_stride; float scale0;
    __device__ __forceinline__ void operator()(const f32x4 (&acc)[2][2][4][2], const Unit& u, int wr, int wc, int fr, int fq) const {
        const int row0 = u.pm * BM + wr * 64 + fr; int colt = u.pn * BM; bf16_t* base = O;
        float sc = 1.f; if (split_cols) { const int t = colt / split_cols; base += (size_t)t * split_stride; colt -= t * split_cols; if (t == 0) sc = scale0; }
        const int col0 = colt + wc * 32 + 8 * fq, bcol0 = u.pn * BM + wc * 32 + 8 * fq;
        f32x4 bv[2][2];
#pragma unroll
        for (int bj = 0; bj < 2; ++bj)
#pragma unroll
            for (int n = 0; n < 2; ++n) bv[bj][n] = bias ? *(const f32x4*)(bias + bcol0 + bj * HALF + 4 * n) : (f32x4){0.f, 0.f, 0.f, 0.f};
#pragma unroll
        for (int ai = 0; ai < 2; ++ai)
#pragma unroll
            for (int m = 0; m < 4; ++m) { bf16_t* rowp = base + (size_t)(row0 + ai * HALF + m * 16) * ldc + col0;
#pragma unroll
                for (int bj = 0; bj < 2; ++bj) { f32x4 v0 = acc[ai][bj][m][0] + bv[bj][0], v1 = acc[ai][bj][m][1] + bv[bj][1];
                    if (ACT == 1) { f32x2 a = gelu_pk((f32x2){v0[0], v0[1]}), b = gelu_pk((f32x2){v0[2], v0[3]}), c = gelu_pk((f32x2){v1[0], v1[1]}), d = gelu_pk((f32x2){v1[2], v1[3]});
                        v0 = (f32x4){a.x, a.y, b.x, b.y}; v1 = (f32x4){c.x, c.y, d.x, d.y}; }
                    v0 = v0 * sc; v1 = v1 * sc; u32x4 w; w.x = cvt_pk_bf16(v0[0], v0[1]); w.y = cvt_pk_bf16(v0[2], v0[3]); w.z = cvt_pk_bf16(v1[0], v1[1]); w.w = cvt_pk_bf16(v1[2], v1[3]);
                    *(u32x4*)(rowp + bj * HALF) = w; } }
    }
};
template <class Epi, class Sched, bool ALIGN_EPI = false, bool SP2 = false>
__device__ __forceinline__ void gemm_phase(PG8_LAS unsigned char* lds, const Gemm g, const Sched& S, const Epi& E) {
    const int tid = threadIdx.x, wid = __builtin_amdgcn_readfirstlane(tid >> 6), lane = tid & 63, wr = wid >> 2, wc = wid & 3, fr = lane & 15, fq = lane >> 4;
    const int K = g.K, nt = K / BK;
    unsigned voffA[2], voffB[2];
#pragma unroll
    for (int i = 0; i < 2; ++i) { int R, C; stage_rc(tid * 16 + i * 8192, R, C); const int Rb = Epi::PERM ? ((R & ~31) + perm32(R & 31)) : R;
        voffA[i] = (unsigned)(R * K + C) * 2u; voffB[i] = (unsigned)(Rb * K + C) * 2u; }
    const size_t kstep = (size_t)(BK * 2);
    const size_t hstep = (size_t)HALF * K * 2;
    const size_t tstep = 2 * hstep;
    const unsigned ldsw = (unsigned)wid * 1024u;
    const int aoff = lds_byte(wr * 64 + fr, fq * 8), boff = lds_byte(wc * 32 + fr, fq * 8);
#define PG8_SA(b, h) (((b) * 2 + (h)) * HTB)
#define PG8_SB(b, h) ((4 + (b) * 2 + (h)) * HTB)
#define PG8_STAGE(bufoff, gbase, voff) do { _Pragma("unroll") for (int _i = 0; _i < 2; ++_i) \
        __builtin_amdgcn_global_load_lds((const unsigned*)((const char*)(gbase) + (voff)[_i]), (PG8_LAS unsigned*)(lds + (bufoff) + ldsw + _i * 8192), 16, 0, 0); } while (0)
#define PG8_LDA(dst, b, h) do { _Pragma("unroll") for (int m = 0; m < 4; ++m) _Pragma("unroll") for (int k = 0; k < 2; ++k) dst[m][k] = *(const PG8_LAS bf16x8*)(lds + PG8_SA(b, h) + aoff + m * 2048 + k * 1024); } while (0)
#define PG8_LDB(dst, b, h) do { _Pragma("unroll") for (int n = 0; n < 2; ++n) _Pragma("unroll") for (int k = 0; k < 2; ++k) dst[n][k] = *(const PG8_LAS bf16x8*)(lds + PG8_SB(b, h) + boff + n * 2048 + k * 1024); } while (0)
#define PG8_MMA(ai, bj, At, Bt) do { __builtin_amdgcn_s_setprio(1); _Pragma("unroll") for (int m = 0; m < 4; ++m) _Pragma("unroll") for (int n = 0; n < 2; ++n) _Pragma("unroll") for (int k = 0; k < 2; ++k) \
        acc[ai][bj][m][n] = __builtin_amdgcn_mfma_f32_16x16x32_bf16(Bt[n][k], At[m][k], acc[ai][bj][m][n], 0, 0, 0); __builtin_amdgcn_s_setprio(0); } while (0)
#define PG8_WAIT_V(n) asm volatile("s_waitcnt vmcnt(" #n ")" ::: "memory")
#define PG8_WAIT_L(n) asm volatile("s_waitcnt lgkmcnt(" #n ")" ::: "memory")
#define PG8_BAR __builtin_amdgcn_s_barrier()
#define PG8_SCHED __builtin_amdgcn_sched_barrier(0)
    Unit cur, nxt; int ui = 0;
    if (!S.next(0, cur)) return;
    f32x4 acc[2][2][4][2];
#pragma unroll
    for (int a = 0; a < 2; ++a)
#pragma unroll
        for (int b = 0; b < 2; ++b)
#pragma unroll
            for (int m = 0; m < 4; ++m)
#pragma unroll
                for (int n = 0; n < 2; ++n) acc[a][b][m][n] = (f32x4){0.f, 0.f, 0.f, 0.f};
    bf16x8 At[4][2], B0[2][2], B1[2][2];
    const char* cA = g.abase(cur.pm); const char* cB = (const char*)g.Bt + (size_t)cur.pn * tstep;
    S.a_ready(cur);
    if constexpr (SP2) {
        PG8_STAGE(PG8_SB(0, 0), cB, voffB); PG8_STAGE(PG8_SB(0, 1), cB + hstep, voffB); PG8_STAGE(PG8_SA(0, 0), cA, voffA); PG8_STAGE(PG8_SA(0, 1), cA + hstep, voffA);
        if (wr == 1) PG8_BAR;
        PG8_WAIT_V(2); PG8_BAR;
        PG8_STAGE(PG8_SB(1, 0), cB + kstep, voffB); PG8_STAGE(PG8_SA(1, 0), cA + kstep, voffA); PG8_STAGE(PG8_SB(1, 1), cB + hstep + kstep, voffB);
        PG8_WAIT_V(6); PG8_BAR;
    } else {
        PG8_STAGE(PG8_SB(0, 0), cB, voffB); PG8_STAGE(PG8_SA(0, 0), cA, voffA); PG8_STAGE(PG8_SB(0, 1), cB + hstep, voffB); PG8_STAGE(PG8_SA(0, 1), cA + hstep, voffA);
        if (wr == 1) PG8_BAR;
        PG8_WAIT_V(4); PG8_BAR;
        PG8_STAGE(PG8_SB(1, 0), cB + kstep, voffB); PG8_STAGE(PG8_SA(1, 0), cA + kstep, voffA); PG8_STAGE(PG8_SB(1, 1), cB + hstep + kstep, voffB);
        PG8_WAIT_V(6); PG8_BAR;
    }
    for (;;) {
        const bool has_next = S.next(ui + 1, nxt);
        const char* nA = has_next ? g.abase(nxt.pm) : cA; const char* nB = has_next ? (const char*)g.Bt + (size_t)nxt.pn * tstep : cB;
        for (int t = 0; t < nt; t += 2) {
            const bool last = (t == nt - 2);
            const char* a1 = cA + (size_t)(t + 1) * kstep;
            const char* a2 = last ? nA : cA + (size_t)(t + 2) * kstep; const char* b2 = last ? nB : cB + (size_t)(t + 2) * kstep;
            const char* a3 = a2 + kstep; const char* b3 = b2 + kstep;
            if (last && has_next) S.a_ready(nxt);
            if constexpr (SP2) {
            PG8_LDB(B0, 0, 0); PG8_LDB(B1, 0, 1); PG8_SCHED; PG8_LDA(At, 0, 0); PG8_STAGE(PG8_SA(1, 1), a1 + hstep, voffA);
            PG8_WAIT_V(8); PG8_WAIT_L(0); PG8_BAR; PG8_MMA(0, 0, At, B0); PG8_MMA(0, 1, At, B1); PG8_BAR; PG8_SCHED;
            PG8_LDA(At, 0, 1); PG8_STAGE(PG8_SB(0, 0), b2, voffB); PG8_STAGE(PG8_SB(0, 1), b2 + hstep, voffB); PG8_STAGE(PG8_SA(0, 0), a2, voffA);
            PG8_WAIT_V(8); PG8_WAIT_L(0); PG8_BAR; PG8_MMA(1, 0, At, B0); PG8_MMA(1, 1, At, B1); PG8_BAR; PG8_SCHED;
            PG8_LDB(B0, 1, 0); PG8_LDB(B1, 1, 1); PG8_SCHED; PG8_LDA(At, 1, 0); PG8_STAGE(PG8_SA(0, 1), a2 + hstep, voffA);
            PG8_WAIT_V(8); PG8_WAIT_L(0); PG8_BAR; PG8_MMA(0, 0, At, B0); PG8_MMA(0, 1, At, B1); PG8_BAR; PG8_SCHED;
            PG8_LDA(At, 1, 1); PG8_STAGE(PG8_SB(1, 0), b3, voffB); PG8_STAGE(PG8_SB(1, 1), b3 + hstep, voffB); PG8_STAGE(PG8_SA(1, 0), a3, voffA);
            PG8_WAIT_V(8); PG8_WAIT_L(0); PG8_BAR; PG8_MMA(1, 0, At, B0); PG8_MMA(1, 1, At, B1); PG8_BAR; PG8_SCHED;
            } else {
            PG8_LDB(B0, 0, 0); PG8_SCHED; PG8_LDA(At, 0, 0); PG8_STAGE(PG8_SA(1, 1), a1 + hstep, voffA);
            PG8_WAIT_L(8); PG8_BAR; PG8_WAIT_L(0); PG8_MMA(0, 0, At, B0); PG8_BAR; PG8_SCHED;
            PG8_LDB(B1, 0, 1); PG8_STAGE(PG8_SB(0, 0), b2, voffB);
            PG8_BAR; PG8_WAIT_L(0); PG8_MMA(0, 1, At, B1); PG8_BAR;
            PG8_LDA(At, 0, 1); PG8_STAGE(PG8_SA(0, 0), a2, voffA);
            PG8_BAR; PG8_WAIT_L(0); PG8_MMA(1, 0, At, B0); PG8_BAR; PG8_SCHED;
            PG8_STAGE(PG8_SB(0, 1), b2 + hstep, voffB);
            PG8_WAIT_V(6); PG8_BAR; PG8_MMA(1, 1, At, B1); PG8_BAR;
            PG8_LDB(B0, 1, 0); PG8_SCHED; PG8_LDA(At, 1, 0); PG8_STAGE(PG8_SA(0, 1), a2 + hstep, voffA);
            PG8_WAIT_L(8); PG8_BAR; PG8_WAIT_L(0); PG8_MMA(0, 0, At, B0); PG8_BAR; PG8_SCHED;
            PG8_LDB(B1, 1, 1); PG8_STAGE(PG8_SB(1, 0), b3, voffB);
            PG8_BAR; PG8_WAIT_L(0); PG8_MMA(0, 1, At, B1); PG8_BAR;
            PG8_LDA(At, 1, 1); PG8_STAGE(PG8_SA(1, 0), a3, voffA);
            PG8_BAR; PG8_WAIT_L(0); PG8_MMA(1, 0, At, B0); PG8_BAR; PG8_SCHED;
            PG8_STAGE(PG8_SB(1, 1), b3 + hstep, voffB);
            PG8_WAIT_V(6); PG8_BAR; PG8_MMA(1, 1, At, B1); PG8_BAR;
            }
        }
        if constexpr (ALIGN_EPI) { if (wr == 0) PG8_BAR; }
        if constexpr (!Epi::AFTER_DRAIN) { E(acc, cur, wr, wc, fr, fq); S.done(cur); }
        if (!has_next) break;
#pragma unroll
        for (int a = 0; a < 2; ++a)
#pragma unroll
            for (int b = 0; b < 2; ++b)
#pragma unroll
                for (int m = 0; m < 4; ++m)
#pragma unroll
                    for (int n = 0; n < 2; ++n) acc[a][b][m][n] = (f32x4){0.f, 0.f, 0.f, 0.f};
        cur = nxt; cA = nA; cB = nB; ++ui;
        if constexpr (ALIGN_EPI) { if (wr == 1) PG8_BAR; }
    }
    PG8_WAIT_V(0);
    if constexpr (!ALIGN_EPI) { if (wr == 0) PG8_BAR; }
    PG8_BAR;
    if constexpr (Epi::AFTER_DRAIN) { E.fused(acc, cur, wr, wc, fr, fq, lds, wid, lane); S.done(cur); }
#undef PG8_SA
#undef PG8_SB
#undef PG8_STAGE
#undef PG8_LDA
#undef PG8_LDB
#undef PG8_MMA
#undef PG8_WAIT_V
#undef PG8_WAIT_L
#undef PG8_BAR
#undef PG8_SCHED
}
}

#ifndef PG8_SP2
#define PG8_SP2 true
#endif
#ifndef PG8_ALIGN
#define PG8_ALIGN true
#endif
#define GAS __attribute__((address_space(1)))
#define LAS __attribute__((address_space(3)))
typedef unsigned short bf16;
typedef unsigned v4u __attribute__((ext_vector_type(4)));
typedef float f32x4 __attribute__((ext_vector_type(4)));
typedef short bf16x8 __attribute__((ext_vector_type(8)));
typedef GAS unsigned gu32;
typedef GAS unsigned long long gu64;
#define RLX_AGENT __ATOMIC_RELAXED, __HIP_MEMORY_SCOPE_AGENT
#define LDS_WAIT() asm volatile("s_waitcnt lgkmcnt(0)" ::: "memory")
#define VM_WAIT() asm volatile("s_waitcnt vmcnt(0)" ::: "memory")
__device__ __forceinline__ unsigned long long rt() { return __builtin_amdgcn_s_memrealtime(); }
__device__ __forceinline__ unsigned f2bf(float f) { unsigned u = __builtin_bit_cast(unsigned, f); return (u + 0x7fffu + ((u >> 16) & 1u)) >> 16; }
__device__ __forceinline__ unsigned pk2(float lo, float hi) { return f2bf(lo) | (f2bf(hi) << 16); }

#define XB_TMO      128
#define XB_XCNT(j)  (256  + 64 * (j))
#define XB_XSUB(j)  (1280 + 64 * (j))
#define XB_XGEN(j)  (2304 + 64 * (j))
#define XB_TOP      3328
#define XB_TOPGEN   3392
#define XCD_BAR_WORDS 3456
#define XB_SPIN_CAP (1u << 18)

__device__ __forceinline__ unsigned xb_ld(unsigned* p)              { return __hip_atomic_load(p, __ATOMIC_RELAXED, __HIP_MEMORY_SCOPE_AGENT); }
__device__ __forceinline__ unsigned xb_add(unsigned* p, unsigned v) { return __hip_atomic_fetch_add(p, v, __ATOMIC_RELAXED, __HIP_MEMORY_SCOPE_AGENT); }
__device__ __forceinline__ unsigned xb_xcc_id() { return (unsigned)__builtin_amdgcn_s_getreg((3 << 11) | 20) & 0xFu; }
#define XB_SPIN(cond, bar) do { unsigned _sp = 0; while (cond) { __builtin_amdgcn_s_sleep(1); \
    if ((++_sp & 255u) == 0u) { if (xb_ld(&(bar)[XB_TMO])) break; if (_sp > XB_SPIN_CAP) { atomicAdd(&(bar)[XB_TMO], 1u); break; } } } } while (0)

struct XcdBarrier {
    unsigned* bar; unsigned x;
    volatile LAS unsigned* st;
};

__device__ __forceinline__ XcdBarrier xcd_barrier_post(unsigned* bar, volatile LAS unsigned* st) {
    XcdBarrier b; b.bar = bar; b.x = xb_xcc_id(); b.st = st;
    if (threadIdx.x == 0) (void)xb_add(&bar[XB_XCNT(b.x)], 1u);
    return b;
}
__device__ __forceinline__ void xcd_barrier_complete(unsigned* bar, unsigned x, unsigned& nloc, unsigned& nx) {
    const unsigned G = gridDim.x * gridDim.y * gridDim.z;
    unsigned sum, cnt, mine, sp = 0u;
    for (;;) {
        sum = 0u; cnt = 0u; mine = 0u;
#pragma unroll
        for (unsigned j = 0; j < 16; ++j) { const unsigned c = xb_ld(&bar[XB_XCNT(j)]); sum += c; cnt += (c > 0u) ? 1u : 0u; mine = (j == x) ? c : mine; }
        if (sum == G) break;
        __builtin_amdgcn_s_sleep(1);
        if ((++sp & 255u) == 0u) { if (xb_ld(&bar[XB_TMO])) break; if (sp > XB_SPIN_CAP) { atomicAdd(&bar[XB_TMO], 1u); break; } }
    }
    nloc = mine > 0u ? mine : 1u; nx = cnt > 0u ? cnt : 1u;
}

__device__ __forceinline__ void xcd_barrier(const XcdBarrier& b) {
    asm volatile("s_waitcnt vmcnt(0)" ::: "memory");
    __syncthreads();
    if (threadIdx.x == 0) {
        unsigned* bar = b.bar;
        __builtin_amdgcn_s_waitcnt(0);
        unsigned nloc = b.st[0], nx = b.st[1];
        if (nloc == 0u) { xcd_barrier_complete(bar, b.x, nloc, nx); b.st[0] = nloc; b.st[1] = nx; }
        const unsigned old = xb_add(&bar[XB_XSUB(b.x)], 1u);
        const unsigned gen = old / nloc;
        if (old + 1u == (gen + 1u) * nloc) {
            __builtin_amdgcn_fence(__ATOMIC_RELEASE, "agent");
            asm volatile("s_waitcnt vmcnt(0)" ::: "memory");
            const unsigned og = xb_add(&bar[XB_TOP], 1u);
            const unsigned tg = og / nx;
            if (og + 1u == (tg + 1u) * nx) xb_add(&bar[XB_TOPGEN], 1u);
            else XB_SPIN(xb_ld(&bar[XB_TOPGEN]) == tg, bar);
            __builtin_amdgcn_fence(__ATOMIC_ACQUIRE, "agent");
            xb_add(&bar[XB_XGEN(b.x)], 1u);
            asm volatile("s_waitcnt vmcnt(0)" ::: "memory");
        } else {
            XB_SPIN(xb_ld(&bar[XB_XGEN(b.x)]) == gen, bar);
            __builtin_amdgcn_fence(__ATOMIC_ACQUIRE, "agent");
            asm volatile("s_waitcnt vmcnt(0)" ::: "memory");
        }
    }
    __syncthreads();
}

constexpr int BATCH = 2, SEQ = 16384, DM = 1024, TT = BATCH * SEQ, NPROJ = 3584, DFF = 2816, NUP = 2 * DFF, NPANEL = TT / 256;
constexpr int NH = 8, HD = 64, HW = 512;
constexpr float EPS = 1e-6f;
#ifndef MK_DUP
#define MK_DUP 0
#endif
#ifndef MK_ONE_LAUNCH
#define MK_ONE_LAUNCH 0
#endif

constexpr size_t MiB = 1u << 20;
constexpr size_t WS_CTL = 0, CTL_ZERO_BYTES = 1 * MiB;
constexpr size_t WS_WIN = 1 * MiB, WS_WOUT = 8 * MiB, WS_WUP = 10 * MiB, WS_WDN = 21 * MiB;
constexpr size_t WS_CS = 27 * MiB;
constexpr size_t WS_SMALL = 31 * MiB;
constexpr size_t SM_BIASD = 0, SM_DPOS = 8192, SM_DNEG = 16384, SM_GAM = 24576, SM_G256 = 24576 + 64;
constexpr size_t WS_KMS = 32 * MiB;
constexpr size_t WS_ROWSS = 33 * MiB;
constexpr size_t WS_SEL = 35 * MiB;
constexpr size_t WS_RUNS = 36 * MiB, WS_CNTW = 38 * MiB;
constexpr size_t WS_KV = 40 * MiB, WS_RP = 56 * MiB;
constexpr size_t WS_XN = 72 * MiB;
constexpr size_t WS_PROJ = 136 * MiB;
constexpr size_t PROJ_SEG = (size_t)TT * 512 * 2;
constexpr size_t WS_Y = 360 * MiB;
constexpr size_t WS_Y1 = 136 * MiB;
constexpr size_t WS_U = 136 * MiB;
constexpr size_t WS_F = 312 * MiB;
constexpr size_t WS_PO01 = 72 * MiB, WS_PO23 = 424 * MiB, PO_SLOT = (size_t)TT * 512 * 2;
constexpr size_t WS_ML = 488 * MiB;
constexpr size_t WS_END = 496 * MiB;
constexpr int CW_TOT = 49152;
constexpr int CW_Q = 8192;
constexpr int CW_BAR = 4096;

typedef unsigned u32x4v __attribute__((ext_vector_type(4)));
typedef unsigned u32x2v __attribute__((ext_vector_type(2)));

__device__ __forceinline__ float bflo(unsigned w) { return __uint_as_float(w << 16); }
__device__ __forceinline__ float bfhi(unsigned w) { return __uint_as_float(w & 0xffff0000u); }
__device__ __forceinline__ float bf1(bf16 b) { return __uint_as_float((unsigned)b << 16); }

namespace pg8 {
struct EpiProj {
    static constexpr bool PERM = true, AFTER_DRAIN = false;
    bf16_t* proj; const float* cs; const float* dpos; const float* dneg; float* kms;
    __device__ __forceinline__ void operator()(const f32x4 (&acc)[2][2][4][2], const Unit& u, int wr, int wc, int fr, int fq) const {
        const int seg = u.pn >> 1, cb = (u.pn & 1) * 256;
        bf16_t* base = proj + (size_t)seg * ((size_t)TT * 512);
        const int row0 = u.pm * BM + wr * 64 + fr, colw = cb + wc * 32 + 8 * fq;
        if (seg == 3 || seg == 4) {
            const int i0 = 16 * (wc & 1) + 4 * fq;
#pragma unroll
            for (int ai = 0; ai < 2; ++ai)
#pragma unroll
                for (int m = 0; m < 4; ++m) {
                    const int row = row0 + ai * HALF + m * 16, t = row & (SEQ - 1), tl = t & 255;
                    const f32x4 c01 = *(const f32x4*)(cs + ((size_t)t * 32 + i0) * 2), c23 = *(const f32x4*)(cs + ((size_t)t * 32 + i0) * 2 + 4);
                    bf16_t* rowp = base + (size_t)row * 512 + colw;
#pragma unroll
                    for (int bj = 0; bj < 2; ++bj) {
                        const int head = (cb >> 6) + bj * 2 + (wc >> 1);
                        const float ds = (seg == 3) ? dpos[head * 256 + tl] : 0.125f * dneg[head * 256 + tl];
                        const f32x4 v0 = acc[ai][bj][m][0], v1 = acc[ai][bj][m][1];
                        u32x4 w;
                        w.x = cvt_pk_bf16((v0[0] * c01[0] - v0[1] * c01[1]) * ds, (v0[0] * c01[1] + v0[1] * c01[0]) * ds);
                        w.y = cvt_pk_bf16((v0[2] * c01[2] - v0[3] * c01[3]) * ds, (v0[2] * c01[3] + v0[3] * c01[2]) * ds);
                        w.z = cvt_pk_bf16((v1[0] * c23[0] - v1[1] * c23[1]) * ds, (v1[0] * c23[1] + v1[1] * c23[0]) * ds);
                        w.w = cvt_pk_bf16((v1[2] * c23[2] - v1[3] * c23[3]) * ds, (v1[2] * c23[3] + v1[3] * c23[2]) * ds);
                        *(u32x4*)(rowp + bj * HALF) = w;
                    }
                }
        } else {
            const float sc = (seg == 0) ? 0.18033688011112042f : 1.0f;
#pragma unroll
            for (int ai = 0; ai < 2; ++ai)
#pragma unroll
                for (int m = 0; m < 4; ++m) {
                    bf16_t* rowp = base + (size_t)(row0 + ai * HALF + m * 16) * 512 + colw;
#pragma unroll
                    for (int bj = 0; bj < 2; ++bj) {
                        const f32x4 v0 = acc[ai][bj][m][0] * sc, v1 = acc[ai][bj][m][1] * sc;
                        u32x4 w; w.x = cvt_pk_bf16(v0[0], v0[1]); w.y = cvt_pk_bf16(v0[2], v0[3]); w.z = cvt_pk_bf16(v1[0], v1[1]); w.w = cvt_pk_bf16(v1[2], v1[3]);
                        *(u32x4*)(rowp + bj * HALF) = w;
                    }
                }
            if (seg == 1) {
#pragma unroll
                for (int bj = 0; bj < 2; ++bj)
#pragma unroll
                    for (int n = 0; n < 2; ++n) {
                        f32x4 s = acc[0][bj][0][n];
#pragma unroll
                        for (int m = 1; m < 4; ++m) s += acc[0][bj][m][n];
#pragma unroll
                        for (int m = 0; m < 4; ++m) s += acc[1][bj][m][n];
#pragma unroll
                        for (int o = 1; o < 16; o <<= 1) { s[0] += __shfl_xor(s[0], o); s[1] += __shfl_xor(s[1], o); s[2] += __shfl_xor(s[2], o); s[3] += __shfl_xor(s[3], o); }
                        if (fr == 0) *(f32x4*)(kms + ((size_t)wr * NPANEL + u.pm) * 512 + colw + bj * HALF + 4 * n) = s;
                    }
            }
        }
    }
};
struct EpiY {
    static constexpr bool PERM = true, AFTER_DRAIN = false;
    bf16_t* Y; float* rowss;
    __device__ __forceinline__ void operator()(const f32x4 (&acc)[2][2][4][2], const Unit& u, int wr, int wc, int fr, int fq) const {
        const int row0 = u.pm * BM + wr * 64 + fr, colw = u.pn * BM + wc * 32 + 8 * fq;
#pragma unroll
        for (int ai = 0; ai < 2; ++ai)
#pragma unroll
            for (int m = 0; m < 4; ++m) {
                const int row = row0 + ai * HALF + m * 16;
                bf16_t* rowp = Y + (size_t)row * 1024 + colw; float ss = 0.f;
#pragma unroll
                for (int bj = 0; bj < 2; ++bj) {
                    const f32x4 v0 = acc[ai][bj][m][0], v1 = acc[ai][bj][m][1];
                    ss += (v0[0] * v0[0] + v0[1] * v0[1]) + (v0[2] * v0[2] + v0[3] * v0[3]) + (v1[0] * v1[0] + v1[1] * v1[1]) + (v1[2] * v1[2] + v1[3] * v1[3]);
                    u32x4 w; w.x = cvt_pk_bf16(v0[0], v0[1]); w.y = cvt_pk_bf16(v0[2], v0[3]); w.z = cvt_pk_bf16(v1[0], v1[1]); w.w = cvt_pk_bf16(v1[2], v1[3]);
                    *(u32x4*)(rowp + bj * HALF) = w;
                }
                ss += __shfl_xor(ss, 16); ss += __shfl_xor(ss, 32);
                if (fq == 0) rowss[(size_t)row * 16 + u.pn * 4 + wc] = ss;
            }
    }
};
struct EpiFfn {
    static constexpr bool PERM = true, AFTER_DRAIN = false;
    bf16_t* Fo; const float* cw; const float* cb; PG8_LAS float* xch;
    __device__ __forceinline__ void operator()(const f32x4 (&acc)[2][2][4][2], const Unit& u, int wr, int wc, int fr, int fq) const {
        const int b = u.pm / 65, i = u.pm - 65 * b, t0 = 254 * i - 2, lane = fr + 16 * fq;
        if (fr >= 14) {
#pragma unroll
            for (int ai = 0; ai < 2; ++ai) { PG8_LAS f32x4* d = (PG8_LAS f32x4*)(xch + ((((wr * 4 + wc) * 2 + ai) * 2 + (fr - 14)) * 4 + fq) * 16);
                d[0] = acc[ai][0][3][0]; d[1] = acc[ai][0][3][1]; d[2] = acc[ai][1][3][0]; d[3] = acc[ai][1][3][1]; }
        }
        asm volatile("s_waitcnt lgkmcnt(0)\n\ts_barrier" ::: "memory");
        const int c0 = u.pn * 128 + wc * 32 + 8 * fq;
        const int a1 = ((lane & 48) | ((fr + 15) & 15)) * 4, a2 = ((lane & 48) | ((fr + 14) & 15)) * 4;
        const f32x4 z4 = {0.f, 0.f, 0.f, 0.f};
#pragma unroll
        for (int n = 0; n < 2; ++n) {
            f32x4 w[3][2], bs[2];
#pragma unroll
            for (int bj = 0; bj < 2; ++bj) { bs[bj] = *(const f32x4*)(cb + bj * DFF + c0 + 4 * n);
#pragma unroll
                for (int j = 0; j < 3; ++j) w[j][bj] = *(const f32x4*)(cw + (size_t)j * NUP + bj * DFF + c0 + 4 * n); }
#pragma unroll
            for (int ai = 0; ai < 2; ++ai) {
                f32x4 r1[2], r2[2];
                { const bool has = (wr == 1) || (ai == 1); const int sw = (wr == 1) ? wc : 4 + wc, sa = (wr == 1) ? ai : 0;
                  const PG8_LAS f32x4* s15 = (const PG8_LAS f32x4*)(xch + (((sw * 2 + sa) * 2 + 1) * 4 + fq) * 16); const PG8_LAS f32x4* s14 = (const PG8_LAS f32x4*)(xch + (((sw * 2 + sa) * 2 + 0) * 4 + fq) * 16);
#pragma unroll
                  for (int bj = 0; bj < 2; ++bj) { r1[bj] = has ? s15[bj * 2 + n] : z4; r2[bj] = has ? s14[bj * 2 + n] : z4; } }
#pragma unroll
                for (int m = 0; m < 4; ++m) {
                    f32x4 x[2];
#pragma unroll
                    for (int bj = 0; bj < 2; ++bj) {
                        f32x4 cur = acc[ai][bj][m][n];
                        if (m == 0 && ai == 0) { if (i == 0 && wr == 0 && fr < 2) cur = z4; }
                        f32x4 s1, s2;
#pragma unroll
                        for (int k = 0; k < 4; ++k) { s1[k] = __int_as_float(__builtin_amdgcn_ds_bpermute(a1, __float_as_int(cur[k]))); s2[k] = __int_as_float(__builtin_amdgcn_ds_bpermute(a2, __float_as_int(cur[k]))); }
                        f32x4 p1, p2;
                        if (m == 0) { p1 = fr == 0 ? r1[bj] : s1; p2 = fr == 0 ? r2[bj] : (fr == 1 ? r1[bj] : s2); }
                        else { p1 = fr == 0 ? r1[bj] : s1; p2 = fr < 2 ? r2[bj] : s2; }
                        r1[bj] = s1; r2[bj] = s2;
                        x[bj] = bs[bj] + w[0][bj] * p2 + w[1][bj] * p1 + w[2][bj] * cur;
                    }
                    const int r = ai * HALF + wr * 64 + m * 16 + fr, t = t0 + r;
                    if (r >= 2 && t < 16384) {
                        unsigned o0, o1;
#define FFN_G(a, bv) ({ const float z_ = 0.7978845608028654f * ((a) + 0.044715f * (a) * (a) * (a)); (a) * (1.0f - 1.0f / (__expf(2.0f * z_) + 1.0f)) * (bv); })
                        o0 = cvt_pk_bf16(FFN_G(x[0][0], x[1][0]), FFN_G(x[0][1], x[1][1])); o1 = cvt_pk_bf16(FFN_G(x[0][2], x[1][2]), FFN_G(x[0][3], x[1][3]));
#undef FFN_G
                        typedef unsigned u32x2e __attribute__((ext_vector_type(2)));
                        *(u32x2e*)(Fo + ((size_t)b * 16384 + t) * DFF + c0 + 4 * n) = (u32x2e){o0, o1};
                    }
                }
            }
        }
    }
};
}

constexpr int RING_OFF = 0, RING_BYTES = 131072;
constexpr int LDSCTL_OFF = RING_BYTES, MISC_OFF = LDSCTL_OFF + 320;
constexpr int LDS_BYTES = 163840;
constexpr int XCH_OFF = 139264;
constexpr int NWAVES = 8;

struct Frame {
    LAS unsigned char* lds; volatile LAS unsigned* MISC; gu32* ctl;
    int tid, lane, wave, vcu, G;
    const float *x, *g_mix_pre, *w_in, *rel_bias, *w_out, *g_mix_post, *g_ffn_pre, *w_up, *conv_w, *conv_b, *w_down, *g_ffn_post;
    float* out;
    bf16 *Win_t, *Wout_t, *Wup_t, *Wdn_t, *XN, *PROJ, *Y, *Y1, *U, *Fb;
    float *cs, *biasd, *dpos, *dneg, *gam, *g256, *kms, *rowss, *KV, *RP;
    unsigned* sel; unsigned short* LISTG; bf16 *PO01, *PO23; float* ML;
};

__device__ __forceinline__ float wave_sum(float v) {
#pragma unroll
    for (int o = 1; o < 64; o <<= 1) v += __shfl_xor(v, o);
    return v;
}

template <int MODE> __device__ __forceinline__ int src_col(int n) {
    if (MODE == 2) return ((n >> 7) & 1) * DFF + (n >> 8) * 128 + (n & 127);
    if (MODE == 1) { const int seg = n >> 9; if (seg == 3 || seg == 4) { const int p = n & 63; return (n & ~63) + (p >> 1) + 32 * (p & 1); } }
    return n;
}
template <int MODE> __device__ __forceinline__ void p0_transpose_item(const float* W, const float* gain, int K, int N, bf16* WT, LAS float* scr, int item, int lane) {
    const int nblk = N / 32, kb = item / nblk, nb = item % nblk, k0 = 64 * kb, n0 = 32 * nb;
    const int sc = src_col<MODE>(n0 + (lane & 31));
#pragma unroll 8
    for (int i = 0; i < 32; ++i) { const int kk = 2 * i + (lane >> 5); const float g = gain ? gain[k0 + kk] : 1.0f; scr[kk * 33 + (lane & 31)] = W[(size_t)(k0 + kk) * N + sc] * g; }
    LDS_WAIT(); asm volatile("" ::: "memory");
    const int c = lane & 7;
#pragma unroll
    for (int j = 0; j < 4; ++j) { const int n = (lane >> 3) + 8 * j; const LAS float* s = scr + (8 * c) * 33 + n;
        v4u o; o.x = pk2(s[0 * 33], s[1 * 33]); o.y = pk2(s[2 * 33], s[3 * 33]); o.z = pk2(s[4 * 33], s[5 * 33]); o.w = pk2(s[6 * 33], s[7 * 33]);
        *(GAS v4u*)(WT + (size_t)(n0 + n) * K + k0 + 8 * c) = o; }
    LDS_WAIT(); asm volatile("" ::: "memory");
}
__device__ __forceinline__ int t5_bucket(int n) {
    if (n < 16) return n;
    int l = 16 + (int)(__logf((float)n * (1.0f / 16.0f)) / __logf(8.0f) * 16.0f);
    return l < 31 ? l : 31;
}
__device__ __forceinline__ void p0_prologue(Frame& F) {
    LAS float* scr = (LAS float*)(F.lds + RING_OFF + F.wave * 16384);
    const int gw = F.vcu * NWAVES + F.wave, NGW = F.G * NWAVES;
    constexpr int I_IN = (DM / 64) * (NPROJ / 32), I_OUT = (DM / 64) * (DM / 32), I_UP = (DM / 64) * (NUP / 32), I_DN = (DFF / 64) * (DM / 32);
    for (int it = gw; it < I_IN + I_OUT + I_UP + I_DN; it += NGW) {
        int r = it;
        if (r < I_IN) { p0_transpose_item<1>(F.w_in, F.g_mix_pre, DM, NPROJ, F.Win_t, scr, r, F.lane); continue; } r -= I_IN;
        if (r < I_OUT) { p0_transpose_item<0>(F.w_out, nullptr, DM, DM, F.Wout_t, scr, r, F.lane); continue; } r -= I_OUT;
        if (r < I_UP) { p0_transpose_item<2>(F.w_up, F.g_ffn_pre, DM, NUP, F.Wup_t, scr, r, F.lane); continue; } r -= I_UP;
        p0_transpose_item<0>(F.w_down, nullptr, DFF, DM, F.Wdn_t, scr, r, F.lane);
    }
    for (int m = gw; m < TT; m += NGW) {
        const GAS f32x4* xr = (const GAS f32x4*)(F.x + (size_t)m * DM) + F.lane;
        f32x4 v[4]; float s = 0.f;
#pragma unroll
        for (int j = 0; j < 4; ++j) { v[j] = xr[64 * j]; s += (v[j].x * v[j].x + v[j].y * v[j].y) + (v[j].z * v[j].z + v[j].w * v[j].w); }
        const float rstd = 1.0f / sqrtf(wave_sum(s) * (1.f / DM) + EPS);
        GAS unsigned long long* o8 = (GAS unsigned long long*)(F.XN + (size_t)m * DM) + F.lane;
#pragma unroll
        for (int j = 0; j < 4; ++j) o8[64 * j] = (unsigned long long)pk2(v[j].x * rstd, v[j].y * rstd) | ((unsigned long long)pk2(v[j].z * rstd, v[j].w * rstd) << 32);
    }
    const int gt = blockIdx.x * (NWAVES * 64) + F.tid, NT = F.G * NWAVES * 64;
    for (int i = gt; i < SEQ * 32; i += NT) {
        const int t = i >> 5, k = i & 31;
        double inv = 1.0; for (int q = 0; q < k; ++q) inv *= 0.74989420933245582730;
        const float ang = (float)t * (float)inv;
        const double rev = (double)ang * 0.15915494309189533577; const double fr = rev - __builtin_rint(rev);
        F.cs[2 * i] = __builtin_amdgcn_cosf((float)fr); F.cs[2 * i + 1] = __builtin_amdgcn_sinf((float)fr);
    }
    for (int i = gt; i < NH * 256; i += NT) {
        const int h = i >> 8, n = i & 255; const double g = 1.0 - 1.0 / (double)(32 << h);
        double p = 1.0; for (int q = 0; q < n; ++q) p *= g;
        F.dpos[i] = (float)p; F.dneg[i] = (float)(1.0 / p);
        if (n == 255) { F.gam[h] = (float)g; F.g256[h] = (float)(p * g); }
    }
    for (int i = gt; i < NH * 132; i += NT) { const int h = i / 132, d = i % 132; F.biasd[i] = F.rel_bias[t5_bucket(d < 128 ? d : 128) * NH + h]; }
}

__device__ __forceinline__ void p2_gate(Frame& F) {
    LAS float* km = (LAS float*)(F.lds + RING_OFF);
    LAS int* hist = (LAS int*)(F.lds + RING_OFF + 16384);
    const bf16* QA = F.PROJ;
    for (int it = blockIdx.x; it < 512; it += F.G) {
        const int cp = it < 256 ? 31 - (it & 31) : (it & 31), bh = it >> 5, b = bh >> 3, h = bh & 7, c0 = 2 * cp, nj = c0 + 1;
        __syncthreads();
        if (F.tid < 384) hist[F.tid] = 0;
        for (int i = F.tid; i < nj * 64; i += NWAVES * 64) { const int j = i >> 6, d = i & 63; const size_t o = (size_t)(b * 64 + j) * 512 + h * 64 + d;
            km[i] = (F.kms[o] + F.kms[(size_t)NPANEL * 512 + o]) * (1.0f / 256.0f); }
        __syncthreads();
        const int t = c0 * 256 + F.tid, c = t >> 8; const size_t row = (size_t)b * SEQ + t;
        float q[64];
        { const GAS u32x4v* qp = (const GAS u32x4v*)(QA + row * 512 + h * 64);
#pragma unroll
          for (int i = 0; i < 8; ++i) { const u32x4v w = qp[i]; q[8 * i] = bflo(w.x); q[8 * i + 1] = bfhi(w.x); q[8 * i + 2] = bflo(w.y); q[8 * i + 3] = bfhi(w.y); q[8 * i + 4] = bflo(w.z); q[8 * i + 5] = bfhi(w.z); q[8 * i + 6] = bflo(w.w); q[8 * i + 7] = bfhi(w.w); } }
        float v0 = -INFINITY, v1 = -INFINITY, v2 = -INFINITY; unsigned i0 = 255u, i1 = 255u, i2 = 255u;
        for (int j = 0; j < c; ++j) {
            const LAS f32x4* kp = (const LAS f32x4*)(km + j * 64); float g = 0.f;
#pragma unroll
            for (int i = 0; i < 16; ++i) { const f32x4 k4 = kp[i]; g += q[4 * i] * k4.x + q[4 * i + 1] * k4.y + q[4 * i + 2] * k4.z + q[4 * i + 3] * k4.w; }
            if (g > v0) { v2 = v1; i2 = i1; v1 = v0; i1 = i0; v0 = g; i0 = (unsigned)j; }
            else if (g > v1) { v2 = v1; i2 = i1; v1 = g; i1 = (unsigned)j; }
            else if (g > v2) { v2 = g; i2 = (unsigned)j; }
        }
        F.sel[row * 8 + h] = i0 | (i1 << 8) | (i2 << 16);
        const int half = F.tid >> 8, tl = F.tid & 255;
        if (i0 != 255u) atomicAdd((int*)&hist[half * 64 + i0], 1);
        if (i1 != 255u) atomicAdd((int*)&hist[half * 64 + i1], 1);
        if (i2 != 255u) atomicAdd((int*)&hist[half * 64 + i2], 1);
        __syncthreads();
        if (F.tid < 128) { const int v = hist[F.tid];
            hist[128 + F.tid] = v ? (int)__hip_atomic_fetch_add(F.ctl + CW_TOT + bh * 64 + (F.tid & 63), (unsigned)v, RLX_AGENT) : 0; }
        __syncthreads();
        unsigned short* lg = F.LISTG + (size_t)bh * 64 * 16384; const unsigned ent = ((unsigned)c << 10) | (unsigned)tl;
        if (i0 != 255u) lg[(size_t)i0 * 16384 + hist[128 + half * 64 + i0] + atomicAdd((int*)&hist[256 + half * 64 + i0], 1)] = (unsigned short)(ent);
        if (i1 != 255u) lg[(size_t)i1 * 16384 + hist[128 + half * 64 + i1] + atomicAdd((int*)&hist[256 + half * 64 + i1], 1)] = (unsigned short)(ent | 256u);
        if (i2 != 255u) lg[(size_t)i2 * 16384 + hist[128 + half * 64 + i2] + atomicAdd((int*)&hist[256 + half * 64 + i2], 1)] = (unsigned short)(ent | 512u);
    }
}
__device__ __forceinline__ void p2_kv_simple(Frame& F) {
    const bf16* KR = F.PROJ + 4 * (size_t)TT * 512; const bf16* VR = F.PROJ + 5 * (size_t)TT * 512;
    for (int it = blockIdx.x; it < 1024; it += F.G) {
        const int b = it >> 9, h = (it >> 6) & 7, c = it & 63; const size_t row0 = (size_t)b * SEQ + c * 256;
        const int d = F.tid >> 3, e0 = (F.tid & 7) * 8; float a[8];
#pragma unroll
        for (int i = 0; i < 8; ++i) a[i] = 0.f;
        for (int m = 0; m < 256; ++m) {
            const float kk = bf1(KR[(row0 + m) * 512 + h * 64 + d]);
            const u32x4v w = *(const GAS u32x4v*)(VR + (row0 + m) * 512 + h * 64 + e0);
            a[0] += kk * bflo(w.x); a[1] += kk * bfhi(w.x); a[2] += kk * bflo(w.y); a[3] += kk * bfhi(w.y); a[4] += kk * bflo(w.z); a[5] += kk * bfhi(w.z); a[6] += kk * bflo(w.w); a[7] += kk * bfhi(w.w);
        }
        const float sc = F.dpos[h * 256 + 255];
#pragma unroll
        for (int i = 0; i < 8; ++i) F.KV[(size_t)it * 4096 + d * 64 + e0 + i] = a[i] * sc;
    }
}
__device__ __forceinline__ void p3_scan(Frame& F) {
    const int gt = blockIdx.x * (NWAVES * 64) + F.tid;
    if (gt < 16 * 4096) {
        const int bh = gt >> 12, idx = gt & 4095, h = bh & 7; const float g = F.g256[h]; float st = 0.f;
        for (int c = 0; c < 64; ++c) { const size_t o = ((size_t)(bh * 64 + c)) * 4096 + idx; F.RP[o] = st; st = st * g + F.KV[o]; }
    }
}
__device__ __forceinline__ void p3_moba_simple(Frame& F) {
    const bf16* QA = F.PROJ; const bf16* KA = F.PROJ + (size_t)TT * 512; const bf16* VA = F.PROJ + 2 * (size_t)TT * 512;
    const int gt = blockIdx.x * (NWAVES * 64) + F.tid, NT = F.G * NWAVES * 64;
    for (int idx = gt; idx < TT * NH; idx += NT) {
        const int h = idx >> 15, row = idx & (TT - 1), b = row >> 14, t = row & (SEQ - 1), c = t >> 8;
        float q[64], o[64];
        { const GAS u32x4v* qp = (const GAS u32x4v*)(QA + (size_t)row * 512 + h * 64);
#pragma unroll
          for (int i = 0; i < 8; ++i) { const u32x4v w = qp[i]; q[8 * i] = bflo(w.x); q[8 * i + 1] = bfhi(w.x); q[8 * i + 2] = bflo(w.y); q[8 * i + 3] = bfhi(w.y); q[8 * i + 4] = bflo(w.z); q[8 * i + 5] = bfhi(w.z); q[8 * i + 6] = bflo(w.w); q[8 * i + 7] = bfhi(w.w); } }
#pragma unroll
        for (int i = 0; i < 64; ++i) o[i] = 0.f;
        const unsigned sw = F.sel[(size_t)row * 8 + h]; const float* bd = F.biasd + h * 132;
        float mrun = -3.0e38f, l = 0.f;
        for (int slot = 0; slot < 4; ++slot) {
            const int j = slot < 3 ? (int)((sw >> (8 * slot)) & 255u) : c;
            if (slot < 3 && j >= c) continue;
            const size_t r0 = (size_t)b * SEQ + j * 256;
            for (int s = 0; s < 256; ++s) {
                const int pos = j * 256 + s; if (pos > t) break;
                const GAS u32x4v* kp = (const GAS u32x4v*)(KA + (r0 + s) * 512 + h * 64); float dot = 0.f;
#pragma unroll
                for (int i = 0; i < 8; ++i) { const u32x4v w = kp[i]; dot += q[8 * i] * bflo(w.x) + q[8 * i + 1] * bfhi(w.x) + q[8 * i + 2] * bflo(w.y) + q[8 * i + 3] * bfhi(w.y) + q[8 * i + 4] * bflo(w.z) + q[8 * i + 5] * bfhi(w.z) + q[8 * i + 6] * bflo(w.w) + q[8 * i + 7] * bfhi(w.w); }
                const int dist = t - pos; const float sc = dot + bd[dist < 128 ? dist : 128];
                if (sc > mrun) { const float a = __expf(mrun - sc); l *= a;
#pragma unroll
                    for (int i = 0; i < 64; ++i) o[i] *= a;
                    mrun = sc; }
                const float p = __expf(sc - mrun); l += p;
                const GAS u32x4v* vp = (const GAS u32x4v*)(VA + (r0 + s) * 512 + h * 64);
#pragma unroll
                for (int i = 0; i < 8; ++i) { const u32x4v w = vp[i]; o[8 * i] += p * bflo(w.x); o[8 * i + 1] += p * bfhi(w.x); o[8 * i + 2] += p * bflo(w.y); o[8 * i + 3] += p * bfhi(w.y); o[8 * i + 4] += p * bflo(w.z); o[8 * i + 5] += p * bfhi(w.z); o[8 * i + 6] += p * bflo(w.w); o[8 * i + 7] += p * bfhi(w.w); }
            }
        }
        const float il = 1.0f / l;
        GAS u32x4v* yp = (GAS u32x4v*)(F.Y + (size_t)row * 1024 + h * 64);
#pragma unroll
        for (int i = 0; i < 8; ++i) { u32x4v w; w.x = pk2(o[8 * i] * il, o[8 * i + 1] * il); w.y = pk2(o[8 * i + 2] * il, o[8 * i + 3] * il); w.z = pk2(o[8 * i + 4] * il, o[8 * i + 5] * il); w.w = pk2(o[8 * i + 6] * il, o[8 * i + 7] * il); yp[i] = w; }
    }
}
__device__ __forceinline__ void p4_ret_simple(Frame& F) {
    const bf16* QR = F.PROJ + 3 * (size_t)TT * 512; const bf16* KR = F.PROJ + 4 * (size_t)TT * 512; const bf16* VR = F.PROJ + 5 * (size_t)TT * 512; const bf16* GR = F.PROJ + 6 * (size_t)TT * 512;
    const int gt = blockIdx.x * (NWAVES * 64) + F.tid, NT = F.G * NWAVES * 64;
    for (int idx = gt; idx < TT * NH; idx += NT) {
        const int h = idx >> 15, row = idx & (TT - 1), b = row >> 14, t = row & (SEQ - 1), c = t >> 8, n = t & 255;
        float q[64], y[64];
        { const GAS u32x4v* qp = (const GAS u32x4v*)(QR + (size_t)row * 512 + h * 64);
#pragma unroll
          for (int i = 0; i < 8; ++i) { const u32x4v w = qp[i]; q[8 * i] = bflo(w.x); q[8 * i + 1] = bfhi(w.x); q[8 * i + 2] = bflo(w.y); q[8 * i + 3] = bfhi(w.y); q[8 * i + 4] = bflo(w.z); q[8 * i + 5] = bfhi(w.z); q[8 * i + 6] = bflo(w.w); q[8 * i + 7] = bfhi(w.w); } }
#pragma unroll
        for (int i = 0; i < 64; ++i) y[i] = 0.f;
        const size_t r0 = (size_t)row - n;
        for (int m = 0; m <= n; ++m) {
            const GAS u32x4v* kp = (const GAS u32x4v*)(KR + (r0 + m) * 512 + h * 64); float dot = 0.f;
#pragma unroll
            for (int i = 0; i < 8; ++i) { const u32x4v w = kp[i]; dot += q[8 * i] * bflo(w.x) + q[8 * i + 1] * bfhi(w.x) + q[8 * i + 2] * bflo(w.y) + q[8 * i + 3] * bfhi(w.y) + q[8 * i + 4] * bflo(w.z) + q[8 * i + 5] * bfhi(w.z) + q[8 * i + 6] * bflo(w.w) + q[8 * i + 7] * bfhi(w.w); }
            const GAS u32x4v* vp = (const GAS u32x4v*)(VR + (r0 + m) * 512 + h * 64);
#pragma unroll
            for (int i = 0; i < 8; ++i) { const u32x4v w = vp[i]; y[8 * i] += dot * bflo(w.x); y[8 * i + 1] += dot * bfhi(w.x); y[8 * i + 2] += dot * bflo(w.y); y[8 * i + 3] += dot * bfhi(w.y); y[8 * i + 4] += dot * bflo(w.z); y[8 * i + 5] += dot * bfhi(w.z); y[8 * i + 6] += dot * bflo(w.w); y[8 * i + 7] += dot * bfhi(w.w); }
        }
        const float* R = F.RP + ((size_t)((b * 8 + h) * 64 + c)) * 4096; const float gam = F.gam[h];
        const bf16* qrow = QR + (size_t)row * 512 + h * 64;
        for (int d = 0; d < 64; ++d) {
            const float qd = bf1(qrow[d]) * gam; const GAS f32x4* rp = (const GAS f32x4*)(R + d * 64);
#pragma unroll
            for (int i = 0; i < 16; ++i) { const f32x4 r4 = rp[i]; y[4 * i] += qd * r4.x; y[4 * i + 1] += qd * r4.y; y[4 * i + 2] += qd * r4.z; y[4 * i + 3] += qd * r4.w; }
        }
        float mu = 0.f;
#pragma unroll
        for (int i = 0; i < 64; ++i) mu += y[i];
        mu *= (1.f / 64.f); float var = 0.f;
#pragma unroll
        for (int i = 0; i < 64; ++i) { y[i] -= mu; var += y[i] * y[i]; }
        const float rs = 1.0f / sqrtf(var * (1.f / 64.f) + EPS);
        const GAS u32x4v* gp = (const GAS u32x4v*)(GR + (size_t)row * 512 + h * 64);
        GAS u32x4v* yp = (GAS u32x4v*)(F.Y + (size_t)row * 1024 + 512 + h * 64);
#pragma unroll
        for (int i = 0; i < 8; ++i) { const u32x4v w = gp[i]; float g[8] = {bflo(w.x), bfhi(w.x), bflo(w.y), bfhi(w.y), bflo(w.z), bfhi(w.z), bflo(w.w), bfhi(w.w)}; float r[8];
#pragma unroll
            for (int k = 0; k < 8; ++k) r[k] = g[k] / (1.0f + __expf(-g[k])) * (y[8 * i + k] * rs);
            u32x4v ow; ow.x = pk2(r[0], r[1]); ow.y = pk2(r[2], r[3]); ow.z = pk2(r[4], r[5]); ow.w = pk2(r[6], r[7]); yp[i] = ow; }
    }
}

namespace mx {
typedef __attribute__((ext_vector_type(8))) short bf16x8;
typedef __attribute__((ext_vector_type(4))) short s16x4;
typedef __attribute__((ext_vector_type(16))) float f32x16;
typedef __attribute__((ext_vector_type(4))) unsigned u32x4;
typedef short v4i16_t __attribute__((ext_vector_type(4)));
typedef __attribute__((address_space(3))) const char* lds_cptr;
typedef float f32x2_t __attribute__((ext_vector_type(2))); typedef __bf16 bf16x2_t __attribute__((ext_vector_type(2)));
__device__ __forceinline__ int crow(int r, int hi) { return (r & 3) + 8 * (r >> 2) + 4 * hi; }
__device__ __forceinline__ unsigned cvtpk(float lo, float hi) { f32x2_t v = {lo, hi}; bf16x2_t b = __builtin_convertvector(v, bf16x2_t); return __builtin_bit_cast(unsigned, b); }
__device__ __forceinline__ void glds16(const void* gsrc, unsigned lds_dst) { unsigned keep;
    asm volatile("s_mov_b32 %0, m0\n\ts_mov_b32 m0, %2\n\ts_nop 0\n\tglobal_load_lds_dwordx4 %1, off\n\ts_mov_b32 m0, %0" : "=&s"(keep) : "v"(gsrc), "s"(lds_dst) : "memory"); }
__device__ __forceinline__ s16x4 vtr(lds_cptr p) { return __builtin_bit_cast(s16x4, __builtin_amdgcn_ds_read_tr16_b64_v4i16((__attribute__((address_space(3))) v4i16_t*)p)); }
#define MX_WAIT_BAR() asm volatile("s_waitcnt vmcnt(0) lgkmcnt(0)\n\ts_barrier" ::: "memory")
#define MX_LBAR() asm volatile("s_waitcnt lgkmcnt(0)\n\ts_barrier" ::: "memory")
__device__ __forceinline__ void dma_kimg(const bf16* tile, unsigned lds_img, int wid, int lane) { glds16(tile + (size_t)lane * 512 + wid * 8, (unsigned)__builtin_amdgcn_readfirstlane(lds_img + wid * 1024)); }
__device__ __forceinline__ void dma_timg(const bf16* tile, unsigned lds_img, int wid, int lane) { glds16(tile + (size_t)(16 * (wid & 3) + (lane >> 2)) * 512 + (wid >> 2) * 32 + (lane & 3) * 8, (unsigned)__builtin_amdgcn_readfirstlane(lds_img + wid * 1024)); }
__device__ __forceinline__ void qkt(f32x16& p0, f32x16& p1, lds_cptr kimg, const bf16x8* qr, int r32, int hi) {
    const lds_cptr kb = kimg + hi * 1024 + r32 * 16; const f32x16 z = {};
#pragma unroll
    for (int d0 = 0; d0 < 4; ++d0) {
        const bf16x8 b0 = *(const __attribute__((address_space(3))) bf16x8*)(kb + d0 * 2048), b1 = *(const __attribute__((address_space(3))) bf16x8*)(kb + d0 * 2048 + 512);
        p0 = __builtin_amdgcn_mfma_f32_32x32x16_bf16(b0, qr[d0], d0 == 0 ? z : p0, 0, 0, 0); p1 = __builtin_amdgcn_mfma_f32_32x32x16_bf16(b1, qr[d0], d0 == 0 ? z : p1, 0, 0, 0); }
}
__device__ __forceinline__ bf16x8 tfrag_perm(lds_cptr timg, int ks, int d0, int lane, int hi) {
    const lds_cptr p = timg + ((lane >> 4) & 1) * 32 + (lane & 3) * 8 + (4 * hi + ((lane & 15) >> 2)) * 64 + d0 * 4096 + ks * 1024;
    const s16x4 lo = vtr(p), hh = vtr(p + 512); return (bf16x8){lo[0], lo[1], lo[2], lo[3], hh[0], hh[1], hh[2], hh[3]};
}
__device__ __forceinline__ bf16x8 tfrag_nat(lds_cptr timg, int ks, int d0, int lane, int hi) {
    const lds_cptr p = timg + ((lane >> 4) & 1) * 32 + (lane & 3) * 8 + (8 * hi + ((lane & 15) >> 2)) * 64 + d0 * 4096 + ks * 1024;
    const s16x4 lo = vtr(p), hh = vtr(p + 256); return (bf16x8){lo[0], lo[1], lo[2], lo[3], hh[0], hh[1], hh[2], hh[3]};
}
__device__ __forceinline__ void pv64(f32x16* o, const f32x16& p0, const f32x16& p1, lds_cptr vimg, int lane, int hi) {
    u32x4 w0 = {cvtpk(p0[0], p0[1]), cvtpk(p0[2], p0[3]), cvtpk(p0[4], p0[5]), cvtpk(p0[6], p0[7])}, w1 = {cvtpk(p0[8], p0[9]), cvtpk(p0[10], p0[11]), cvtpk(p0[12], p0[13]), cvtpk(p0[14], p0[15])};
    u32x4 w2 = {cvtpk(p1[0], p1[1]), cvtpk(p1[2], p1[3]), cvtpk(p1[4], p1[5]), cvtpk(p1[6], p1[7])}, w3 = {cvtpk(p1[8], p1[9]), cvtpk(p1[10], p1[11]), cvtpk(p1[12], p1[13]), cvtpk(p1[14], p1[15])};
#pragma unroll
    for (int d0 = 0; d0 < 2; ++d0) {
        o[d0] = __builtin_amdgcn_mfma_f32_32x32x16_bf16(__builtin_bit_cast(bf16x8, w0), tfrag_perm(vimg, 0, d0, lane, hi), o[d0], 0, 0, 0);
        o[d0] = __builtin_amdgcn_mfma_f32_32x32x16_bf16(__builtin_bit_cast(bf16x8, w1), tfrag_perm(vimg, 1, d0, lane, hi), o[d0], 0, 0, 0);
        o[d0] = __builtin_amdgcn_mfma_f32_32x32x16_bf16(__builtin_bit_cast(bf16x8, w2), tfrag_perm(vimg, 2, d0, lane, hi), o[d0], 0, 0, 0);
        o[d0] = __builtin_amdgcn_mfma_f32_32x32x16_bf16(__builtin_bit_cast(bf16x8, w3), tfrag_perm(vimg, 3, d0, lane, hi), o[d0], 0, 0, 0);
    }
}
constexpr int L_K = 0, L_V = 32768, L_R = 65536, L_LIST = 65536, L_STG = 98304;
}

__device__ __forceinline__ void p2_kv_mfma(Frame& F) {
    using namespace mx;
    const bf16* KR = F.PROJ + 4 * (size_t)TT * 512; const bf16* VR = F.PROJ + 5 * (size_t)TT * 512;
    const int wid = F.wave, lane = F.lane, r32 = lane & 31, hi = lane >> 5;
    const unsigned lds0 = (unsigned)(size_t)F.lds; const lds_cptr L = (lds_cptr)F.lds;
    for (int it = blockIdx.x; it < 1024; it += F.G) {
        const int b = it >> 9, h = (it >> 6) & 7, c = it & 63; const size_t row0 = (size_t)b * SEQ + c * 256;
        MX_LBAR();
#pragma unroll
        for (int kt = 0; kt < 4; ++kt) { dma_timg(KR + (row0 + 64 * kt) * 512 + h * 64, lds0 + L_K + kt * 8192, wid, lane); dma_timg(VR + (row0 + 64 * kt) * 512 + h * 64, lds0 + L_V + kt * 8192, wid, lane); }
        MX_WAIT_BAR();
        const int dt = wid & 1, et = (wid >> 1) & 1, kh = wid >> 2; f32x16 acc = {};
#pragma unroll
        for (int k = 0; k < 8; ++k) { const int kt = 2 * kh + (k >> 2), ks = k & 3;
            acc = __builtin_amdgcn_mfma_f32_32x32x16_bf16(tfrag_perm(L + L_K + kt * 8192, ks, dt, lane, hi), tfrag_perm(L + L_V + kt * 8192, ks, et, lane, hi), acc, 0, 0, 0); }
        LAS float* red = (LAS float*)(F.lds + L_STG) + (wid & 3) * 1024;
        if (kh == 1) {
#pragma unroll
            for (int r = 0; r < 16; ++r) red[r * 64 + lane] = acc[r];
        }
        MX_LBAR();
        if (kh == 0) { const float sc = F.dpos[h * 256 + 255]; float* dst = F.KV + (size_t)it * 4096 + (32 * dt + 4 * hi) * 64 + 32 * et + r32;
#pragma unroll
            for (int r = 0; r < 16; ++r) dst[((r & 3) + 8 * (r >> 2)) * 64] = (acc[r] + red[r * 64 + lane]) * sc; }
    }
    MX_LBAR();
}
__device__ __forceinline__ void p4_ret_mfma(Frame& F) {
    using namespace mx;
    const bf16* QR = F.PROJ + 3 * (size_t)TT * 512; const bf16* KR = F.PROJ + 4 * (size_t)TT * 512; const bf16* VR = F.PROJ + 5 * (size_t)TT * 512; const bf16* GR = F.PROJ + 6 * (size_t)TT * 512;
    const int wid = F.wave, lane = F.lane, r32 = lane & 31, hi = lane >> 5;
    const unsigned lds0 = (unsigned)(size_t)F.lds; const lds_cptr L = (lds_cptr)F.lds;
    for (int it = blockIdx.x; it < 1024; it += F.G) {
        const int b = it >> 9, h = (it >> 6) & 7, c = it & 63; const size_t row0 = (size_t)b * SEQ + c * 256;
        MX_LBAR();
#pragma unroll
        for (int kt = 0; kt < 4; ++kt) { dma_kimg(KR + (row0 + 64 * kt) * 512 + h * 64, lds0 + L_K + kt * 8192, wid, lane); dma_timg(VR + (row0 + 64 * kt) * 512 + h * 64, lds0 + L_V + kt * 8192, wid, lane); }
        {
            const int d = F.tid >> 3, e0 = (F.tid & 7) * 8; const float g = F.gam[h];
            const GAS f32x4* rp = (const GAS f32x4*)(F.RP + (size_t)it * 4096 + d * 64 + e0); const f32x4 a = rp[0], bq = rp[1];
            u32x4 w = {cvtpk(a.x * g, a.y * g), cvtpk(a.z * g, a.w * g), cvtpk(bq.x * g, bq.y * g), cvtpk(bq.z * g, bq.w * g)};
            *(LAS u32x4*)(F.lds + L_R + ((e0 >> 5) * 4 + (d >> 4)) * 1024 + (d & 15) * 64 + (e0 & 31) * 2) = w; }
        bf16x8 qr[4];
        { const bf16* qp = QR + (row0 + 32 * wid + r32) * 512 + h * 64 + hi * 8;
#pragma unroll
          for (int d0 = 0; d0 < 4; ++d0) qr[d0] = *(const bf16x8*)(qp + d0 * 16); }
        MX_WAIT_BAR();
        f32x16 o[2]; o[0] = f32x16{}; o[1] = f32x16{};
        const int ktd = wid >> 1;
        for (int kt = 0; kt <= ktd; ++kt) {
            f32x16 p0, p1; qkt(p0, p1, L + L_K + kt * 8192, qr, r32, hi);
            if (kt == ktd) { const int qrel = 32 * (wid & 1) + r32;
#pragma unroll
                for (int r = 0; r < 16; ++r) { const int kv = crow(r, hi); if (kv > qrel) p0[r] = 0.f; if (kv + 32 > qrel) p1[r] = 0.f; } }
            pv64(o, p0, p1, L + L_V + kt * 8192, lane, hi);
        }
#pragma unroll
        for (int d0 = 0; d0 < 2; ++d0)
#pragma unroll
            for (int ks = 0; ks < 4; ++ks) o[d0] = __builtin_amdgcn_mfma_f32_32x32x16_bf16(qr[ks], tfrag_nat(L + L_R, ks, d0, lane, hi), o[d0], 0, 0, 0);
        LAS bf16* stg = (LAS bf16*)(F.lds + L_STG) + wid * 2048;
#pragma unroll
        for (int r = 0; r < 16; ++r) {
            float s1 = o[0][r] + o[1][r], s2 = o[0][r] * o[0][r] + o[1][r] * o[1][r];
#pragma unroll
            for (int x = 1; x < 32; x <<= 1) { s1 += __shfl_xor(s1, x); s2 += __shfl_xor(s2, x); }
            const float mu = s1 * (1.f / 64.f), var = s2 * (1.f / 64.f) - mu * mu, rs = 1.0f / sqrtf(fmaxf(var, 0.f) + EPS);
            const int orow = crow(r, hi);
            stg[orow * 64 + r32] = (bf16)(cvtpk((o[0][r] - mu) * rs, 0.f) & 0xffffu); stg[orow * 64 + 32 + r32] = (bf16)(cvtpk((o[1][r] - mu) * rs, 0.f) & 0xffffu);
        }
        LDS_WAIT();
#pragma unroll
        for (int i = 0; i < 4; ++i) { const int row = i * 8 + (lane >> 3), ch = lane & 7; const size_t grow = row0 + 32 * wid + row;
            const u32x4 yv = *(const LAS u32x4*)(stg + row * 64 + ch * 8); const u32x4 gv = *(const GAS u32x4*)(GR + grow * 512 + h * 64 + ch * 8);
            u32x4 ov;
#define P4_G(yw, gw) cvtpk(bflo(gw) / (1.0f + __expf(-bflo(gw))) * bflo(yw), bfhi(gw) / (1.0f + __expf(-bfhi(gw))) * bfhi(yw))
            ov.x = P4_G(yv.x, gv.x); ov.y = P4_G(yv.y, gv.y); ov.z = P4_G(yv.z, gv.z); ov.w = P4_G(yv.w, gv.w);
#undef P4_G
            *(GAS u32x4*)(F.Y + grow * 1024 + 512 + h * 64 + ch * 8) = ov; }
    }
    MX_LBAR();
}


constexpr int NMOBA_ITEMS = 64 * 16;
constexpr int LX_ITEM = 131072 + 512, LX_BD2 = 131072 + 1024, LX_WSF = 131072 + 2048;
__device__ __forceinline__ unsigned moba_entry(const LAS unsigned short* LIST, int j, int ri) { return ri < 256 ? (((unsigned)j << 10) | (3u << 8) | (unsigned)ri) : (unsigned)LIST[ri - 256]; }
__device__ __forceinline__ void moba_loadq(Frame& F, mx::bf16x8* qr, const LAS unsigned short* LIST, int b, int h, int j, int tile, int n) {
    int ri = tile * 32 + (F.lane & 31); if (ri >= n) ri = n - 1;
    const unsigned e = moba_entry(LIST, j, ri); const int tq = (int)(e >> 10) * 256 + (int)(e & 255u);
    const bf16* qp = F.PROJ + ((size_t)b * SEQ + tq) * 512 + h * 64 + (F.lane >> 5) * 8;
#pragma unroll
    for (int d0 = 0; d0 < 4; ++d0) qr[d0] = *(const mx::bf16x8*)(qp + d0 * 16);
}
__device__ __forceinline__ void moba_tile(Frame& F, const mx::bf16x8* qr, int b, int h, int j, int tile, int n) {
    using namespace mx;
    const int wid = F.wave, lane = F.lane, r32 = lane & 31, hi = lane >> 5;
    const lds_cptr L = (lds_cptr)F.lds;
    const LAS unsigned short* LIST = (const LAS unsigned short*)(F.lds + L_LIST);
    LAS float* wsf = (LAS float*)(F.lds + LX_WSF) + wid * 64;
    const LAS float* bd2 = (const LAS float*)(F.lds + LX_BD2);
    const bool own = tile < 8;
    int ri = tile * 32 + r32; const bool rvalid = ri < n; if (!rvalid) ri = n - 1;
    const unsigned e = moba_entry(LIST, j, ri);
    const int tq = (int)(e >> 10) * 256 + (int)(e & 255u), slot = (int)((e >> 8) & 3u);
    const size_t row = (size_t)b * SEQ + tq;
    float m = -1.0e30f, l = 0.f; f32x16 o[2]; o[0] = f32x16{}; o[1] = f32x16{};
    const int ktmax = own ? ((tile * 32 + 31) >> 6) : 3;
    const bool far = !own && __all(tq >= 256 * j + 383);
    for (int kt = 0; kt <= ktmax; ++kt) {
        f32x16 p0, p1; qkt(p0, p1, L + L_K + kt * 8192, qr, r32, hi);
        if (!far) { const int kb = 256 * j + 64 * kt + 4 * hi;
#pragma unroll
            for (int r = 0; r < 16; ++r) { const int d0 = tq - (kb + (r & 3) + 8 * (r >> 2)), d1 = d0 - 32;
                const float b0 = bd2[d0 < 0 ? 0 : (d0 < 128 ? d0 : 128)], b1 = bd2[d1 < 0 ? 0 : (d1 < 128 ? d1 : 128)];
                p0[r] = d0 < 0 ? -1.0e30f : p0[r] + b0; p1[r] = d1 < 0 ? -1.0e30f : p1[r] + b1; } }
        float rm = fmaxf(p0[0], p1[0]);
#pragma unroll
        for (int r = 1; r < 16; ++r) rm = fmaxf(rm, fmaxf(p0[r], p1[r]));
        { auto rr = __builtin_amdgcn_permlane32_swap(__float_as_uint(rm), __float_as_uint(rm), false, false); rm = fmaxf(__uint_as_float(rr[0]), __uint_as_float(rr[1])); }
        const float mn = fmaxf(m, rm), alpha = __builtin_amdgcn_exp2f(m - mn); m = mn;
        float ls = 0.f;
#pragma unroll
        for (int r = 0; r < 16; ++r) { p0[r] = __builtin_amdgcn_exp2f(p0[r] - mn); p1[r] = __builtin_amdgcn_exp2f(p1[r] - mn); ls += p0[r] + p1[r]; }
        l = l * alpha + ls;
        if (kt > 0) {
            if (hi == 0) wsf[r32] = alpha;
            LDS_WAIT();
#pragma unroll
            for (int g = 0; g < 4; ++g) { const f32x4 a4 = *(const LAS f32x4*)(wsf + 8 * g + 4 * hi);
#pragma unroll
                for (int k = 0; k < 4; ++k) { o[0][4 * g + k] *= a4[k]; o[1][4 * g + k] *= a4[k]; } }
        }
        pv64(o, p0, p1, L + L_V + kt * 8192, lane, hi);
    }
    { auto rr = __builtin_amdgcn_permlane32_swap(__float_as_uint(l), __float_as_uint(l), false, false); l = __uint_as_float(rr[0]) + __uint_as_float(rr[1]); }
    if (hi == 0) { wsf[32 + r32] = 1.0f / l;
        if (rvalid) { float* mlp = F.ML + (((size_t)slot * TT + row) * 8 + h) * 2; mlp[0] = far ? m + bd2[128] : m; mlp[1] = l; } }
    LDS_WAIT();
    LAS bf16* stg = (LAS bf16*)(F.lds + L_STG) + wid * 2048;
#pragma unroll
    for (int g = 0; g < 4; ++g) { const f32x4 i4 = *(const LAS f32x4*)(wsf + 32 + 8 * g + 4 * hi);
#pragma unroll
        for (int k = 0; k < 4; ++k) { const int r = 4 * g + k, orow = crow(r, hi);
            stg[orow * 64 + r32] = (bf16)(cvtpk(o[0][r] * i4[k], 0.f) & 0xffffu); stg[orow * 64 + 32 + r32] = (bf16)(cvtpk(o[1][r] * i4[k], 0.f) & 0xffffu); } }
    LDS_WAIT();
#pragma unroll
    for (int i = 0; i < 4; ++i) { const int rw = i * 8 + (lane >> 3), ch = lane & 7, ri2 = tile * 32 + rw;
        if (ri2 < n) { const unsigned e2 = moba_entry(LIST, j, ri2);
            const int tq2 = (int)(e2 >> 10) * 256 + (int)(e2 & 255u), s2 = (int)((e2 >> 8) & 3u);
            bf16* dst = (s2 < 2 ? F.PO01 + (size_t)s2 * TT * 512 : F.PO23 + (size_t)(s2 - 2) * TT * 512) + (((size_t)b * SEQ + tq2) * 8 + h) * 64 + ch * 8;
            *(GAS u32x4*)dst = *(const LAS u32x4*)(stg + rw * 64 + ch * 8); } }
    LDS_WAIT();
}
__device__ __forceinline__ void p3_moba(Frame& F, int qw) {
    using namespace mx;
    const bf16* KA = F.PROJ + (size_t)TT * 512; const bf16* VA = F.PROJ + 2 * (size_t)TT * 512;
    const int wid = F.wave, lane = F.lane;
    const unsigned lds0 = (unsigned)(size_t)F.lds;
    volatile LAS int* itemw = (volatile LAS int*)(F.lds + LX_ITEM);
    LAS unsigned short* LIST = (LAS unsigned short*)(F.lds + L_LIST);
    LAS float* bd2 = (LAS float*)(F.lds + LX_BD2);
    int nxt = 0;
    if (F.tid == 0) nxt = (int)__hip_atomic_fetch_add(F.ctl + qw, 1u, RLX_AGENT);
    for (;;) {
        if (F.tid == 0) itemw[0] = nxt;
        MX_LBAR();
        const int idx = itemw[0];
        if (idx >= NMOBA_ITEMS) break;
        if (F.tid == 0) nxt = (int)__hip_atomic_fetch_add(F.ctl + qw, 1u, RLX_AGENT);
        const int j = idx >> 4, bh = idx & 15, b = bh >> 3, h = bh & 7;
        const size_t row0 = (size_t)b * SEQ + j * 256;
#pragma unroll
        for (int kt = 0; kt < 4; ++kt) { dma_kimg(KA + (row0 + 64 * kt) * 512 + h * 64, lds0 + L_K + kt * 8192, wid, lane); dma_timg(VA + (row0 + 64 * kt) * 512 + h * 64, lds0 + L_V + kt * 8192, wid, lane); }
        if (F.tid < 132) bd2[F.tid] = F.biasd[h * 132 + F.tid] * 1.4426950408889634f;
        const int nsel = (int)F.ctl[CW_TOT + bh * 64 + j], n = 256 + nsel;
        { const unsigned short* lg = F.LISTG + ((size_t)bh * 64 + j) * 16384;
          for (int i = F.tid; i < nsel; i += NWAVES * 64) LIST[i] = lg[i]; }
        MX_WAIT_BAR();
        const int ntile = (n + 31) >> 5;
        bf16x8 qr[4], qn[4];
        moba_loadq(F, qr, LIST, b, h, j, wid, n);
        for (int tile = wid; tile < ntile; tile += 8) {
            if (tile + 8 < ntile) moba_loadq(F, qn, LIST, b, h, j, tile + 8, n);
            moba_tile(F, qr, b, h, j, tile, n);
#pragma unroll
            for (int d0 = 0; d0 < 4; ++d0) qr[d0] = qn[d0];
        }
    }
}
__device__ __forceinline__ void p4_combine(Frame& F) {
    const int gt = blockIdx.x * (NWAVES * 64) + F.tid, NT = F.G * NWAVES * 64;
    for (int gid = gt; gid < TT * 64; gid += NT) {
        const int ch = gid & 7, h = (gid >> 3) & 7, row = gid >> 6, c = (row & (SEQ - 1)) >> 8, nv = c < 3 ? c : 3;
        float ms[4], ls[4];
#pragma unroll
        for (int s = 0; s < 4; ++s) { const bool v = (s == 3) || (s < nv); const float* mlp = F.ML + (((size_t)s * TT + row) * 8 + h) * 2; ms[s] = v ? mlp[0] : -3.0e38f; ls[s] = v ? mlp[1] : 0.f; }
        const float M = fmaxf(fmaxf(ms[0], ms[1]), fmaxf(ms[2], ms[3]));
        float acc[8], wsum = 0.f;
#pragma unroll
        for (int k = 0; k < 8; ++k) acc[k] = 0.f;
#pragma unroll
        for (int s = 0; s < 4; ++s) { const bool v = (s == 3) || (s < nv);
            if (v) { const float w = __builtin_amdgcn_exp2f(ms[s] - M) * ls[s]; wsum += w;
                const bf16* src = (s < 2 ? F.PO01 + (size_t)s * TT * 512 : F.PO23 + (size_t)(s - 2) * TT * 512) + ((size_t)row * 8 + h) * 64 + ch * 8;
                const u32x4v pw = *(const GAS u32x4v*)src;
                acc[0] += w * bflo(pw.x); acc[1] += w * bfhi(pw.x); acc[2] += w * bflo(pw.y); acc[3] += w * bfhi(pw.y); acc[4] += w * bflo(pw.z); acc[5] += w * bfhi(pw.z); acc[6] += w * bflo(pw.w); acc[7] += w * bfhi(pw.w); } }
        const float iw = 1.0f / wsum; u32x4v ow; ow.x = pk2(acc[0] * iw, acc[1] * iw); ow.y = pk2(acc[2] * iw, acc[3] * iw); ow.z = pk2(acc[4] * iw, acc[5] * iw); ow.w = pk2(acc[6] * iw, acc[7] * iw);
        *(GAS u32x4v*)(F.Y + (size_t)row * 1024 + h * 64 + ch * 8) = ow;
    }
}

__device__ __forceinline__ void rows_residual(Frame& F, const float* xin, const bf16* Yb, const float* gpost, float* xout, bf16* XNo) {
    const int gw = F.vcu * NWAVES + F.wave, NGW = F.G * NWAVES;
    for (int m = gw; m < TT; m += NGW) {
        float ss = 0.f;
        { const GAS f32x4* rp = (const GAS f32x4*)(F.rowss + (size_t)m * 16);
#pragma unroll
          for (int i = 0; i < 4; ++i) { const f32x4 r = rp[i]; ss += (r.x + r.y) + (r.z + r.w); } }
        const float rstd = 1.0f / sqrtf(ss * (1.f / DM) + EPS);
        const GAS f32x4* xr = (const GAS f32x4*)(xin + (size_t)m * DM) + F.lane;
        const GAS u32x2v* yr = (const GAS u32x2v*)(Yb + (size_t)m * DM) + F.lane;
        const GAS f32x4* gr = (const GAS f32x4*)gpost + F.lane;
        GAS f32x4* orow = (GAS f32x4*)(xout + (size_t)m * DM) + F.lane;
        f32x4 v[4]; float s2 = 0.f;
#pragma unroll
        for (int j = 0; j < 4; ++j) { const f32x4 xv = xr[64 * j]; const u32x2v yw = yr[64 * j]; const f32x4 g = gr[64 * j];
            v[j].x = xv.x + bflo(yw.x) * rstd * g.x; v[j].y = xv.y + bfhi(yw.x) * rstd * g.y; v[j].z = xv.z + bflo(yw.y) * rstd * g.z; v[j].w = xv.w + bfhi(yw.y) * rstd * g.w;
            orow[64 * j] = v[j]; s2 += (v[j].x * v[j].x + v[j].y * v[j].y) + (v[j].z * v[j].z + v[j].w * v[j].w); }
        if (XNo) {
            const float r2 = 1.0f / sqrtf(wave_sum(s2) * (1.f / DM) + EPS);
            GAS unsigned long long* o8 = (GAS unsigned long long*)(XNo + (size_t)m * DM) + F.lane;
#pragma unroll
            for (int j = 0; j < 4; ++j) o8[64 * j] = (unsigned long long)pk2(v[j].x * r2, v[j].y * r2) | ((unsigned long long)pk2(v[j].z * r2, v[j].w * r2) << 32);
        }
    }
}
__device__ __forceinline__ float gelu_tanh(float a) { const float z = 0.7978845608028654f * (a + 0.044715f * a * a * a); return a * (1.0f - 1.0f / (__expf(2.0f * z) + 1.0f)); }
__device__ __forceinline__ void p8_conv(Frame& F, int hb) {
    const int gw = F.vcu * NWAVES + F.wave, NGW = F.G * NWAVES;
    constexpr int RSEG = 32, NSEG = SEQ / RSEG;
    for (int it = gw; it < 11 * NSEG; it += NGW) {
        const int strip = it % 11, seg = it / 11, c = strip * 256 + F.lane * 4, r0 = seg * RSEG;
        f32x4 wa[3], wb[3];
#pragma unroll
        for (int j = 0; j < 3; ++j) { wa[j] = *(const GAS f32x4*)(F.conv_w + (size_t)j * NUP + c); wb[j] = *(const GAS f32x4*)(F.conv_w + (size_t)j * NUP + DFF + c); }
        const f32x4 ba = *(const GAS f32x4*)(F.conv_b + c), bb = *(const GAS f32x4*)(F.conv_b + DFF + c);
        f32x4 a2 = {0.f, 0.f, 0.f, 0.f}, a1 = a2, b2 = a2, b1 = a2;
#define P8_LD(r, ua, ub) do { const u32x2v wa_ = *(const GAS u32x2v*)(Ub + (size_t)(r) * NUP + c), wb_ = *(const GAS u32x2v*)(Ub + (size_t)(r) * NUP + DFF + c); \
            ua = (f32x4){bflo(wa_.x), bfhi(wa_.x), bflo(wa_.y), bfhi(wa_.y)}; ub = (f32x4){bflo(wb_.x), bfhi(wb_.x), bflo(wb_.y), bfhi(wb_.y)}; } while (0)
        const bf16* Ub = F.U;
        if (r0 >= 2) { P8_LD(r0 - 2, a2, b2); P8_LD(r0 - 1, a1, b1); }
        for (int r = r0; r < r0 + RSEG; ++r) {
            f32x4 ua, ub; P8_LD(r, ua, ub);
            const f32x4 av = ba + wa[0] * a2 + wa[1] * a1 + wa[2] * ua, bv = bb + wb[0] * b2 + wb[1] * b1 + wb[2] * ub;
            u32x2v o; o.x = pk2(gelu_tanh(av.x) * bv.x, gelu_tanh(av.y) * bv.y); o.y = pk2(gelu_tanh(av.z) * bv.z, gelu_tanh(av.w) * bv.w);
            *(GAS u32x2v*)(F.Fb + ((size_t)hb * SEQ + r) * DFF + c) = o;
            a2 = a1; a1 = ua; b2 = b1; b1 = ub;
        }
    }
}

constexpr int NPHASE = 10;
struct Args { const float* in[12]; float* out; unsigned char* ws; int ph_lo, ph_hi; };
__global__ void __launch_bounds__(NWAVES * 64, 2) fwd_kernel(Args args) {
    extern __shared__ __attribute__((aligned(16))) unsigned char lds[];
    Frame F;
    F.lds = (LAS unsigned char*)lds; F.MISC = (volatile LAS unsigned*)(F.lds + MISC_OFF);
    F.tid = threadIdx.x; F.lane = F.tid & 63; F.wave = __builtin_amdgcn_readfirstlane(F.tid >> 6);
    F.G = gridDim.x; { const int bx = blockIdx.x; F.vcu = (F.G % 8 == 0) ? (bx % 8) * (F.G / 8) + bx / 8 : bx; }
    unsigned char* ws = args.ws;
    F.ctl = (gu32*)(ws + WS_CTL);
    F.x = args.in[0]; F.g_mix_pre = args.in[1]; F.w_in = args.in[2]; F.rel_bias = args.in[3]; F.w_out = args.in[4]; F.g_mix_post = args.in[5];
    F.g_ffn_pre = args.in[6]; F.w_up = args.in[7]; F.conv_w = args.in[8]; F.conv_b = args.in[9]; F.w_down = args.in[10]; F.g_ffn_post = args.in[11]; F.out = args.out;
    F.Win_t = (bf16*)(ws + WS_WIN); F.Wout_t = (bf16*)(ws + WS_WOUT); F.Wup_t = (bf16*)(ws + WS_WUP); F.Wdn_t = (bf16*)(ws + WS_WDN);
    F.XN = (bf16*)(ws + WS_XN); F.PROJ = (bf16*)(ws + WS_PROJ); F.Y = (bf16*)(ws + WS_Y); F.Y1 = (bf16*)(ws + WS_Y1); F.U = (bf16*)(ws + WS_U); F.Fb = (bf16*)(ws + WS_F);
    F.cs = (float*)(ws + WS_CS); F.biasd = (float*)(ws + WS_SMALL + SM_BIASD); F.dpos = (float*)(ws + WS_SMALL + SM_DPOS); F.dneg = (float*)(ws + WS_SMALL + SM_DNEG);
    F.gam = (float*)(ws + WS_SMALL + SM_GAM); F.g256 = (float*)(ws + WS_SMALL + SM_G256);
    F.kms = (float*)(ws + WS_KMS); F.rowss = (float*)(ws + WS_ROWSS); F.KV = (float*)(ws + WS_KV); F.RP = (float*)(ws + WS_RP); F.sel = (unsigned*)(ws + WS_SEL);
    F.LISTG = (unsigned short*)args.out;
    F.PO01 = (bf16*)(ws + WS_PO01); F.PO23 = (bf16*)(ws + WS_PO23); F.ML = (float*)(ws + WS_ML);
    for (int u = F.tid; u < (LDS_BYTES - LDSCTL_OFF) / 4; u += NWAVES * 64) ((LAS unsigned*)(F.lds + LDSCTL_OFF))[u] = 0u;
    __syncthreads();
    XcdBarrier bar; bar.bar = (unsigned*)(F.ctl + CW_BAR); bar.x = 0; bar.st = nullptr;
    if (MK_ONE_LAUNCH) bar = xcd_barrier_post((unsigned*)(F.ctl + CW_BAR), F.MISC + 8);
    const int lo = args.ph_lo, hi = args.ph_hi;
#define IN(k) (lo <= (k) && (k) < hi)
#define DUP(k) ((MK_DUP >> (k)) & 1)
#define SEAM(k) do { if (IN(k) && IN((k) + 1)) xcd_barrier(bar); } while (0)

    if (IN(0)) { p0_prologue(F); if (DUP(0)) { __syncthreads(); p0_prologue(F); } }
#if MK_ONE_LAUNCH
    if (IN(0) && IN(1)) { cooperative_groups::this_grid().sync(); }
#endif
    if (IN(1)) {
        pg8::Gemm g{F.XN, F.Win_t, TT, NPROJ, DM}; pg8::StaticOrder S; S.init(TT, NPROJ, F.G, (int)blockIdx.x);
        pg8::EpiProj E{F.PROJ, F.cs, F.dpos, F.dneg, F.kms};
        pg8::gemm_phase<pg8::EpiProj, pg8::StaticOrder, PG8_ALIGN, PG8_SP2>(F.lds + RING_OFF, g, S, E);
        if (DUP(1)) { __syncthreads(); pg8::gemm_phase<pg8::EpiProj, pg8::StaticOrder, PG8_ALIGN, PG8_SP2>(F.lds + RING_OFF, g, S, E); }
    } SEAM(1);
    if (IN(2)) { p2_gate(F); __syncthreads(); p2_kv_mfma(F); if (DUP(2)) { __syncthreads(); p2_gate(F); __syncthreads(); p2_kv_mfma(F); } } SEAM(2);
    if (IN(3)) { p3_scan(F); p3_moba(F, CW_Q); if (DUP(3)) { __syncthreads(); p3_scan(F); p3_moba(F, CW_Q + 64); } } SEAM(3);
    if (IN(4)) { p4_ret_mfma(F); p4_combine(F); if (DUP(4)) { __syncthreads(); p4_ret_mfma(F); p4_combine(F); } } SEAM(4);
    if (IN(5)) {
        pg8::Gemm g{F.Y, F.Wout_t, TT, DM, DM}; pg8::StaticOrder S; S.init(TT, DM, F.G, (int)blockIdx.x);
        pg8::EpiY E{F.Y1, F.rowss};
        pg8::gemm_phase<pg8::EpiY, pg8::StaticOrder, PG8_ALIGN, PG8_SP2>(F.lds + RING_OFF, g, S, E);
    } SEAM(5);
    if (IN(6)) { rows_residual(F, F.x, F.Y1, F.g_mix_post, F.out, F.XN); if (DUP(6)) rows_residual(F, F.x, F.Y1, F.g_mix_post, F.out, F.XN); } SEAM(6);
    if (IN(7)) {
        pg8::Gemm g{F.XN, F.Wup_t, 130 * 256, NUP, DM, 1}; pg8::StaticOrder S; S.init(130 * 256, NUP, F.G, (int)blockIdx.x);
        pg8::EpiFfn E{F.Fb, F.conv_w, F.conv_b, (LAS float*)(F.lds + XCH_OFF)};
        pg8::gemm_phase<pg8::EpiFfn, pg8::StaticOrder, true, PG8_SP2>(F.lds + RING_OFF, g, S, E);
    } SEAM(7);
    if (IN(8)) {
        pg8::Gemm g{F.Fb, F.Wdn_t, TT, DM, DFF}; pg8::StaticOrder S; S.init(TT, DM, F.G, (int)blockIdx.x);
        pg8::EpiY E{F.Y1, F.rowss};
        pg8::gemm_phase<pg8::EpiY, pg8::StaticOrder, PG8_ALIGN, PG8_SP2>(F.lds + RING_OFF, g, S, E);
    } SEAM(8);
    if (IN(9)) { rows_residual(F, F.out, F.Y1, F.g_ffn_post, F.out, nullptr); }
#undef IN
#undef SEAM
}

extern "C" void kernel_launch(void* const* d_in, const int* in_sizes, int n_in, void* d_out, int out_size, void* d_ws, size_t ws_size, hipStream_t stream) {
    static int grid = 0;
    if (grid == 0) {
        if (n_in != 12 || in_sizes[0] != TT * DM || out_size != TT * DM || ws_size < WS_END) { fprintf(stderr, "kernel_launch: unexpected shapes (n_in %d in0 %d out %d ws %zu)\n", n_in, n_in > 0 ? in_sizes[0] : -1, out_size, ws_size); grid = -1; return; }
        int dev = 0, cus = 0, per_cu = 0;
        if (hipGetDevice(&dev) != hipSuccess || hipDeviceGetAttribute(&cus, hipDeviceAttributeMultiprocessorCount, dev) != hipSuccess) { grid = -1; return; }
        if (hipFuncSetAttribute((const void*)fwd_kernel, hipFuncAttributeMaxDynamicSharedMemorySize, LDS_BYTES) != hipSuccess) { fprintf(stderr, "kernel_launch: hipFuncSetAttribute failed\n"); grid = -1; return; }
        if (hipOccupancyMaxActiveBlocksPerMultiprocessor(&per_cu, (const void*)fwd_kernel, NWAVES * 64, LDS_BYTES) != hipSuccess || per_cu < 1) { fprintf(stderr, "kernel_launch: occupancy query says %d\n", per_cu); per_cu = 1; }
        (void)hipGetLastError();
        grid = cus * (per_cu < 1 ? 1 : 1);
    }
    if (grid < 0) return;
    if (hipMemsetAsync((char*)d_ws + WS_CTL, 0, CTL_ZERO_BYTES, stream) != hipSuccess) { fprintf(stderr, "kernel_launch: memset failed\n"); return; }
    Args a{};
    for (int i = 0; i < 12; ++i) a.in[i] = (const float*)d_in[i];
    a.out = (float*)d_out; a.ws = (unsigned char*)d_ws;
#if MK_ONE_LAUNCH
    a.ph_lo = 0; a.ph_hi = NPHASE;
    void* kargs[] = {&a};
    hipError_t e = hipLaunchCooperativeKernel((const void*)fwd_kernel, dim3(grid), dim3(NWAVES * 64), kargs, LDS_BYTES, stream);
    if (e != hipSuccess) fprintf(stderr, "kernel_launch: cooperative launch failed: %s\n", hipGetErrorString(e));
#else
    for (int p = 0; p < NPHASE; ++p) { a.ph_lo = p; a.ph_hi = p + 1; hipLaunchKernelGGL(fwd_kernel, dim3(grid), dim3(NWAVES * 64), LDS_BYTES, stream, a); }
#endif
}
```

```cpp
#include <hip/hip_runtime.h>
#include <hip/hip_cooperative_groups.h>
#include <cstdio>
#include <cstdint>
#define MK_ONE_LAUNCH 1
namespace pg8 {
#define PG8_LAS __attribute__((address_space(3)))
typedef unsigned short bf16_t;
typedef short bf16x8 __attribute__((ext_vector_type(8)));
typedef float f32x4 __attribute__((ext_vector_type(4)));
typedef unsigned u32x4 __attribute__((ext_vector_type(4)));
constexpr int BM = 256, BK = 64, HALF = 128, HTB = HALF * BK * 2  , STAGE_BYTES = 8 * HTB, NXCD = 8, WGM = 8;

__host__ __device__ __forceinline__ int lds_byte(int r, int c) { const int st = (r >> 4) * 2 + (c >> 5), rr = r & 15, cc = c & 31, ob = rr * 64 + cc * 2; return st * 1024 + (ob ^ (((ob >> 9) & 1) << 5)); }
__host__ __device__ __forceinline__ void stage_rc(int b, int& R, int& C) { const int st = b / 1024, sb = b % 1024, swz = sb ^ (((sb >> 9) & 1) << 5); R = (st >> 1) * 16 + swz / 64; C = (st & 1) * 32 + (swz % 64) / 2; }
__host__ __device__ __forceinline__ int perm32(int rho) { const int n = rho >> 4, i = rho & 15; return 8 * (i >> 2) + 4 * n + (i & 3); }

struct Unit { int pm, pn; };
struct Gemm { const bf16_t* A; const bf16_t* Bt; int M, N, K; int amode;
    __device__ __forceinline__ const char* abase(int pm) const { if (amode == 0) return (const char*)A + (size_t)pm * ((size_t)BM * K * 2);
        const int b = pm / 65, i = pm - 65 * b; return (const char*)A + ((long)b * 16384 + 254 * i - 2) * ((long)K * 2); } };

struct StaticOrder {
    int nM, nN, nwg, G, c;
    __host__ __device__ void init(int M, int N, int G_, int c_) { nM = M / BM; nN = N / BM; nwg = nM * nN; G = G_; c = c_; }
    __host__ __device__ bool next(int i, Unit& u) const {
        const long L = (long)i * G + c; if (L >= nwg) return false;
        int wgid = (int)L; { const int q = nwg / NXCD, r = nwg % NXCD, xcd = wgid % NXCD, off = wgid / NXCD; wgid = (xcd < r ? xcd * (q + 1) : r * (q + 1) + (xcd - r) * q) + off; }
        const int nig = WGM * nN, gid = wgid / nig, fm = gid * WGM, gsz = (nM - fm) < WGM ? (nM - fm) : WGM;
        u.pm = fm + ((wgid % nig) % gsz); u.pn = (wgid % nig) / gsz; return true;
    }
    __device__ __forceinline__ void a_ready(const Unit&) const {}
    __device__ __forceinline__ void done(const Unit&) const {}
};

__device__ __forceinline__ unsigned cvt_pk_bf16(float lo, float hi) { unsigned r; asm volatile("v_cvt_pk_bf16_f32 %0, %1, %2" : "=v"(r) : "v"(lo), "v"(hi)); return r; }
typedef float f32x2 __attribute__((ext_vector_type(2)));
__device__ __forceinline__ f32x2 gelu_pk(f32x2 v) {
    const f32x2 av = __builtin_elementwise_abs(v), d = av * 0.2316418882f + 1.0f;
    f32x2 t; t.x = __builtin_amdgcn_rcpf(d.x); t.y = __builtin_amdgcn_rcpf(d.y);
    f32x2 q = t * 0.5307027145f + (-0.7265760135f); q = q * t + 0.7107068705f; q = q * t + (-0.142248368f); q = q * t + 0.127414796f; q = q * t;
    const f32x2 s = (v * v) * (-0.72134752044f);
    f32x2 e; e.x = __builtin_amdgcn_exp2f(s.x); e.y = __builtin_amdgcn_exp2f(s.y);
    const f32x2 m = v * (q * e), r = v - m;
    f32x2 o; o.x = v.x < 0.f ? m.x : r.x; o.y = v.y < 0.f ? m.y : r.y; return o;
}

template <int ACT  > struct EpiBf16 {
    static constexpr bool PERM = true, AFTER_DRAIN = false; static_assert(ACT == 0 || ACT == 1, "EpiBf16: ACT is 0 (none) or 1 (gelu_pk)");
    bf16_t* O; int ldc; const float* bias; int split_cols; size_t split_stride; float scale0;
    __device__ __forceinline__ void operator()(const f32x4 (&acc)[2][2][4][2], const Unit& u, int wr, int wc, int fr, int fq) const {
        const int row0 = u.pm * BM + wr * 64 + fr; int colt = u.pn * BM; bf16_t* base = O;
        float sc = 1.f; if (split_cols) { const int t = colt / split_cols; base += (size_t)t * split_stride; colt -= t * split_cols; if (t == 0) sc = scale0; }
        const int col0 = colt + wc * 32 + 8 * fq, bcol0 = u.pn * BM + wc * 32 + 8 * fq;
        f32x4 bv[2][2];
#pragma unroll
        for (int bj = 0; bj < 2; ++bj)
#pragma unroll
            for (int n = 0; n < 2; ++n) bv[bj][n] = bias ? *(const f32x4*)(bias + bcol0 + bj * HALF + 4 * n) : (f32x4){0.f, 0.f, 0.f, 0.f};
#pragma unroll
        for (int ai = 0; ai < 2; ++ai)
#pragma unroll
            for (int m = 0; m < 4; ++m) { bf16_t* rowp = base + (size_t)(row0 + ai * HALF + m * 16) * ldc + col0;
#pragma unroll
                for (int bj = 0; bj < 2; ++bj) { f32x4 v0 = acc[ai][bj][m][0] + bv[bj][0], v1 = acc[ai][bj][m][1] + bv[bj][1];
                    if (ACT == 1) { f32x2 a = gelu_pk((f32x2){v0[0], v0[1]}), b = gelu_pk((f32x2){v0[2], v0[3]}), c = gelu_pk((f32x2){v1[0], v1[1]}), d = gelu_pk((f32x2){v1[2], v1[3]});
                        v0 = (f32x4){a.x, a.y, b.x, b.y}; v1 = (f32x4){c.x, c.y, d.x, d.y}; }
                    v0 = v0 * sc; v1 = v1 * sc; u32x4 w; w.x = cvt_pk_bf16(v0[0], v0[1]); w.y = cvt_pk_bf16(v0[2], v0[3]); w.z = cvt_pk_bf16(v1[0], v1[1]); w.w = cvt_pk_bf16(v1[2], v1[3]);
                    *(u32x4*)(rowp + bj * HALF) = w; } }
    }
};
template <class Epi, class Sched, bool ALIGN_EPI = false, bool SP2 = false>
__device__ __forceinline__ void gemm_phase(PG8_LAS unsigned char* lds, const Gemm g, const Sched& S, const Epi& E) {
    const int tid = threadIdx.x, wid = __builtin_amdgcn_readfirstlane(tid >> 6), lane = tid & 63, wr = wid >> 2, wc = wid & 3, fr = lane & 15, fq = lane >> 4;
    const int K = g.K, nt = K / BK;
    unsigned voffA[2], voffB[2];
#pragma unroll
    for (int i = 0; i < 2; ++i) { int R, C; stage_rc(tid * 16 + i * 8192, R, C); const int Rb = Epi::PERM ? ((R & ~31) + perm32(R & 31)) : R;
        voffA[i] = (unsigned)(R * K + C) * 2u; voffB[i] = (unsigned)(Rb * K + C) * 2u; }
    const size_t kstep = (size_t)(BK * 2);
    const size_t hstep = (size_t)HALF * K * 2;
    const size_t tstep = 2 * hstep;
    const unsigned ldsw = (unsigned)wid * 1024u;
    const int aoff = lds_byte(wr * 64 + fr, fq * 8), boff = lds_byte(wc * 32 + fr, fq * 8);
#define PG8_SA(b, h) (((b) * 2 + (h)) * HTB)
#define PG8_SB(b, h) ((4 + (b) * 2 + (h)) * HTB)
#define PG8_STAGE(bufoff, gbase, voff) do { _Pragma("unroll") for (int _i = 0; _i < 2; ++_i) \
        __builtin_amdgcn_global_load_lds((const unsigned*)((const char*)(gbase) + (voff)[_i]), (PG8_LAS unsigned*)(lds + (bufoff) + ldsw + _i * 8192), 16, 0, 0); } while (0)
#define PG8_LDA(dst, b, h) do { _Pragma("unroll") for (int m = 0; m < 4; ++m) _Pragma("unroll") for (int k = 0; k < 2; ++k) dst[m][k] = *(const PG8_LAS bf16x8*)(lds + PG8_SA(b, h) + aoff + m * 2048 + k * 1024); } while (0)
#define PG8_LDB(dst, b, h) do { _Pragma("unroll") for (int n = 0; n < 2; ++n) _Pragma("unroll") for (int k = 0; k < 2; ++k) dst[n][k] = *(const PG8_LAS bf16x8*)(lds + PG8_SB(b, h) + boff + n * 2048 + k * 1024); } while (0)
#define PG8_MMA(ai, bj, At, Bt) do { __builtin_amdgcn_s_setprio(1); _Pragma("unroll") for (int m = 0; m < 4; ++m) _Pragma("unroll") for (int n = 0; n < 2; ++n) _Pragma("unroll") for (int k = 0; k < 2; ++k) \
        acc[ai][bj][m][n] = __builtin_amdgcn_mfma_f32_16x16x32_bf16(Bt[n][k], At[m][k], acc[ai][bj][m][n], 0, 0, 0); __builtin_amdgcn_s_setprio(0); } while (0)
#define PG8_WAIT_V(n) asm volatile("s_waitcnt vmcnt(" #n ")" ::: "memory")
#define PG8_WAIT_L(n) asm volatile("s_waitcnt lgkmcnt(" #n ")" ::: "memory")
#define PG8_BAR __builtin_amdgcn_s_barrier()
#define PG8_SCHED __builtin_amdgcn_sched_barrier(0)
    Unit cur, nxt; int ui = 0;
    if (!S.next(0, cur)) return;
    f32x4 acc[2][2][4][2];
#pragma unroll
    for (int a = 0; a < 2; ++a)
#pragma unroll
        for (int b = 0; b < 2; ++b)
#pragma unroll
            for (int m = 0; m < 4; ++m)
#pragma unroll
                for (int n = 0; n < 2; ++n) acc[a][b][m][n] = (f32x4){0.f, 0.f, 0.f, 0.f};
    bf16x8 At[4][2], B0[2][2], B1[2][2];
    const char* cA = g.abase(cur.pm); const char* cB = (const char*)g.Bt + (size_t)cur.pn * tstep;
    S.a_ready(cur);
    if constexpr (SP2) {
        PG8_STAGE(PG8_SB(0, 0), cB, voffB); PG8_STAGE(PG8_SB(0, 1), cB + hstep, voffB); PG8_STAGE(PG8_SA(0, 0), cA, voffA); PG8_STAGE(PG8_SA(0, 1), cA + hstep, voffA);
        if (wr == 1) PG8_BAR;
        PG8_WAIT_V(2); PG8_BAR;
        PG8_STAGE(PG8_SB(1, 0), cB + kstep, voffB); PG8_STAGE(PG8_SA(1, 0), cA + kstep, voffA); PG8_STAGE(PG8_SB(1, 1), cB + hstep + kstep, voffB);
        PG8_WAIT_V(6); PG8_BAR;
    } else {
        PG8_STAGE(PG8_SB(0, 0), cB, voffB); PG8_STAGE(PG8_SA(0, 0), cA, voffA); PG8_STAGE(PG8_SB(0, 1), cB + hstep, voffB); PG8_STAGE(PG8_SA(0, 1), cA + hstep, voffA);
        if (wr == 1) PG8_BAR;
        PG8_WAIT_V(4); PG8_BAR;
        PG8_STAGE(PG8_SB(1, 0), cB + kstep, voffB); PG8_STAGE(PG8_SA(1, 0), cA + kstep, voffA); PG8_STAGE(PG8_SB(1, 1), cB + hstep + kstep, voffB);
        PG8_WAIT_V(6); PG8_BAR;
    }
    for (;;) {
        const bool has_next = S.next(ui + 1, nxt);
        const char* nA = has_next ? g.abase(nxt.pm) : cA; const char* nB = has_next ? (const char*)g.Bt + (size_t)nxt.pn * tstep : cB;
        for (int t = 0; t < nt; t += 2) {
            const bool last = (t == nt - 2);
            const char* a1 = cA + (size_t)(t + 1) * kstep;
            const char* a2 = last ? nA : cA + (size_t)(t + 2) * kstep; const char* b2 = last ? nB : cB + (size_t)(t + 2) * kstep;
            const char* a3 = a2 + kstep; const char* b3 = b2 + kstep;
            if (last && has_next) S.a_ready(nxt);
            if constexpr (SP2) {
            PG8_LDB(B0, 0, 0); PG8_LDB(B1, 0, 1); PG8_SCHED; PG8_LDA(At, 0, 0); PG8_STAGE(PG8_SA(1, 1), a1 + hstep, voffA);
            PG8_WAIT_V(8); PG8_WAIT_L(0); PG8_BAR; PG8_MMA(0, 0, At, B0); PG8_MMA(0, 1, At, B1); PG8_BAR; PG8_SCHED;
            PG8_LDA(At, 0, 1); PG8_STAGE(PG8_SB(0, 0), b2, voffB); PG8_STAGE(PG8_SB(0, 1), b2 + hstep, voffB); PG8_STAGE(PG8_SA(0, 0), a2, voffA);
            PG8_WAIT_V(8); PG8_WAIT_L(0); PG8_BAR; PG8_MMA(1, 0, At, B0); PG8_MMA(1, 1, At, B1); PG8_BAR; PG8_SCHED;
            PG8_LDB(B0, 1, 0); PG8_LDB(B1, 1, 1); PG8_SCHED; PG8_LDA(At, 1, 0); PG8_STAGE(PG8_SA(0, 1), a2 + hstep, voffA);
            PG8_WAIT_V(8); PG8_WAIT_L(0); PG8_BAR; PG8_MMA(0, 0, At, B0); PG8_MMA(0, 1, At, B1); PG8_BAR; PG8_SCHED;
            PG8_LDA(At, 1, 1); PG8_STAGE(PG8_SB(1, 0), b3, voffB); PG8_STAGE(PG8_SB(1, 1), b3 + hstep, voffB); PG8_STAGE(PG8_SA(1, 0), a3, voffA);
            PG8_WAIT_V(8); PG8_WAIT_L(0); PG8_BAR; PG8_MMA(1, 0, At, B0); PG8_MMA(1, 1, At, B1); PG8_BAR; PG8_SCHED;
            } else {
            PG8_LDB(B0, 0, 0); PG8_SCHED; PG8_LDA(At, 0, 0); PG8_STAGE(PG8_SA(1, 1), a1 + hstep, voffA);
            PG8_WAIT_L(8); PG8_BAR; PG8_WAIT_L(0); PG8_MMA(0, 0, At, B0); PG8_BAR; PG8_SCHED;
            PG8_LDB(B1, 0, 1); PG8_STAGE(PG8_SB(0, 0), b2, voffB);
            PG8_BAR; PG8_WAIT_L(0); PG8_MMA(0, 1, At, B1); PG8_BAR;
            PG8_LDA(At, 0, 1); PG8_STAGE(PG8_SA(0, 0), a2, voffA);
            PG8_BAR; PG8_WAIT_L(0); PG8_MMA(1, 0, At, B0); PG8_BAR; PG8_SCHED;
            PG8_STAGE(PG8_SB(0, 1), b2 + hstep, voffB);
            PG8_WAIT_V(6); PG8_BAR; PG8_MMA(1, 1, At, B1); PG8_BAR;
            PG8_LDB(B0, 1, 0); PG8_SCHED; PG8_LDA(At, 1, 0); PG8_STAGE(PG8_SA(0, 1), a2 + hstep, voffA);
            PG8_WAIT_L(8); PG8_BAR; PG8_WAIT_L(0); PG8_MMA(0, 0, At, B0); PG8_BAR; PG8_SCHED;
            PG8_LDB(B1, 1, 1); PG8_STAGE(PG8_SB(1, 0), b3, voffB);
            PG8_BAR; PG8_WAIT_L(0); PG8_MMA(0, 1, At, B1); PG8_BAR;
            PG8_LDA(At, 1, 1); PG8_STAGE(PG8_SA(1, 0), a3, voffA);
            PG8_BAR; PG8_WAIT_L(0); PG8_MMA(1, 0, At, B0); PG8_BAR; PG8_SCHED;
            PG8_STAGE(PG8_SB(1, 1), b3 + hstep, voffB);
            PG8_WAIT_V(6); PG8_BAR; PG8_MMA(1, 1, At, B1); PG8_BAR;
            }
        }
        if constexpr (ALIGN_EPI) { if (wr == 0) PG8_BAR; }
        if constexpr (!Epi::AFTER_DRAIN) { E(acc, cur, wr, wc, fr, fq); S.done(cur); }
        if (!has_next) break;
#pragma unroll
        for (int a = 0; a < 2; ++a)
#pragma unroll
            for (int b = 0; b < 2; ++b)
#pragma unroll
                for (int m = 0; m < 4; ++m)
#pragma unroll
                    for (int n = 0; n < 2; ++n) acc[a][b][m][n] = (f32x4){0.f, 0.f, 0.f, 0.f};
        cur = nxt; cA = nA; cB = nB; ++ui;
        if constexpr (ALIGN_EPI) { if (wr == 1) PG8_BAR; }
    }
    PG8_WAIT_V(0);
    if constexpr (!ALIGN_EPI) { if (wr == 0) PG8_BAR; }
    PG8_BAR;
    if constexpr (Epi::AFTER_DRAIN) { E.fused(acc, cur, wr, wc, fr, fq, lds, wid, lane); S.done(cur); }
#undef PG8_SA
#undef PG8_SB
#undef PG8_STAGE
#undef PG8_LDA
#undef PG8_LDB
#undef PG8_MMA
#undef PG8_WAIT_V
#undef PG8_WAIT_L
#undef PG8_BAR
#undef PG8_SCHED
}
}

#ifndef PG8_SP2
#define PG8_SP2 true
#endif
#ifndef PG8_ALIGN
#define PG8_ALIGN true
#endif
#define GAS __attribute__((address_space(1)))
#define LAS __attribute__((address_space(3)))
typedef unsigned short bf16;
typedef unsigned v4u __attribute__((ext_vector_type(4)));
typedef float f32x4 __attribute__((ext_vector_type(4)));
typedef short bf16x8 __attribute__((ext_vector_type(8)));
typedef GAS unsigned gu32;
typedef GAS unsigned long long gu64;
#define RLX_AGENT __ATOMIC_RELAXED, __HIP_MEMORY_SCOPE_AGENT
#define LDS_WAIT() asm volatile("s_waitcnt lgkmcnt(0)" ::: "memory")
#define VM_WAIT() asm volatile("s_waitcnt vmcnt(0)" ::: "memory")
__device__ __forceinline__ unsigned long long rt() { return __builtin_amdgcn_s_memrealtime(); }
__device__ __forceinline__ unsigned f2bf(float f) { unsigned u = __builtin_bit_cast(unsigned, f); return (u + 0x7fffu + ((u >> 16) & 1u)) >> 16; }
__device__ __forceinline__ unsigned pk2(float lo, float hi) { return f2bf(lo) | (f2bf(hi) << 16); }

#define XB_TMO      128
#define XB_XCNT(j)  (256  + 64 * (j))
#define XB_XSUB(j)  (1280 + 64 * (j))
#define XB_XGEN(j)  (2304 + 64 * (j))
#define XB_TOP      3328
#define XB_TOPGEN   3392
#define XCD_BAR_WORDS 3456
#define XB_SPIN_CAP (1u << 18)

__device__ __forceinline__ unsigned xb_ld(unsigned* p)              { return __hip_atomic_load(p, __ATOMIC_RELAXED, __HIP_MEMORY_SCOPE_AGENT); }
__device__ __forceinline__ unsigned xb_add(unsigned* p, unsigned v) { return __hip_atomic_fetch_add(p, v, __ATOMIC_RELAXED, __HIP_MEMORY_SCOPE_AGENT); }
__device__ __forceinline__ unsigned xb_xcc_id() { return (unsigned)__builtin_amdgcn_s_getreg((3 << 11) | 20) & 0xFu; }
#define XB_SPIN(cond, bar) do { unsigned _sp = 0; while (cond) { __builtin_amdgcn_s_sleep(1); \
    if ((++_sp & 255u) == 0u) { if (xb_ld(&(bar)[XB_TMO])) break; if (_sp > XB_SPIN_CAP) { atomicAdd(&(bar)[XB_TMO], 1u); break; } } } } while (0)

struct XcdBarrier {
    unsigned* bar; unsigned x;
    volatile LAS unsigned* st;
};

__device__ __forceinline__ XcdBarrier xcd_barrier_post(unsigned* bar, volatile LAS unsigned* st) {
    XcdBarrier b; b.bar = bar; b.x = xb_xcc_id(); b.st = st;
    if (threadIdx.x == 0) (void)xb_add(&bar[XB_XCNT(b.x)], 1u);
    return b;
}
__device__ __forceinline__ void xcd_barrier_complete(unsigned* bar, unsigned x, unsigned& nloc, unsigned& nx) {
    const unsigned G = gridDim.x * gridDim.y * gridDim.z;
    unsigned sum, cnt, mine, sp = 0u;
    for (;;) {
        sum = 0u; cnt = 0u; mine = 0u;
#pragma unroll
        for (unsigned j = 0; j < 16; ++j) { const unsigned c = xb_ld(&bar[XB_XCNT(j)]); sum += c; cnt += (c > 0u) ? 1u : 0u; mine = (j == x) ? c : mine; }
        if (sum == G) break;
        __builtin_amdgcn_s_sleep(1);
        if ((++sp & 255u) == 0u) { if (xb_ld(&bar[XB_TMO])) break; if (sp > XB_SPIN_CAP) { atomicAdd(&bar[XB_TMO], 1u); break; } }
    }
    nloc = mine > 0u ? mine : 1u; nx = cnt > 0u ? cnt : 1u;
}

__device__ __forceinline__ void xcd_barrier(const XcdBarrier& b) {
    asm volatile("s_waitcnt vmcnt(0)" ::: "memory");
    __syncthreads();
    if (threadIdx.x == 0) {
        unsigned* bar = b.bar;
        __builtin_amdgcn_s_waitcnt(0);
        unsigned nloc = b.st[0], nx = b.st[1];
        if (nloc == 0u) { xcd_barrier_complete(bar, b.x, nloc, nx); b.st[0] = nloc; b.st[1] = nx; }
        const unsigned old = xb_add(&bar[XB_XSUB(b.x)], 1u);
        const unsigned gen = old / nloc;
        if (old + 1u == (gen + 1u) * nloc) {
            __builtin_amdgcn_fence(__ATOMIC_RELEASE, "agent");
            asm volatile("s_waitcnt vmcnt(0)" ::: "memory");
            const unsigned og = xb_add(&bar[XB_TOP], 1u);
            const unsigned tg = og / nx;
            if (og + 1u == (tg + 1u) * nx) xb_add(&bar[XB_TOPGEN], 1u);
            else XB_SPIN(xb_ld(&bar[XB_TOPGEN]) == tg, bar);
            __builtin_amdgcn_fence(__ATOMIC_ACQUIRE, "agent");
            xb_add(&bar[XB_XGEN(b.x)], 1u);
            asm volatile("s_waitcnt vmcnt(0)" ::: "memory");
        } else {
            XB_SPIN(xb_ld(&bar[XB_XGEN(b.x)]) == gen, bar);
            __builtin_amdgcn_fence(__ATOMIC_ACQUIRE, "agent");
            asm volatile("s_waitcnt vmcnt(0)" ::: "memory");
        }
    }
    __syncthreads();
}

constexpr int BATCH = 2, SEQ = 16384, DM = 1024, TT = BATCH * SEQ, NPROJ = 3584, DFF = 2816, NUP = 2 * DFF, NPANEL = TT / 256;
constexpr int NH = 8, HD = 64, HW = 512;
constexpr float EPS = 1e-6f;
#ifndef MK_DUP
#define MK_DUP 0
#endif
#ifndef MK_ONE_LAUNCH
#define MK_ONE_LAUNCH 0
#endif

constexpr size_t MiB = 1u << 20;
constexpr size_t WS_CTL = 0, CTL_ZERO_BYTES = 1 * MiB;
constexpr size_t WS_WIN = 1 * MiB, WS_WOUT = 8 * MiB, WS_WUP = 10 * MiB, WS_WDN = 21 * MiB;
constexpr size_t WS_CS = 27 * MiB;
constexpr size_t WS_SMALL = 31 * MiB;
constexpr size_t SM_BIASD = 0, SM_DPOS = 8192, SM_DNEG = 16384, SM_GAM = 24576, SM_G256 = 24576 + 64;
constexpr size_t WS_KMS = 32 * MiB;
constexpr size_t WS_ROWSS = 33 * MiB;
constexpr size_t WS_SEL = 35 * MiB;
constexpr size_t WS_RUNS = 36 * MiB, WS_CNTW = 38 * MiB;
constexpr size_t WS_KV = 40 * MiB, WS_RP = 56 * MiB;
constexpr size_t WS_XN = 72 * MiB;
constexpr size_t WS_PROJ = 136 * MiB;
constexpr size_t PROJ_SEG = (size_t)TT * 512 * 2;
constexpr size_t WS_Y = 360 * MiB;
constexpr size_t WS_Y1 = 136 * MiB;
constexpr size_t WS_U = 136 * MiB;
constexpr size_t WS_F = 312 * MiB;
constexpr size_t WS_PO01 = 72 * MiB, WS_PO23 = 424 * MiB, PO_SLOT = (size_t)TT * 512 * 2;
constexpr size_t WS_ML = 488 * MiB;
constexpr size_t WS_END = 496 * MiB;
constexpr int CW_TOT = 49152;
constexpr int CW_Q = 8192;
constexpr int CW_BAR = 4096;

typedef unsigned u32x4v __attribute__((ext_vector_type(4)));
typedef unsigned u32x2v __attribute__((ext_vector_type(2)));

__device__ __forceinline__ float bflo(unsigned w) { return __uint_as_float(w << 16); }
__device__ __forceinline__ float bfhi(unsigned w) { return __uint_as_float(w & 0xffff0000u); }
__device__ __forceinline__ float bf1(bf16 b) { return __uint_as_float((unsigned)b << 16); }

namespace pg8 {
struct EpiProj {
    static constexpr bool PERM = true, AFTER_DRAIN = false;
    bf16_t* proj; const float* cs; const float* dpos; const float* dneg; float* kms;
    __device__ __forceinline__ void operator()(const f32x4 (&acc)[2][2][4][2], const Unit& u, int wr, int wc, int fr, int fq) const {
        const int seg = u.pn >> 1, cb = (u.pn & 1) * 256;
        bf16_t* base = proj + (size_t)seg * ((size_t)TT * 512);
        const int row0 = u.pm * BM + wr * 64 + fr, colw = cb + wc * 32 + 8 * fq;
        if (seg == 3 || seg == 4) {
            const int i0 = 16 * (wc & 1) + 4 * fq;
#pragma unroll
            for (int ai = 0; ai < 2; ++ai)
#pragma unroll
                for (int m = 0; m < 4; ++m) {
                    const int row = row0 + ai * HALF + m * 16, t = row & (SEQ - 1), tl = t & 255;
                    const f32x4 c01 = *(const f32x4*)(cs + ((size_t)t * 32 + i0) * 2), c23 = *(const f32x4*)(cs + ((size_t)t * 32 + i0) * 2 + 4);
                    bf16_t* rowp = base + (size_t)row * 512 + colw;
#pragma unroll
                    for (int bj = 0; bj < 2; ++bj) {
                        const int head = (cb >> 6) + bj * 2 + (wc >> 1);
                        const float ds = (seg == 3) ? dpos[head * 256 + tl] : 0.125f * dneg[head * 256 + tl];
                        const f32x4 v0 = acc[ai][bj][m][0], v1 = acc[ai][bj][m][1];
                        u32x4 w;
                        w.x = cvt_pk_bf16((v0[0] * c01[0] - v0[1] * c01[1]) * ds, (v0[0] * c01[1] + v0[1] * c01[0]) * ds);
                        w.y = cvt_pk_bf16((v0[2] * c01[2] - v0[3] * c01[3]) * ds, (v0[2] * c01[3] + v0[3] * c01[2]) * ds);
                        w.z = cvt_pk_bf16((v1[0] * c23[0] - v1[1] * c23[1]) * ds, (v1[0] * c23[1] + v1[1] * c23[0]) * ds);
                        w.w = cvt_pk_bf16((v1[2] * c23[2] - v1[3] * c23[3]) * ds, (v1[2] * c23[3] + v1[3] * c23[2]) * ds);
                        *(u32x4*)(rowp + bj * HALF) = w;
                    }
                }
        } else {
            const float sc = (seg == 0) ? 0.18033688011112042f : 1.0f;
#pragma unroll
            for (int ai = 0; ai < 2; ++ai)
#pragma unroll
                for (int m = 0; m < 4; ++m) {
                    bf16_t* rowp = base + (size_t)(row0 + ai * HALF + m * 16) * 512 + colw;
#pragma unroll
                    for (int bj = 0; bj < 2; ++bj) {
                        const f32x4 v0 = acc[ai][bj][m][0] * sc, v1 = acc[ai][bj][m][1] * sc;
                        u32x4 w; w.x = cvt_pk_bf16(v0[0], v0[1]); w.y = cvt_pk_bf16(v0[2], v0[3]); w.z = cvt_pk_bf16(v1[0], v1[1]); w.w = cvt_pk_bf16(v1[2], v1[3]);
                        *(u32x4*)(rowp + bj * HALF) = w;
                    }
                }
            if (seg == 1) {
#pragma unroll
                for (int bj = 0; bj < 2; ++bj)
#pragma unroll
                    for (int n = 0; n < 2; ++n) {
                        f32x4 s = acc[0][bj][0][n];
#pragma unroll
                        for (int m = 1; m < 4; ++m) s += acc[0][bj][m][n];
#pragma unroll
                        for (int m = 0; m < 4; ++m) s += acc[1][bj][m][n];
#pragma unroll
                        for (int o = 1; o < 16; o <<= 1) { s[0] += __shfl_xor(s[0], o); s[1] += __shfl_xor(s[1], o); s[2] += __shfl_xor(s[2], o); s[3] += __shfl_xor(s[3], o); }
                        if (fr == 0) *(f32x4*)(kms + ((size_t)wr * NPANEL + u.pm) * 512 + colw + bj * HALF + 4 * n) = s;
                    }
            }
        }
    }
};
struct EpiY {
    static constexpr bool PERM = true, AFTER_DRAIN = false;
    bf16_t* Y; float* rowss;
    __device__ __forceinline__ void operator()(const f32x4 (&acc)[2][2][4][2], const Unit& u, int wr, int wc, int fr, int fq) const {
        const int row0 = u.pm * BM + wr * 64 + fr, colw = u.pn * BM + wc * 32 + 8 * fq;
#pragma unroll
        for (int ai = 0; ai < 2; ++ai)
#pragma unroll
            for (int m = 0; m < 4; ++m) {
                const int row = row0 + ai * HALF + m * 16;
                bf16_t* rowp = Y + (size_t)row * 1024 + colw; float ss = 0.f;
#pragma unroll
                for (int bj = 0; bj < 2; ++bj) {
                    const f32x4 v0 = acc[ai][bj][m][0], v1 = acc[ai][bj][m][1];
                    ss += (v0[0] * v0[0] + v0[1] * v0[1]) + (v0[2] * v0[2] + v0[3] * v0[3]) + (v1[0] * v1[0] + v1[1] * v1[1]) + (v1[2] * v1[2] + v1[3] * v1[3]);
                    u32x4 w; w.x = cvt_pk_bf16(v0[0], v0[1]); w.y = cvt_pk_bf16(v0[2], v0[3]); w.z = cvt_pk_bf16(v1[0], v1[1]); w.w = cvt_pk_bf16(v1[2], v1[3]);
                    *(u32x4*)(rowp + bj * HALF) = w;
                }
                ss += __shfl_xor(ss, 16); ss += __shfl_xor(ss, 32);
                if (fq == 0) rowss[(size_t)row * 16 + u.pn * 4 + wc] = ss;
            }
    }
};
struct EpiFfn {
    static constexpr bool PERM = true, AFTER_DRAIN = false;
    bf16_t* Fo; const float* cw; const float* cb; PG8_LAS float* xch;
    __device__ __forceinline__ void operator()(const f32x4 (&acc)[2][2][4][2], const Unit& u, int wr, int wc, int fr, int fq) const {
        const int b = u.pm / 65, i = u.pm - 65 * b, t0 = 254 * i - 2, lane = fr + 16 * fq;
        if (fr >= 14) {
#pragma unroll
            for (int ai = 0; ai < 2; ++ai) { PG8_LAS f32x4* d = (PG8_LAS f32x4*)(xch + ((((wr * 4 + wc) * 2 + ai) * 2 + (fr - 14)) * 4 + fq) * 16);
                d[0] = acc[ai][0][3][0]; d[1] = acc[ai][0][3][1]; d[2] = acc[ai][1][3][0]; d[3] = acc[ai][1][3][1]; }
        }
        asm volatile("s_waitcnt lgkmcnt(0)\n\ts_barrier" ::: "memory");
        const int c0 = u.pn * 128 + wc * 32 + 8 * fq;
        const int a1 = ((lane & 48) | ((fr + 15) & 15)) * 4, a2 = ((lane & 48) | ((fr + 14) & 15)) * 4;
        const f32x4 z4 = {0.f, 0.f, 0.f, 0.f};
#pragma unroll
        for (int n = 0; n < 2; ++n) {
            f32x4 w[3][2], bs[2];
#pragma unroll
            for (int bj = 0; bj < 2; ++bj) { bs[bj] = *(const f32x4*)(cb + bj * DFF + c0 + 4 * n);
#pragma unroll
                for (int j = 0; j < 3; ++j) w[j][bj] = *(const f32x4*)(cw + (size_t)j * NUP + bj * DFF + c0 + 4 * n); }
#pragma unroll
            for (int ai = 0; ai < 2; ++ai) {
                f32x4 r1[2], r2[2];
                { const bool has = (wr == 1) || (ai == 1); const int sw = (wr == 1) ? wc : 4 + wc, sa = (wr == 1) ? ai : 0;
                  const PG8_LAS f32x4* s15 = (const PG8_LAS f32x4*)(xch + (((sw * 2 + sa) * 2 + 1) * 4 + fq) * 16); const PG8_LAS f32x4* s14 = (const PG8_LAS f32x4*)(xch + (((sw * 2 + sa) * 2 + 0) * 4 + fq) * 16);
#pragma unroll
                  for (int bj = 0; bj < 2; ++bj) { r1[bj] = has ? s15[bj * 2 + n] : z4; r2[bj] = has ? s14[bj * 2 + n] : z4; } }
#pragma unroll
                for (int m = 0; m < 4; ++m) {
                    f32x4 x[2];
#pragma unroll
                    for (int bj = 0; bj < 2; ++bj) {
                        f32x4 cur = acc[ai][bj][m][n];
                        if (m == 0 && ai == 0) { if (i == 0 && wr == 0 && fr < 2) cur = z4; }
                        f32x4 s1, s2;
#pragma unroll
                        for (int k = 0; k < 4; ++k) { s1[k] = __int_as_float(__builtin_amdgcn_ds_bpermute(a1, __float_as_int(cur[k]))); s2[k] = __int_as_float(__builtin_amdgcn_ds_bpermute(a2, __float_as_int(cur[k]))); }
                        f32x4 p1, p2;
                        if (m == 0) { p1 = fr == 0 ? r1[bj] : s1; p2 = fr == 0 ? r2[bj] : (fr == 1 ? r1[bj] : s2); }
                        else { p1 = fr == 0 ? r1[bj] : s1; p2 = fr < 2 ? r2[bj] : s2; }
                        r1[bj] = s1; r2[bj] = s2;
                        x[bj] = bs[bj] + w[0][bj] * p2 + w[1][bj] * p1 + w[2][bj] * cur;
                    }
                    const int r = ai * HALF + wr * 64 + m * 16 + fr, t = t0 + r;
                    if (r >= 2 && t < 16384) {
                        unsigned o0, o1;
#define FFN_G(a, bv) ({ const float z_ = 0.7978845608028654f * ((a) + 0.044715f * (a) * (a) * (a)); (a) * (1.0f - 1.0f / (__expf(2.0f * z_) + 1.0f)) * (bv); })
                        o0 = cvt_pk_bf16(FFN_G(x[0][0], x[1][0]), FFN_G(x[0][1], x[1][1])); o1 = cvt_pk_bf16(FFN_G(x[0][2], x[1][2]), FFN_G(x[0][3], x[1][3]));
#undef FFN_G
                        typedef unsigned u32x2e __attribute__((ext_vector_type(2)));
                        *(u32x2e*)(Fo + ((size_t)b * 16384 + t) * DFF + c0 + 4 * n) = (u32x2e){o0, o1};
                    }
                }
            }
        }
    }
};
}

constexpr int RING_OFF = 0, RING_BYTES = 131072;
constexpr int LDSCTL_OFF = RING_BYTES, MISC_OFF = LDSCTL_OFF + 320;
constexpr int LDS_BYTES = 163840;
constexpr int XCH_OFF = 139264;
constexpr int NWAVES = 8;

struct Frame {
    LAS unsigned char* lds; volatile LAS unsigned* MISC; gu32* ctl;
    int tid, lane, wave, vcu, G;
    const float *x, *g_mix_pre, *w_in, *rel_bias, *w_out, *g_mix_post, *g_ffn_pre, *w_up, *conv_w, *conv_b, *w_down, *g_ffn_post;
    float* out;
    bf16 *Win_t, *Wout_t, *Wup_t, *Wdn_t, *XN, *PROJ, *Y, *Y1, *U, *Fb;
    float *cs, *biasd, *dpos, *dneg, *gam, *g256, *kms, *rowss, *KV, *RP;
    unsigned* sel; unsigned short* LISTG; bf16 *PO01, *PO23; float* ML;
};

__device__ __forceinline__ float wave_sum(float v) {
#pragma unroll
    for (int o = 1; o < 64; o <<= 1) v += __shfl_xor(v, o);
    return v;
}

template <int MODE> __device__ __forceinline__ int src_col(int n) {
    if (MODE == 2) return ((n >> 7) & 1) * DFF + (n >> 8) * 128 + (n & 127);
    if (MODE == 1) { const int seg = n >> 9; if (seg == 3 || seg == 4) { const int p = n & 63; return (n & ~63) + (p >> 1) + 32 * (p & 1); } }
    return n;
}
template <int MODE> __device__ __forceinline__ void p0_transpose_item(const float* W, const float* gain, int K, int N, bf16* WT, LAS float* scr, int item, int lane) {
    const int nblk = N / 32, kb = item / nblk, nb = item % nblk, k0 = 64 * kb, n0 = 32 * nb;
    const int sc = src_col<MODE>(n0 + (lane & 31));
#pragma unroll 8
    for (int i = 0; i < 32; ++i) { const int kk = 2 * i + (lane >> 5); const float g = gain ? gain[k0 + kk] : 1.0f; scr[kk * 33 + (lane & 31)] = W[(size_t)(k0 + kk) * N + sc] * g; }
    LDS_WAIT(); asm volatile("" ::: "memory");
    const int c = lane & 7;
#pragma unroll
    for (int j = 0; j < 4; ++j) { const int n = (lane >> 3) + 8 * j; const LAS float* s = scr + (8 * c) * 33 + n;
        v4u o; o.x = pk2(s[0 * 33], s[1 * 33]); o.y = pk2(s[2 * 33], s[3 * 33]); o.z = pk2(s[4 * 33], s[5 * 33]); o.w = pk2(s[6 * 33], s[7 * 33]);
        *(GAS v4u*)(WT + (size_t)(n0 + n) * K + k0 + 8 * c) = o; }
    LDS_WAIT(); asm volatile("" ::: "memory");
}
__device__ __forceinline__ int t5_bucket(int n) {
    if (n < 16) return n;
    int l = 16 + (int)(__logf((float)n * (1.0f / 16.0f)) / __logf(8.0f) * 16.0f);
    return l < 31 ? l : 31;
}
__device__ __forceinline__ void p0_prologue(Frame& F) {
    LAS float* scr = (LAS float*)(F.lds + RING_OFF + F.wave * 16384);
    const int gw = F.vcu * NWAVES + F.wave, NGW = F.G * NWAVES;
    constexpr int I_IN = (DM / 64) * (NPROJ / 32), I_OUT = (DM / 64) * (DM / 32), I_UP = (DM / 64) * (NUP / 32), I_DN = (DFF / 64) * (DM / 32);
    for (int it = gw; it < I_IN + I_OUT + I_UP + I_DN; it += NGW) {
        int r = it;
        if (r < I_IN) { p0_transpose_item<1>(F.w_in, F.g_mix_pre, DM, NPROJ, F.Win_t, scr, r, F.lane); continue; } r -= I_IN;
        if (r < I_OUT) { p0_transpose_item<0>(F.w_out, nullptr, DM, DM, F.Wout_t, scr, r, F.lane); continue; } r -= I_OUT;
        if (r < I_UP) { p0_transpose_item<2>(F.w_up, F.g_ffn_pre, DM, NUP, F.Wup_t, scr, r, F.lane); continue; } r -= I_UP;
        p0_transpose_item<0>(F.w_down, nullptr, DFF, DM, F.Wdn_t, scr, r, F.lane);
    }
    for (int m = gw; m < TT; m += NGW) {
        const GAS f32x4* xr = (const GAS f32x4*)(F.x + (size_t)m * DM) + F.lane;
        f32x4 v[4]; float s = 0.f;
#pragma unroll
        for (int j = 0; j < 4; ++j) { v[j] = xr[64 * j]; s += (v[j].x * v[j].x + v[j].y * v[j].y) + (v[j].z * v[j].z + v[j].w * v[j].w); }
        const float rstd = 1.0f / sqrtf(wave_sum(s) * (1.f / DM) + EPS);
        GAS unsigned long long* o8 = (GAS unsigned long long*)(F.XN + (size_t)m * DM) + F.lane;
#pragma unroll
        for (int j = 0; j < 4; ++j) o8[64 * j] = (unsigned long long)pk2(v[j].x * rstd, v[j].y * rstd) | ((unsigned long long)pk2(v[j].z * rstd, v[j].w * rstd) << 32);
    }
    const int gt = blockIdx.x * (NWAVES * 64) + F.tid, NT = F.G * NWAVES * 64;
    for (int i = gt; i < SEQ * 32; i += NT) {
        const int t = i >> 5, k = i & 31;
        double inv = 1.0; for (int q = 0; q < k; ++q) inv *= 0.74989420933245582730;
        const float ang = (float)t * (float)inv;
        const double rev = (double)ang * 0.15915494309189533577; const double fr = rev - __builtin_rint(rev);
        F.cs[2 * i] = __builtin_amdgcn_cosf((float)fr); F.cs[2 * i + 1] = __builtin_amdgcn_sinf((float)fr);
    }
    for (int i = gt; i < NH * 256; i += NT) {
        const int h = i >> 8, n = i & 255; const double g = 1.0 - 1.0 / (double)(32 << h);
        double p = 1.0; for (int q = 0; q < n; ++q) p *= g;
        F.dpos[i] = (float)p; F.dneg[i] = (float)(1.0 / p);
        if (n == 255) { F.gam[h] = (float)g; F.g256[h] = (float)(p * g); }
    }
    for (int i = gt; i < NH * 132; i += NT) { const int h = i / 132, d = i % 132; F.biasd[i] = F.rel_bias[t5_bucket(d < 128 ? d : 128) * NH + h]; }
}

__device__ __forceinline__ void p2_gate(Frame& F) {
    LAS float* km = (LAS float*)(F.lds + RING_OFF);
    LAS int* hist = (LAS int*)(F.lds + RING_OFF + 16384);
    const bf16* QA = F.PROJ;
    for (int it = blockIdx.x; it < 512; it += F.G) {
        const int cp = it < 256 ? 31 - (it & 31) : (it & 31), bh = it >> 5, b = bh >> 3, h = bh & 7, c0 = 2 * cp, nj = c0 + 1;
        __syncthreads();
        if (F.tid < 384) hist[F.tid] = 0;
        for (int i = F.tid; i < nj * 64; i += NWAVES * 64) { const int j = i >> 6, d = i & 63; const size_t o = (size_t)(b * 64 + j) * 512 + h * 64 + d;
            km[i] = (F.kms[o] + F.kms[(size_t)NPANEL * 512 + o]) * (1.0f / 256.0f); }
        __syncthreads();
        const int t = c0 * 256 + F.tid, c = t >> 8; const size_t row = (size_t)b * SEQ + t;
        float q[64];
        { const GAS u32x4v* qp = (const GAS u32x4v*)(QA + row * 512 + h * 64);
#pragma unroll
          for (int i = 0; i < 8; ++i) { const u32x4v w = qp[i]; q[8 * i] = bflo(w.x); q[8 * i + 1] = bfhi(w.x); q[8 * i + 2] = bflo(w.y); q[8 * i + 3] = bfhi(w.y); q[8 * i + 4] = bflo(w.z); q[8 * i + 5] = bfhi(w.z); q[8 * i + 6] = bflo(w.w); q[8 * i + 7] = bfhi(w.w); } }
        float v0 = -INFINITY, v1 = -INFINITY, v2 = -INFINITY; unsigned i0 = 255u, i1 = 255u, i2 = 255u;
        for (int j = 0; j < c; ++j) {
            const LAS f32x4* kp = (const LAS f32x4*)(km + j * 64); float g = 0.f;
#pragma unroll
            for (int i = 0; i < 16; ++i) { const f32x4 k4 = kp[i]; g += q[4 * i] * k4.x + q[4 * i + 1] * k4.y + q[4 * i + 2] * k4.z + q[4 * i + 3] * k4.w; }
            if (g > v0) { v2 = v1; i2 = i1; v1 = v0; i1 = i0; v0 = g; i0 = (unsigned)j; }
            else if (g > v1) { v2 = v1; i2 = i1; v1 = g; i1 = (unsigned)j; }
            else if (g > v2) { v2 = g; i2 = (unsigned)j; }
        }
        F.sel[row * 8 + h] = i0 | (i1 << 8) | (i2 << 16);
        const int half = F.tid >> 8, tl = F.tid & 255;
        if (i0 != 255u) atomicAdd((int*)&hist[half * 64 + i0], 1);
        if (i1 != 255u) atomicAdd((int*)&hist[half * 64 + i1], 1);
        if (i2 != 255u) atomicAdd((int*)&hist[half * 64 + i2], 1);
        __syncthreads();
        if (F.tid < 128) { const int v = hist[F.tid];
            hist[128 + F.tid] = v ? (int)__hip_atomic_fetch_add(F.ctl + CW_TOT + bh * 64 + (F.tid & 63), (unsigned)v, RLX_AGENT) : 0; }
        __syncthreads();
        unsigned short* lg = F.LISTG + (size_t)bh * 64 * 16384; const unsigned ent = ((unsigned)c << 10) | (unsigned)tl;
        if (i0 != 255u) lg[(size_t)i0 * 16384 + hist[128 + half * 64 + i0] + atomicAdd((int*)&hist[256 + half * 64 + i0], 1)] = (unsigned short)(ent);
        if (i1 != 255u) lg[(size_t)i1 * 16384 + hist[128 + half * 64 + i1] + atomicAdd((int*)&hist[256 + half * 64 + i1], 1)] = (unsigned short)(ent | 256u);
        if (i2 != 255u) lg[(size_t)i2 * 16384 + hist[128 + half * 64 + i2] + atomicAdd((int*)&hist[256 + half * 64 + i2], 1)] = (unsigned short)(ent | 512u);
    }
}
__device__ __forceinline__ void p2_kv_simple(Frame& F) {
    const bf16* KR = F.PROJ + 4 * (size_t)TT * 512; const bf16* VR = F.PROJ + 5 * (size_t)TT * 512;
    for (int it = blockIdx.x; it < 1024; it += F.G) {
        const int b = it >> 9, h = (it >> 6) & 7, c = it & 63; const size_t row0 = (size_t)b * SEQ + c * 256;
        const int d = F.tid >> 3, e0 = (F.tid & 7) * 8; float a[8];
#pragma unroll
        for (int i = 0; i < 8; ++i) a[i] = 0.f;
        for (int m = 0; m < 256; ++m) {
            const float kk = bf1(KR[(row0 + m) * 512 + h * 64 + d]);
            const u32x4v w = *(const GAS u32x4v*)(VR + (row0 + m) * 512 + h * 64 + e0);
            a[0] += kk * bflo(w.x); a[1] += kk * bfhi(w.x); a[2] += kk * bflo(w.y); a[3] += kk * bfhi(w.y); a[4] += kk * bflo(w.z); a[5] += kk * bfhi(w.z); a[6] += kk * bflo(w.w); a[7] += kk * bfhi(w.w);
        }
        const float sc = F.dpos[h * 256 + 255];
#pragma unroll
        for (int i = 0; i < 8; ++i) F.KV[(size_t)it * 4096 + d * 64 + e0 + i] = a[i] * sc;
    }
}
__device__ __forceinline__ void p3_scan(Frame& F) {
    const int gt = blockIdx.x * (NWAVES * 64) + F.tid;
    if (gt < 16 * 4096) {
        const int bh = gt >> 12, idx = gt & 4095, h = bh & 7; const float g = F.g256[h]; float st = 0.f;
        for (int c = 0; c < 64; ++c) { const size_t o = ((size_t)(bh * 64 + c)) * 4096 + idx; F.RP[o] = st; st = st * g + F.KV[o]; }
    }
}
__device__ __forceinline__ void p3_moba_simple(Frame& F) {
    const bf16* QA = F.PROJ; const bf16* KA = F.PROJ + (size_t)TT * 512; const bf16* VA = F.PROJ + 2 * (size_t)TT * 512;
    const int gt = blockIdx.x * (NWAVES * 64) + F.tid, NT = F.G * NWAVES * 64;
    for (int idx = gt; idx < TT * NH; idx += NT) {
        const int h = idx >> 15, row = idx & (TT - 1), b = row >> 14, t = row & (SEQ - 1), c = t >> 8;
        float q[64], o[64];
        { const GAS u32x4v* qp = (const GAS u32x4v*)(QA + (size_t)row * 512 + h * 64);
#pragma unroll
          for (int i = 0; i < 8; ++i) { const u32x4v w = qp[i]; q[8 * i] = bflo(w.x); q[8 * i + 1] = bfhi(w.x); q[8 * i + 2] = bflo(w.y); q[8 * i + 3] = bfhi(w.y); q[8 * i + 4] = bflo(w.z); q[8 * i + 5] = bfhi(w.z); q[8 * i + 6] = bflo(w.w); q[8 * i + 7] = bfhi(w.w); } }
#pragma unroll
        for (int i = 0; i < 64; ++i) o[i] = 0.f;
        const unsigned sw = F.sel[(size_t)row * 8 + h]; const float* bd = F.biasd + h * 132;
        float mrun = -3.0e38f, l = 0.f;
        for (int slot = 0; slot < 4; ++slot) {
            const int j = slot < 3 ? (int)((sw >> (8 * slot)) & 255u) : c;
            if (slot < 3 && j >= c) continue;
            const size_t r0 = (size_t)b * SEQ + j * 256;
            for (int s = 0; s < 256; ++s) {
                const int pos = j * 256 + s; if (pos > t) break;
                const GAS u32x4v* kp = (const GAS u32x4v*)(KA + (r0 + s) * 512 + h * 64); float dot = 0.f;
#pragma unroll
                for (int i = 0; i < 8; ++i) { const u32x4v w = kp[i]; dot += q[8 * i] * bflo(w.x) + q[8 * i + 1] * bfhi(w.x) + q[8 * i + 2] * bflo(w.y) + q[8 * i + 3] * bfhi(w.y) + q[8 * i + 4] * bflo(w.z) + q[8 * i + 5] * bfhi(w.z) + q[8 * i + 6] * bflo(w.w) + q[8 * i + 7] * bfhi(w.w); }
                const int dist = t - pos; const float sc = dot + bd[dist < 128 ? dist : 128];
                if (sc > mrun) { const float a = __expf(mrun - sc); l *= a;
#pragma unroll
                    for (int i = 0; i < 64; ++i) o[i] *= a;
                    mrun = sc; }
                const float p = __expf(sc - mrun); l += p;
                const GAS u32x4v* vp = (const GAS u32x4v*)(VA + (r0 + s) * 512 + h * 64);
#pragma unroll
                for (int i = 0; i < 8; ++i) { const u32x4v w = vp[i]; o[8 * i] += p * bflo(w.x); o[8 * i + 1] += p * bfhi(w.x); o[8 * i + 2] += p * bflo(w.y); o[8 * i + 3] += p * bfhi(w.y); o[8 * i + 4] += p * bflo(w.z); o[8 * i + 5] += p * bfhi(w.z); o[8 * i + 6] += p * bflo(w.w); o[8 * i + 7] += p * bfhi(w.w); }
            }
        }
        const float il = 1.0f / l;
        GAS u32x4v* yp = (GAS u32x4v*)(F.Y + (size_t)row * 1024 + h * 64);
#pragma unroll
        for (int i = 0; i < 8; ++i) { u32x4v w; w.x = pk2(o[8 * i] * il, o[8 * i + 1] * il); w.y = pk2(o[8 * i + 2] * il, o[8 * i + 3] * il); w.z = pk2(o[8 * i + 4] * il, o[8 * i + 5] * il); w.w = pk2(o[8 * i + 6] * il, o[8 * i + 7] * il); yp[i] = w; }
    }
}
__device__ __forceinline__ void p4_ret_simple(Frame& F) {
    const bf16* QR = F.PROJ + 3 * (size_t)TT * 512; const bf16* KR = F.PROJ + 4 * (size_t)TT * 512; const bf16* VR = F.PROJ + 5 * (size_t)TT * 512; const bf16* GR = F.PROJ + 6 * (size_t)TT * 512;
    const int gt = blockIdx.x * (NWAVES * 64) + F.tid, NT = F.G * NWAVES * 64;
    for (int idx = gt; idx < TT * NH; idx += NT) {
        const int h = idx >> 15, row = idx & (TT - 1), b = row >> 14, t = row & (SEQ - 1), c = t >> 8, n = t & 255;
        float q[64], y[64];
        { const GAS u32x4v* qp = (const GAS u32x4v*)(QR + (size_t)row * 512 + h * 64);
#pragma unroll
          for (int i = 0; i < 8; ++i) { const u32x4v w = qp[i]; q[8 * i] = bflo(w.x); q[8 * i + 1] = bfhi(w.x); q[8 * i + 2] = bflo(w.y); q[8 * i + 3] = bfhi(w.y); q[8 * i + 4] = bflo(w.z); q[8 * i + 5] = bfhi(w.z); q[8 * i + 6] = bflo(w.w); q[8 * i + 7] = bfhi(w.w); } }
#pragma unroll
        for (int i = 0; i < 64; ++i) y[i] = 0.f;
        const size_t r0 = (size_t)row - n;
        for (int m = 0; m <= n; ++m) {
            const GAS u32x4v* kp = (const GAS u32x4v*)(KR + (r0 + m) * 512 + h * 64); float dot = 0.f;
#pragma unroll
            for (int i = 0; i < 8; ++i) { const u32x4v w = kp[i]; dot += q[8 * i] * bflo(w.x) + q[8 * i + 1] * bfhi(w.x) + q[8 * i + 2] * bflo(w.y) + q[8 * i + 3] * bfhi(w.y) + q[8 * i + 4] * bflo(w.z) + q[8 * i + 5] * bfhi(w.z) + q[8 * i + 6] * bflo(w.w) + q[8 * i + 7] * bfhi(w.w); }
            const GAS u32x4v* vp = (const GAS u32x4v*)(VR + (r0 + m) * 512 + h * 64);
#pragma unroll
            for (int i = 0; i < 8; ++i) { const u32x4v w = vp[i]; y[8 * i] += dot * bflo(w.x); y[8 * i + 1] += dot * bfhi(w.x); y[8 * i + 2] += dot * bflo(w.y); y[8 * i + 3] += dot * bfhi(w.y); y[8 * i + 4] += dot * bflo(w.z); y[8 * i + 5] += dot * bfhi(w.z); y[8 * i + 6] += dot * bflo(w.w); y[8 * i + 7] += dot * bfhi(w.w); }
        }
        const float* R = F.RP + ((size_t)((b * 8 + h) * 64 + c)) * 4096; const float gam = F.gam[h];
        const bf16* qrow = QR + (size_t)row * 512 + h * 64;
        for (int d = 0; d < 64; ++d) {
            const float qd = bf1(qrow[d]) * gam; const GAS f32x4* rp = (const GAS f32x4*)(R + d * 64);
#pragma unroll
            for (int i = 0; i < 16; ++i) { const f32x4 r4 = rp[i]; y[4 * i] += qd * r4.x; y[4 * i + 1] += qd * r4.y; y[4 * i + 2] += qd * r4.z; y[4 * i + 3] += qd * r4.w; }
        }
        float mu = 0.f;
#pragma unroll
        for (int i = 0; i < 64; ++i) mu += y[i];
        mu *= (1.f / 64.f); float var = 0.f;
#pragma unroll
        for (int i = 0; i < 64; ++i) { y[i] -= mu; var += y[i] * y[i]; }
        const float rs = 1.0f / sqrtf(var * (1.f / 64.f) + EPS);
        const GAS u32x4v* gp = (const GAS u32x4v*)(GR + (size_t)row * 512 + h * 64);
        GAS u32x4v* yp = (GAS u32x4v*)(F.Y + (size_t)row * 1024 + 512 + h * 64);
#pragma unroll
        for (int i = 0; i < 8; ++i) { const u32x4v w = gp[i]; float g[8] = {bflo(w.x), bfhi(w.x), bflo(w.y), bfhi(w.y), bflo(w.z), bfhi(w.z), bflo(w.w), bfhi(w.w)}; float r[8];
#pragma unroll
            for (int k = 0; k < 8; ++k) r[k] = g[k] / (1.0f + __expf(-g[k])) * (y[8 * i + k] * rs);
            u32x4v ow; ow.x = pk2(r[0], r[1]); ow.y = pk2(r[2], r[3]); ow.z = pk2(r[4], r[5]); ow.w = pk2(r[6], r[7]); yp[i] = ow; }
    }
}

namespace mx {
typedef __attribute__((ext_vector_type(8))) short bf16x8;
typedef __attribute__((ext_vector_type(4))) short s16x4;
typedef __attribute__((ext_vector_type(16))) float f32x16;
typedef __attribute__((ext_vector_type(4))) unsigned u32x4;
typedef short v4i16_t __attribute__((ext_vector_type(4)));
typedef __attribute__((address_space(3))) const char* lds_cptr;
typedef float f32x2_t __attribute__((ext_vector_type(2))); typedef __bf16 bf16x2_t __attribute__((ext_vector_type(2)));
__device__ __forceinline__ int crow(int r, int hi) { return (r & 3) + 8 * (r >> 2) + 4 * hi; }
__device__ __forceinline__ unsigned cvtpk(float lo, float hi) { f32x2_t v = {lo, hi}; bf16x2_t b = __builtin_convertvector(v, bf16x2_t); return __builtin_bit_cast(unsigned, b); }
__device__ __forceinline__ void glds16(const void* gsrc, unsigned lds_dst) { unsigned keep;
    asm volatile("s_mov_b32 %0, m0\n\ts_mov_b32 m0, %2\n\ts_nop 0\n\tglobal_load_lds_dwordx4 %1, off\n\ts_mov_b32 m0, %0" : "=&s"(keep) : "v"(gsrc), "s"(lds_dst) : "memory"); }
__device__ __forceinline__ s16x4 vtr(lds_cptr p) { return __builtin_bit_cast(s16x4, __builtin_amdgcn_ds_read_tr16_b64_v4i16((__attribute__((address_space(3))) v4i16_t*)p)); }
#define MX_WAIT_BAR() asm volatile("s_waitcnt vmcnt(0) lgkmcnt(0)\n\ts_barrier" ::: "memory")
#define MX_LBAR() asm volatile("s_waitcnt lgkmcnt(0)\n\ts_barrier" ::: "memory")
__device__ __forceinline__ void dma_kimg(const bf16* tile, unsigned lds_img, int wid, int lane) { glds16(tile + (size_t)lane * 512 + wid * 8, (unsigned)__builtin_amdgcn_readfirstlane(lds_img + wid * 1024)); }
__device__ __forceinline__ void dma_timg(const bf16* tile, unsigned lds_img, int wid, int lane) { glds16(tile + (size_t)(16 * (wid & 3) + (lane >> 2)) * 512 + (wid >> 2) * 32 + (lane & 3) * 8, (unsigned)__builtin_amdgcn_readfirstlane(lds_img + wid * 1024)); }
__device__ __forceinline__ void qkt(f32x16& p0, f32x16& p1, lds_cptr kimg, const bf16x8* qr, int r32, int hi) {
    const lds_cptr kb = kimg + hi * 1024 + r32 * 16; const f32x16 z = {};
#pragma unroll
    for (int d0 = 0; d0 < 4; ++d0) {
        const bf16x8 b0 = *(const __attribute__((address_space(3))) bf16x8*)(kb + d0 * 2048), b1 = *(const __attribute__((address_space(3))) bf16x8*)(kb + d0 * 2048 + 512);
        p0 = __builtin_amdgcn_mfma_f32_32x32x16_bf16(b0, qr[d0], d0 == 0 ? z : p0, 0, 0, 0); p1 = __builtin_amdgcn_mfma_f32_32x32x16_bf16(b1, qr[d0], d0 == 0 ? z : p1, 0, 0, 0); }
}
__device__ __forceinline__ bf16x8 tfrag_perm(lds_cptr timg, int ks, int d0, int lane, int hi) {
    const lds_cptr p = timg + ((lane >> 4) & 1) * 32 + (lane & 3) * 8 + (4 * hi + ((lane & 15) >> 2)) * 64 + d0 * 4096 + ks * 1024;
    const s16x4 lo = vtr(p), hh = vtr(p + 512); return (bf16x8){lo[0], lo[1], lo[2], lo[3], hh[0], hh[1], hh[2], hh[3]};
}
__device__ __forceinline__ bf16x8 tfrag_nat(lds_cptr timg, int ks, int d0, int lane, int hi) {
    const lds_cptr p = timg + ((lane >> 4) & 1) * 32 + (lane & 3) * 8 + (8 * hi + ((lane & 15) >> 2)) * 64 + d0 * 4096 + ks * 1024;
    const s16x4 lo = vtr(p), hh = vtr(p + 256); return (bf16x8){lo[0], lo[1], lo[2], lo[3], hh[0], hh[1], hh[2], hh[3]};
}
__device__ __forceinline__ void pv64(f32x16* o, const f32x16& p0, const f32x16& p1, lds_cptr vimg, int lane, int hi) {
    u32x4 w0 = {cvtpk(p0[0], p0[1]), cvtpk(p0[2], p0[3]), cvtpk(p0[4], p0[5]), cvtpk(p0[6], p0[7])}, w1 = {cvtpk(p0[8], p0[9]), cvtpk(p0[10], p0[11]), cvtpk(p0[12], p0[13]), cvtpk(p0[14], p0[15])};
    u32x4 w2 = {cvtpk(p1[0], p1[1]), cvtpk(p1[2], p1[3]), cvtpk(p1[4], p1[5]), cvtpk(p1[6], p1[7])}, w3 = {cvtpk(p1[8], p1[9]), cvtpk(p1[10], p1[11]), cvtpk(p1[12], p1[13]), cvtpk(p1[14], p1[15])};
#pragma unroll
    for (int d0 = 0; d0 < 2; ++d0) {
        o[d0] = __builtin_amdgcn_mfma_f32_32x32x16_bf16(__builtin_bit_cast(bf16x8, w0), tfrag_perm(vimg, 0, d0, lane, hi), o[d0], 0, 0, 0);
        o[d0] = __builtin_amdgcn_mfma_f32_32x32x16_bf16(__builtin_bit_cast(bf16x8, w1), tfrag_perm(vimg, 1, d0, lane, hi), o[d0], 0, 0, 0);
        o[d0] = __builtin_amdgcn_mfma_f32_32x32x16_bf16(__builtin_bit_cast(bf16x8, w2), tfrag_perm(vimg, 2, d0, lane, hi), o[d0], 0, 0, 0);
        o[d0] = __builtin_amdgcn_mfma_f32_32x32x16_bf16(__builtin_bit_cast(bf16x8, w3), tfrag_perm(vimg, 3, d0, lane, hi), o[d0], 0, 0, 0);
    }
}
__device__ __forceinline__ void pv64t(f32x16* ot, const f32x16& p0, const f32x16& p1, lds_cptr vimg, int lane, int hi) {
    u32x4 w0 = {cvtpk(p0[0], p0[1]), cvtpk(p0[2], p0[3]), cvtpk(p0[4], p0[5]), cvtpk(p0[6], p0[7])}, w1 = {cvtpk(p0[8], p0[9]), cvtpk(p0[10], p0[11]), cvtpk(p0[12], p0[13]), cvtpk(p0[14], p0[15])};
    u32x4 w2 = {cvtpk(p1[0], p1[1]), cvtpk(p1[2], p1[3]), cvtpk(p1[4], p1[5]), cvtpk(p1[6], p1[7])}, w3 = {cvtpk(p1[8], p1[9]), cvtpk(p1[10], p1[11]), cvtpk(p1[12], p1[13]), cvtpk(p1[14], p1[15])};
#pragma unroll
    for (int d0 = 0; d0 < 2; ++d0) {
        ot[d0] = __builtin_amdgcn_mfma_f32_32x32x16_bf16(tfrag_perm(vimg, 0, d0, lane, hi), __builtin_bit_cast(bf16x8, w0), ot[d0], 0, 0, 0);
        ot[d0] = __builtin_amdgcn_mfma_f32_32x32x16_bf16(tfrag_perm(vimg, 1, d0, lane, hi), __builtin_bit_cast(bf16x8, w1), ot[d0], 0, 0, 0);
        ot[d0] = __builtin_amdgcn_mfma_f32_32x32x16_bf16(tfrag_perm(vimg, 2, d0, lane, hi), __builtin_bit_cast(bf16x8, w2), ot[d0], 0, 0, 0);
        ot[d0] = __builtin_amdgcn_mfma_f32_32x32x16_bf16(tfrag_perm(vimg, 3, d0, lane, hi), __builtin_bit_cast(bf16x8, w3), ot[d0], 0, 0, 0);
    }
}
__device__ __forceinline__ void qkt_c(f32x16& p0, f32x16& p1, lds_cptr kimg, const bf16x8* qr, const f32x16& c, int r32, int hi) {
    const lds_cptr kb = kimg + hi * 1024 + r32 * 16;
#pragma unroll
    for (int d0 = 0; d0 < 4; ++d0) {
        const bf16x8 b0 = *(const __attribute__((address_space(3))) bf16x8*)(kb + d0 * 2048), b1 = *(const __attribute__((address_space(3))) bf16x8*)(kb + d0 * 2048 + 512);
        p0 = __builtin_amdgcn_mfma_f32_32x32x16_bf16(b0, qr[d0], d0 == 0 ? c : p0, 0, 0, 0); p1 = __builtin_amdgcn_mfma_f32_32x32x16_bf16(b1, qr[d0], d0 == 0 ? c : p1, 0, 0, 0); }
}
__device__ __forceinline__ float max3f(float a, float b, float c) { float r; asm("v_max3_f32 %0, %1, %2, %3" : "=v"(r) : "v"(a), "v"(b), "v"(c)); return r; }
__device__ __forceinline__ float rowmax32(const f32x16& p0, const f32x16& p1) {
    float a = max3f(p0[0], p0[1], p1[0]), b = max3f(p0[2], p0[3], p1[1]); a = max3f(a, p1[2], p1[3]);
#pragma unroll
    for (int r = 4; r < 16; r += 4) { a = max3f(a, p0[r], p0[r + 1]); b = max3f(b, p0[r + 2], p0[r + 3]); a = max3f(a, p1[r], p1[r + 1]); b = max3f(b, p1[r + 2], p1[r + 3]); }
    const float m = max3f(a, b, b);
    auto rr = __builtin_amdgcn_permlane32_swap(__float_as_uint(m), __float_as_uint(m), false, false);
    return max3f(__uint_as_float(rr[0]), __uint_as_float(rr[1]), m);
}
#define MX_MFMA_PAD(a, b) asm volatile("s_nop 15\n\ts_nop 7" : "+v"(a), "+v"(b))
__device__ __forceinline__ float halfsum(float v) { auto rr = __builtin_amdgcn_permlane32_swap(__float_as_uint(v), __float_as_uint(v), false, false); return __uint_as_float(rr[0]) + __uint_as_float(rr[1]); }
__device__ __forceinline__ void ot_pack16(const f32x16& v, int k, u32x4& out) {
    unsigned ax = cvtpk(v[8 * k + 0], v[8 * k + 1]), ay = cvtpk(v[8 * k + 2], v[8 * k + 3]), bx = cvtpk(v[8 * k + 4], v[8 * k + 5]), by = cvtpk(v[8 * k + 6], v[8 * k + 7]);
    { auto r = __builtin_amdgcn_permlane32_swap(ax, bx, false, false); ax = r[0]; bx = r[1]; }
    { auto r = __builtin_amdgcn_permlane32_swap(ay, by, false, false); ay = r[0]; by = r[1]; }
    out = (u32x4){ax, ay, bx, by};
}
constexpr int L_K = 0, L_V = 32768, L_R = 65536, L_LIST = 65536, L_STG = 98304;
}

__device__ __forceinline__ void p2_kv_mfma(Frame& F) {
    using namespace mx;
    const bf16* KR = F.PROJ + 4 * (size_t)TT * 512; const bf16* VR = F.PROJ + 5 * (size_t)TT * 512;
    const int wid = F.wave, lane = F.lane, r32 = lane & 31, hi = lane >> 5;
    const unsigned lds0 = (unsigned)(size_t)F.lds; const lds_cptr L = (lds_cptr)F.lds;
    for (int it = blockIdx.x; it < 1024; it += F.G) {
        const int b = it >> 9, h = (it >> 6) & 7, c = it & 63; const size_t row0 = (size_t)b * SEQ + c * 256;
        MX_LBAR();
#pragma unroll
        for (int kt = 0; kt < 4; ++kt) { dma_timg(KR + (row0 + 64 * kt) * 512 + h * 64, lds0 + L_K + kt * 8192, wid, lane); dma_timg(VR + (row0 + 64 * kt) * 512 + h * 64, lds0 + L_V + kt * 8192, wid, lane); }
        MX_WAIT_BAR();
        const int dt = wid & 1, et = (wid >> 1) & 1, kh = wid >> 2; f32x16 acc = {};
#pragma unroll
        for (int k = 0; k < 8; ++k) { const int kt = 2 * kh + (k >> 2), ks = k & 3;
            acc = __builtin_amdgcn_mfma_f32_32x32x16_bf16(tfrag_perm(L + L_K + kt * 8192, ks, dt, lane, hi), tfrag_perm(L + L_V + kt * 8192, ks, et, lane, hi), acc, 0, 0, 0); }
        LAS float* red = (LAS float*)(F.lds + L_STG) + (wid & 3) * 1024;
        if (kh == 1) {
#pragma unroll
            for (int r = 0; r < 16; ++r) red[r * 64 + lane] = acc[r];
        }
        MX_LBAR();
        if (kh == 0) { const float sc = F.dpos[h * 256 + 255]; float* dst = F.KV + (size_t)it * 4096 + (32 * dt + 4 * hi) * 64 + 32 * et + r32;
#pragma unroll
            for (int r = 0; r < 16; ++r) dst[((r & 3) + 8 * (r >> 2)) * 64] = (acc[r] + red[r * 64 + lane]) * sc; }
    }
    MX_LBAR();
}
__device__ __forceinline__ void p4_ret_mfma(Frame& F) {
    using namespace mx;
    const bf16* QR = F.PROJ + 3 * (size_t)TT * 512; const bf16* KR = F.PROJ + 4 * (size_t)TT * 512; const bf16* VR = F.PROJ + 5 * (size_t)TT * 512; const bf16* GR = F.PROJ + 6 * (size_t)TT * 512;
    const int wid = F.wave, lane = F.lane, r32 = lane & 31, hi = lane >> 5;
    const unsigned lds0 = (unsigned)(size_t)F.lds; const lds_cptr L = (lds_cptr)F.lds;
    for (int it = blockIdx.x; it < 1024; it += F.G) {
        const int b = it >> 9, h = (it >> 6) & 7, c = it & 63; const size_t row0 = (size_t)b * SEQ + c * 256;
        MX_LBAR();
#pragma unroll
        for (int kt = 0; kt < 4; ++kt) { dma_kimg(KR + (row0 + 64 * kt) * 512 + h * 64, lds0 + L_K + kt * 8192, wid, lane); dma_timg(VR + (row0 + 64 * kt) * 512 + h * 64, lds0 + L_V + kt * 8192, wid, lane); }
        {
            const int d = F.tid >> 3, e0 = (F.tid & 7) * 8; const float g = F.gam[h];
            const GAS f32x4* rp = (const GAS f32x4*)(F.RP + (size_t)it * 4096 + d * 64 + e0); const f32x4 a = rp[0], bq = rp[1];
            u32x4 w = {cvtpk(a.x * g, a.y * g), cvtpk(a.z * g, a.w * g), cvtpk(bq.x * g, bq.y * g), cvtpk(bq.z * g, bq.w * g)};
            *(LAS u32x4*)(F.lds + L_R + ((e0 >> 5) * 4 + (d >> 4)) * 1024 + (d & 15) * 64 + (e0 & 31) * 2) = w; }
        bf16x8 qr[4];
        { const bf16* qp = QR + (row0 + 32 * wid + r32) * 512 + h * 64 + hi * 8;
#pragma unroll
          for (int d0 = 0; d0 < 4; ++d0) qr[d0] = *(const bf16x8*)(qp + d0 * 16); }
        MX_WAIT_BAR();
        const size_t grow = row0 + 32 * wid + r32;
        u32x2v gq[2][4];
#pragma unroll
        for (int d0 = 0; d0 < 2; ++d0)
#pragma unroll
            for (int g = 0; g < 4; ++g) gq[d0][g] = *(const GAS u32x2v*)(GR + grow * 512 + h * 64 + 32 * d0 + 8 * g + 4 * hi);
        f32x16 o[2]; o[0] = f32x16{}; o[1] = f32x16{};
        const int ktd = wid >> 1;
        for (int kt = 0; kt <= ktd; ++kt) {
            f32x16 p0, p1; qkt(p0, p1, L + L_K + kt * 8192, qr, r32, hi);
            if (kt == ktd) { const int qrel = 32 * (wid & 1) + r32;
#pragma unroll
                for (int r = 0; r < 16; ++r) { const int kv = crow(r, hi); if (kv > qrel) p0[r] = 0.f; if (kv + 32 > qrel) p1[r] = 0.f; } }
            pv64t(o, p0, p1, L + L_V + kt * 8192, lane, hi);
        }
#pragma unroll
        for (int d0 = 0; d0 < 2; ++d0)
#pragma unroll
            for (int ks = 0; ks < 4; ++ks) o[d0] = __builtin_amdgcn_mfma_f32_32x32x16_bf16(tfrag_nat(L + L_R, ks, d0, lane, hi), qr[ks], o[d0], 0, 0, 0);
        float s1a = 0.f, s1b = 0.f, s2a = 0.f, s2b = 0.f;
#pragma unroll
        for (int r = 0; r < 16; r += 2) { s1a += o[0][r] + o[1][r]; s1b += o[0][r + 1] + o[1][r + 1]; s2a += o[0][r] * o[0][r] + o[1][r] * o[1][r]; s2b += o[0][r + 1] * o[0][r + 1] + o[1][r + 1] * o[1][r + 1]; }
        const float mu = halfsum(s1a + s1b) * (1.f / 64.f), var = halfsum(s2a + s2b) * (1.f / 64.f) - mu * mu, rs = __builtin_amdgcn_rsqf(fmaxf(var, 0.f) + EPS);
#pragma unroll
        for (int d0 = 0; d0 < 2; ++d0)
#pragma unroll
            for (int g = 0; g < 4; ++g) { const u32x2v gw = gq[d0][g]; const float gv[4] = {bflo(gw.x), bfhi(gw.x), bflo(gw.y), bfhi(gw.y)};
#pragma unroll
                for (int k = 0; k < 4; ++k) { const float sg = gv[k] * __builtin_amdgcn_rcpf(1.0f + __builtin_amdgcn_exp2f(-1.4426950408889634f * gv[k])); o[d0][4 * g + k] = (o[d0][4 * g + k] - mu) * rs * sg; } }
        bf16* yrow = F.Y + grow * 1024 + 512 + h * 64 + 8 * hi;
#pragma unroll
        for (int d0 = 0; d0 < 2; ++d0)
#pragma unroll
            for (int k = 0; k < 2; ++k) { u32x4 w; ot_pack16(o[d0], k, w); *(GAS u32x4*)(yrow + 32 * d0 + 16 * k) = w; }
    }
    MX_LBAR();
}


constexpr int NMOBA_ITEMS = 64 * 16;
constexpr int LX_ITEM = 131072 + 512, LX_BD2 = 131072 + 1024, LX_WSF = 131072 + 2048;
__device__ __forceinline__ unsigned moba_entry(const LAS unsigned short* LIST, int j, int ri) { return ri < 256 ? (((unsigned)j << 10) | (3u << 8) | (unsigned)ri) : (unsigned)LIST[ri - 256]; }
__device__ __forceinline__ void moba_loadq(Frame& F, mx::bf16x8* qr, const LAS unsigned short* LIST, int b, int h, int j, int tile, int n) {
    int ri = tile * 32 + (F.lane & 31); if (ri >= n) ri = n - 1;
    const unsigned e = moba_entry(LIST, j, ri); const int tq = (int)(e >> 10) * 256 + (int)(e & 255u);
    const bf16* qp = F.PROJ + ((size_t)b * SEQ + tq) * 512 + h * 64 + (F.lane >> 5) * 8;
#pragma unroll
    for (int d0 = 0; d0 < 4; ++d0) qr[d0] = *(const mx::bf16x8*)(qp + d0 * 16);
}
__device__ __forceinline__ void moba_tile(Frame& F, const mx::bf16x8* qr, int b, int h, int j, int tile, int n) {
    using namespace mx;
    const int lane = F.lane, r32 = lane & 31, hi = lane >> 5;
    const lds_cptr L = (lds_cptr)F.lds;
    const LAS unsigned short* LIST = (const LAS unsigned short*)(F.lds + L_LIST);
    const LAS float* bd2 = (const LAS float*)(F.lds + LX_BD2);
    const bool own = tile < 8;
    int ri = tile * 32 + r32; const bool rvalid = ri < n; if (!rvalid) ri = n - 1;
    const unsigned e = moba_entry(LIST, j, ri);
    const int tq = (int)(e >> 10) * 256 + (int)(e & 255u), slot = (int)((e >> 8) & 3u);
    const size_t row = (size_t)b * SEQ + tq;
    float m = 0.f, l0 = 0.f, l1 = 0.f; f32x16 o[2]; o[0] = f32x16{}; o[1] = f32x16{};
    f32x16 negm = f32x16{};
    const int ktmax = own ? ((tile * 32 + 31) >> 6) : 3;
    const bool far = !own && __all(tq >= 256 * j + 383);
    for (int kt = 0; kt <= ktmax; ++kt) {
        f32x16 p0, p1; qkt_c(p0, p1, L + L_K + kt * 8192, qr, negm, r32, hi);
        MX_MFMA_PAD(p0, p1);
        if (!far) { const int kb = 256 * j + 64 * kt + 4 * hi;
#pragma unroll
            for (int r = 0; r < 16; ++r) { const int d0 = tq - (kb + (r & 3) + 8 * (r >> 2)), d1 = d0 - 32;
                int i0 = d0 < 0 ? 0 : (d0 < 128 ? d0 : 128), i1 = d1 < 0 ? 0 : (d1 < 128 ? d1 : 128);
                asm volatile("" : "+v"(i0), "+v"(i1));
                const float b0 = bd2[i0], b1 = bd2[i1];
                p0[r] = d0 < 0 ? -1.0e30f : p0[r] + b0; p1[r] = d1 < 0 ? -1.0e30f : p1[r] + b1; } }
        const float rm = rowmax32(p0, p1);
        if (kt == 0) {
            m = rm;
#pragma unroll
            for (int r = 0; r < 16; ++r) { p0[r] -= rm; p1[r] -= rm; }
#pragma unroll
            for (int r = 0; r < 16; ++r) negm[r] = -m;
        } else if (__any(rm > 8.0f)) {
            const float dl = fmaxf(rm, 0.f), f = __builtin_amdgcn_exp2f(-dl); m += dl; l0 *= f; l1 *= f;
#pragma unroll
            for (int r = 0; r < 16; ++r) { p0[r] -= dl; p1[r] -= dl; o[0][r] *= f; o[1][r] *= f; }
#pragma unroll
            for (int r = 0; r < 16; ++r) negm[r] = -m;
        }
#pragma unroll
        for (int r = 0; r < 16; r += 2) { p0[r] = __builtin_amdgcn_exp2f(p0[r]); p1[r] = __builtin_amdgcn_exp2f(p1[r]); p0[r + 1] = __builtin_amdgcn_exp2f(p0[r + 1]); p1[r + 1] = __builtin_amdgcn_exp2f(p1[r + 1]); l0 += p0[r] + p1[r]; l1 += p0[r + 1] + p1[r + 1]; }
        pv64t(o, p0, p1, L + L_V + kt * 8192, lane, hi);
    }
    const float l = halfsum(l0 + l1), il = __builtin_amdgcn_rcpf(l);
    if (rvalid) {
        if (hi == 0) { float* mlp = F.ML + (((size_t)slot * TT + row) * 8 + h) * 2; mlp[0] = far ? m + bd2[128] : m; mlp[1] = l; }
    }
    bf16* dst = (slot < 2 ? F.PO01 + (size_t)slot * TT * 512 : F.PO23 + (size_t)(slot - 2) * TT * 512) + (row * 8 + h) * 64 + 8 * hi;
#pragma unroll
    for (int d0 = 0; d0 < 2; ++d0) {
#pragma unroll
        for (int r = 0; r < 16; ++r) o[d0][r] *= il;
#pragma unroll
        for (int k = 0; k < 2; ++k) { u32x4 w; ot_pack16(o[d0], k, w); if (rvalid) *(GAS u32x4*)(dst + 32 * d0 + 16 * k) = w; }
    }
}
__device__ __forceinline__ void p3_moba(Frame& F, int qw) {
    using namespace mx;
    const bf16* KA = F.PROJ + (size_t)TT * 512; const bf16* VA = F.PROJ + 2 * (size_t)TT * 512;
    const int wid = F.wave, lane = F.lane;
    const unsigned lds0 = (unsigned)(size_t)F.lds;
    volatile LAS int* itemw = (volatile LAS int*)(F.lds + LX_ITEM);
    LAS unsigned short* LIST = (LAS unsigned short*)(F.lds + L_LIST);
    LAS float* bd2 = (LAS float*)(F.lds + LX_BD2);
    int nxt = 0;
    if (F.tid == 0) nxt = (int)__hip_atomic_fetch_add(F.ctl + qw, 1u, RLX_AGENT);
    for (;;) {
        if (F.tid == 0) itemw[0] = nxt;
        MX_LBAR();
        const int idx = itemw[0];
        if (idx >= NMOBA_ITEMS) break;
        if (F.tid == 0) nxt = (int)__hip_atomic_fetch_add(F.ctl + qw, 1u, RLX_AGENT);
        const int j = idx >> 4, bh = idx & 15, b = bh >> 3, h = bh & 7;
        const size_t row0 = (size_t)b * SEQ + j * 256;
#pragma unroll
        for (int kt = 0; kt < 4; ++kt) { dma_kimg(KA + (row0 + 64 * kt) * 512 + h * 64, lds0 + L_K + kt * 8192, wid, lane); dma_timg(VA + (row0 + 64 * kt) * 512 + h * 64, lds0 + L_V + kt * 8192, wid, lane); }
        if (F.tid < 132) bd2[F.tid] = F.biasd[h * 132 + F.tid] * 1.4426950408889634f;
        const int nsel = (int)F.ctl[CW_TOT + bh * 64 + j], n = 256 + nsel;
        { const unsigned short* lg = F.LISTG + ((size_t)bh * 64 + j) * 16384;
          for (int i = F.tid; i < nsel; i += NWAVES * 64) LIST[i] = lg[i]; }
        MX_WAIT_BAR();
#if MK_DUP & 1024
        MX_LBAR();
#pragma unroll
        for (int kt = 0; kt < 4; ++kt) { dma_kimg(KA + (row0 + 64 * kt) * 512 + h * 64, lds0 + L_K + kt * 8192, wid, lane); dma_timg(VA + (row0 + 64 * kt) * 512 + h * 64, lds0 + L_V + kt * 8192, wid, lane); }
        { const int nsel2 = (int)F.ctl[CW_TOT + bh * 64 + j]; const unsigned short* lg = F.LISTG + ((size_t)bh * 64 + j) * 16384;
          for (int i = F.tid; i < nsel2; i += NWAVES * 64) LIST[i] = lg[i]; }
        MX_WAIT_BAR();
#endif
        const int ntile = (n + 31) >> 5;
        bf16x8 qr[4], qn[4];
#pragma unroll 1
        for (int rep = 0; rep < ((MK_DUP & 2048) ? 2 : 1); ++rep) {
        moba_loadq(F, qr, LIST, b, h, j, wid, n);
        for (int tile = wid; tile < ntile; tile += 8) {
            if (tile + 8 < ntile) moba_loadq(F, qn, LIST, b, h, j, tile + 8, n);
            moba_tile(F, qr, b, h, j, tile, n);
#pragma unroll
            for (int d0 = 0; d0 < 4; ++d0) qr[d0] = qn[d0];
        }
        }
    }
}
__device__ __forceinline__ void p4_combine(Frame& F) {
    const int gt = blockIdx.x * (NWAVES * 64) + F.tid, NT = F.G * NWAVES * 64;
    for (int gid = gt; gid < TT * 64; gid += NT) {
        const int ch = gid & 7, h = (gid >> 3) & 7, row = gid >> 6, c = (row & (SEQ - 1)) >> 8, nv = c < 3 ? c : 3;
        float ms[4], ls[4];
#pragma unroll
        for (int s = 0; s < 4; ++s) { const bool v = (s == 3) || (s < nv); const float* mlp = F.ML + (((size_t)s * TT + row) * 8 + h) * 2; ms[s] = v ? mlp[0] : -3.0e38f; ls[s] = v ? mlp[1] : 0.f; }
        const float M = fmaxf(fmaxf(ms[0], ms[1]), fmaxf(ms[2], ms[3]));
        float acc[8], wsum = 0.f;
#pragma unroll
        for (int k = 0; k < 8; ++k) acc[k] = 0.f;
#pragma unroll
        for (int s = 0; s < 4; ++s) { const bool v = (s == 3) || (s < nv);
            if (v) { const float w = __builtin_amdgcn_exp2f(ms[s] - M) * ls[s]; wsum += w;
                const bf16* src = (s < 2 ? F.PO01 + (size_t)s * TT * 512 : F.PO23 + (size_t)(s - 2) * TT * 512) + ((size_t)row * 8 + h) * 64 + ch * 8;
                const u32x4v pw = *(const GAS u32x4v*)src;
                acc[0] += w * bflo(pw.x); acc[1] += w * bfhi(pw.x); acc[2] += w * bflo(pw.y); acc[3] += w * bfhi(pw.y); acc[4] += w * bflo(pw.z); acc[5] += w * bfhi(pw.z); acc[6] += w * bflo(pw.w); acc[7] += w * bfhi(pw.w); } }
        const float iw = 1.0f / wsum; u32x4v ow; ow.x = pk2(acc[0] * iw, acc[1] * iw); ow.y = pk2(acc[2] * iw, acc[3] * iw); ow.z = pk2(acc[4] * iw, acc[5] * iw); ow.w = pk2(acc[6] * iw, acc[7] * iw);
        *(GAS u32x4v*)(F.Y + (size_t)row * 1024 + h * 64 + ch * 8) = ow;
    }
}

__device__ __forceinline__ void rows_residual(Frame& F, const float* xin, const bf16* Yb, const float* gpost, float* xout, bf16* XNo) {
    const int gw = F.vcu * NWAVES + F.wave, NGW = F.G * NWAVES;
    for (int m = gw; m < TT; m += NGW) {
        float ss = 0.f;
        { const GAS f32x4* rp = (const GAS f32x4*)(F.rowss + (size_t)m * 16);
#pragma unroll
          for (int i = 0; i < 4; ++i) { const f32x4 r = rp[i]; ss += (r.x + r.y) + (r.z + r.w); } }
        const float rstd = 1.0f / sqrtf(ss * (1.f / DM) + EPS);
        const GAS f32x4* xr = (const GAS f32x4*)(xin + (size_t)m * DM) + F.lane;
        const GAS u32x2v* yr = (const GAS u32x2v*)(Yb + (size_t)m * DM) + F.lane;
        const GAS f32x4* gr = (const GAS f32x4*)gpost + F.lane;
        GAS f32x4* orow = (GAS f32x4*)(xout + (size_t)m * DM) + F.lane;
        f32x4 v[4]; float s2 = 0.f;
#pragma unroll
        for (int j = 0; j < 4; ++j) { const f32x4 xv = xr[64 * j]; const u32x2v yw = yr[64 * j]; const f32x4 g = gr[64 * j];
            v[j].x = xv.x + bflo(yw.x) * rstd * g.x; v[j].y = xv.y + bfhi(yw.x) * rstd * g.y; v[j].z = xv.z + bflo(yw.y) * rstd * g.z; v[j].w = xv.w + bfhi(yw.y) * rstd * g.w;
            orow[64 * j] = v[j]; s2 += (v[j].x * v[j].x + v[j].y * v[j].y) + (v[j].z * v[j].z + v[j].w * v[j].w); }
        if (XNo) {
            const float r2 = 1.0f / sqrtf(wave_sum(s2) * (1.f / DM) + EPS);
            GAS unsigned long long* o8 = (GAS unsigned long long*)(XNo + (size_t)m * DM) + F.lane;
#pragma unroll
            for (int j = 0; j < 4; ++j) o8[64 * j] = (unsigned long long)pk2(v[j].x * r2, v[j].y * r2) | ((unsigned long long)pk2(v[j].z * r2, v[j].w * r2) << 32);
        }
    }
}
__device__ __forceinline__ float gelu_tanh(float a) { const float z = 0.7978845608028654f * (a + 0.044715f * a * a * a); return a * (1.0f - 1.0f / (__expf(2.0f * z) + 1.0f)); }
__device__ __forceinline__ void p8_conv(Frame& F, int hb) {
    const int gw = F.vcu * NWAVES + F.wave, NGW = F.G * NWAVES;
    constexpr int RSEG = 32, NSEG = SEQ / RSEG;
    for (int it = gw; it < 11 * NSEG; it += NGW) {
        const int strip = it % 11, seg = it / 11, c = strip * 256 + F.lane * 4, r0 = seg * RSEG;
        f32x4 wa[3], wb[3];
#pragma unroll
        for (int j = 0; j < 3; ++j) { wa[j] = *(const GAS f32x4*)(F.conv_w + (size_t)j * NUP + c); wb[j] = *(const GAS f32x4*)(F.conv_w + (size_t)j * NUP + DFF + c); }
        const f32x4 ba = *(const GAS f32x4*)(F.conv_b + c), bb = *(const GAS f32x4*)(F.conv_b + DFF + c);
        f32x4 a2 = {0.f, 0.f, 0.f, 0.f}, a1 = a2, b2 = a2, b1 = a2;
#define P8_LD(r, ua, ub) do { const u32x2v wa_ = *(const GAS u32x2v*)(Ub + (size_t)(r) * NUP + c), wb_ = *(const GAS u32x2v*)(Ub + (size_t)(r) * NUP + DFF + c); \
            ua = (f32x4){bflo(wa_.x), bfhi(wa_.x), bflo(wa_.y), bfhi(wa_.y)}; ub = (f32x4){bflo(wb_.x), bfhi(wb_.x), bflo(wb_.y), bfhi(wb_.y)}; } while (0)
        const bf16* Ub = F.U;
        if (r0 >= 2) { P8_LD(r0 - 2, a2, b2); P8_LD(r0 - 1, a1, b1); }
        for (int r = r0; r < r0 + RSEG; ++r) {
            f32x4 ua, ub; P8_LD(r, ua, ub);
            const f32x4 av = ba + wa[0] * a2 + wa[1] * a1 + wa[2] * ua, bv = bb + wb[0] * b2 + wb[1] * b1 + wb[2] * ub;
            u32x2v o; o.x = pk2(gelu_tanh(av.x) * bv.x, gelu_tanh(av.y) * bv.y); o.y = pk2(gelu_tanh(av.z) * bv.z, gelu_tanh(av.w) * bv.w);
            *(GAS u32x2v*)(F.Fb + ((size_t)hb * SEQ + r) * DFF + c) = o;
            a2 = a1; a1 = ua; b2 = b1; b1 = ub;
        }
    }
}

constexpr int NPHASE = 10;
struct Args { const float* in[12]; float* out; unsigned char* ws; int ph_lo, ph_hi; };
__global__ void __launch_bounds__(NWAVES * 64, 2) fwd_kernel(Args args) {
    extern __shared__ __attribute__((aligned(16))) unsigned char lds[];
    Frame F;
    F.lds = (LAS unsigned char*)lds; F.MISC = (volatile LAS unsigned*)(F.lds + MISC_OFF);
    F.tid = threadIdx.x; F.lane = F.tid & 63; F.wave = __builtin_amdgcn_readfirstlane(F.tid >> 6);
    F.G = gridDim.x; { const int bx = blockIdx.x; F.vcu = (F.G % 8 == 0) ? (bx % 8) * (F.G / 8) + bx / 8 : bx; }
    unsigned char* ws = args.ws;
    F.ctl = (gu32*)(ws + WS_CTL);
    F.x = args.in[0]; F.g_mix_pre = args.in[1]; F.w_in = args.in[2]; F.rel_bias = args.in[3]; F.w_out = args.in[4]; F.g_mix_post = args.in[5];
    F.g_ffn_pre = args.in[6]; F.w_up = args.in[7]; F.conv_w = args.in[8]; F.conv_b = args.in[9]; F.w_down = args.in[10]; F.g_ffn_post = args.in[11]; F.out = args.out;
    F.Win_t = (bf16*)(ws + WS_WIN); F.Wout_t = (bf16*)(ws + WS_WOUT); F.Wup_t = (bf16*)(ws + WS_WUP); F.Wdn_t = (bf16*)(ws + WS_WDN);
    F.XN = (bf16*)(ws + WS_XN); F.PROJ = (bf16*)(ws + WS_PROJ); F.Y = (bf16*)(ws + WS_Y); F.Y1 = (bf16*)(ws + WS_Y1); F.U = (bf16*)(ws + WS_U); F.Fb = (bf16*)(ws + WS_F);
    F.cs = (float*)(ws + WS_CS); F.biasd = (float*)(ws + WS_SMALL + SM_BIASD); F.dpos = (float*)(ws + WS_SMALL + SM_DPOS); F.dneg = (float*)(ws + WS_SMALL + SM_DNEG);
    F.gam = (float*)(ws + WS_SMALL + SM_GAM); F.g256 = (float*)(ws + WS_SMALL + SM_G256);
    F.kms = (float*)(ws + WS_KMS); F.rowss = (float*)(ws + WS_ROWSS); F.KV = (float*)(ws + WS_KV); F.RP = (float*)(ws + WS_RP); F.sel = (unsigned*)(ws + WS_SEL);
    F.LISTG = (unsigned short*)args.out;
    F.PO01 = (bf16*)(ws + WS_PO01); F.PO23 = (bf16*)(ws + WS_PO23); F.ML = (float*)(ws + WS_ML);
    for (int u = F.tid; u < (LDS_BYTES - LDSCTL_OFF) / 4; u += NWAVES * 64) ((LAS unsigned*)(F.lds + LDSCTL_OFF))[u] = 0u;
    __syncthreads();
    XcdBarrier bar; bar.bar = (unsigned*)(F.ctl + CW_BAR); bar.x = 0; bar.st = nullptr;
    if (MK_ONE_LAUNCH) bar = xcd_barrier_post((unsigned*)(F.ctl + CW_BAR), F.MISC + 8);
    const int lo = args.ph_lo, hi = args.ph_hi;
#define IN(k) (lo <= (k) && (k) < hi)
#define DUP(k) ((MK_DUP >> (k)) & 1)
#define SEAM(k) do { if (IN(k) && IN((k) + 1)) xcd_barrier(bar); } while (0)

    if (IN(0)) { p0_prologue(F); if (DUP(0)) { __syncthreads(); p0_prologue(F); } }
#if MK_ONE_LAUNCH
    if (IN(0) && IN(1)) { cooperative_groups::this_grid().sync(); }
#endif
    if (IN(1)) {
        pg8::Gemm g{F.XN, F.Win_t, TT, NPROJ, DM}; pg8::StaticOrder S; S.init(TT, NPROJ, F.G, (int)blockIdx.x);
        pg8::EpiProj E{F.PROJ, F.cs, F.dpos, F.dneg, F.kms};
        pg8::gemm_phase<pg8::EpiProj, pg8::StaticOrder, PG8_ALIGN, PG8_SP2>(F.lds + RING_OFF, g, S, E);
        if (DUP(1)) { __syncthreads(); pg8::gemm_phase<pg8::EpiProj, pg8::StaticOrder, PG8_ALIGN, PG8_SP2>(F.lds + RING_OFF, g, S, E); }
    } SEAM(1);
    if (IN(2)) { p2_gate(F); __syncthreads(); p2_kv_mfma(F); if (DUP(2)) { __syncthreads(); p2_gate(F); __syncthreads(); p2_kv_mfma(F); } } SEAM(2);
    if (IN(3)) { p3_scan(F); p3_moba(F, CW_Q); if (DUP(3)) { __syncthreads(); p3_scan(F); p3_moba(F, CW_Q + 64); } } SEAM(3);
    if (IN(4)) { p4_ret_mfma(F); p4_combine(F); if (DUP(4)) { __syncthreads(); p4_ret_mfma(F); p4_combine(F); } } SEAM(4);
    if (IN(5)) {
        pg8::Gemm g{F.Y, F.Wout_t, TT, DM, DM}; pg8::StaticOrder S; S.init(TT, DM, F.G, (int)blockIdx.x);
        pg8::EpiY E{F.Y1, F.rowss};
        pg8::gemm_phase<pg8::EpiY, pg8::StaticOrder, PG8_ALIGN, PG8_SP2>(F.lds + RING_OFF, g, S, E);
    } SEAM(5);
    if (IN(6)) { rows_residual(F, F.x, F.Y1, F.g_mix_post, F.out, F.XN); if (DUP(6)) rows_residual(F, F.x, F.Y1, F.g_mix_post, F.out, F.XN); } SEAM(6);
    if (IN(7)) {
        pg8::Gemm g{F.XN, F.Wup_t, 130 * 256, NUP, DM, 1}; pg8::StaticOrder S; S.init(130 * 256, NUP, F.G, (int)blockIdx.x);
        pg8::EpiFfn E{F.Fb, F.conv_w, F.conv_b, (LAS float*)(F.lds + XCH_OFF)};
        pg8::gemm_phase<pg8::EpiFfn, pg8::StaticOrder, true, PG8_SP2>(F.lds + RING_OFF, g, S, E);
    } SEAM(7);
    if (IN(8)) {
        pg8::Gemm g{F.Fb, F.Wdn_t, TT, DM, DFF}; pg8::StaticOrder S; S.init(TT, DM, F.G, (int)blockIdx.x);
        pg8::EpiY E{F.Y1, F.rowss};
        pg8::gemm_phase<pg8::EpiY, pg8::StaticOrder, PG8_ALIGN, PG8_SP2>(F.lds + RING_OFF, g, S, E);
    } SEAM(8);
    if (IN(9)) { rows_residual(F, F.out, F.Y1, F.g_ffn_post, F.out, nullptr); }
#undef IN
#undef SEAM
}

extern "C" void kernel_launch(void* const* d_in, const int* in_sizes, int n_in, void* d_out, int out_size, void* d_ws, size_t ws_size, hipStream_t stream) {
    static int grid = 0;
    if (grid == 0) {
        if (n_in != 12 || in_sizes[0] != TT * DM || out_size != TT * DM || ws_size < WS_END) { fprintf(stderr, "kernel_launch: unexpected shapes (n_in %d in0 %d out %d ws %zu)\n", n_in, n_in > 0 ? in_sizes[0] : -1, out_size, ws_size); grid = -1; return; }
        int dev = 0, cus = 0, per_cu = 0;
        if (hipGetDevice(&dev) != hipSuccess || hipDeviceGetAttribute(&cus, hipDeviceAttributeMultiprocessorCount, dev) != hipSuccess) { grid = -1; return; }
        if (hipFuncSetAttribute((const void*)fwd_kernel, hipFuncAttributeMaxDynamicSharedMemorySize, LDS_BYTES) != hipSuccess) { fprintf(stderr, "kernel_launch: hipFuncSetAttribute failed\n"); grid = -1; return; }
        if (hipOccupancyMaxActiveBlocksPerMultiprocessor(&per_cu, (const void*)fwd_kernel, NWAVES * 64, LDS_BYTES) != hipSuccess || per_cu < 1) { fprintf(stderr, "kernel_launch: occupancy query says %d\n", per_cu); per_cu = 1; }
        (void)hipGetLastError();
        grid = cus * (per_cu < 1 ? 1 : 1);
    }
    if (grid < 0) return;
    if (hipMemsetAsync((char*)d_ws + WS_CTL, 0, CTL_ZERO_BYTES, stream) != hipSuccess) { fprintf(stderr, "kernel_launch: memset failed\n"); return; }
    Args a{};
    for (int i = 0; i < 12; ++i) a.in[i] = (const float*)d_in[i];
    a.out = (float*)d_out; a.ws = (unsigned char*)d_ws;
#if MK_ONE_LAUNCH
    a.ph_lo = 0; a.ph_hi = NPHASE;
    void* kargs[] = {&a};
    hipError_t e = hipLaunchCooperativeKernel((const void*)fwd_kernel, dim3(grid), dim3(NWAVES * 64), kargs, LDS_BYTES, stream);
    if (e != hipSuccess) fprintf(stderr, "kernel_launch: cooperative launch failed: %s\n", hipGetErrorString(e));
#else
    for (int p = 0; p < NPHASE; ++p) { a.ph_lo = p; a.ph_hi = p + 1; hipLaunchKernelGGL(fwd_kernel, dim3(grid), dim3(NWAVES * 64), LDS_BYTES, stream, a); }
#endif
}
```
